# Optimizing an MI355X kernel written in HIP

```python
import math
import jax, jax.numpy as jnp
from jax import lax
import numpy as np

D_MODEL = 1024
BATCH = 16
SEQ = 256
DEPTH = 1
DEC_BATCH = 4
DEC_SEQ = 4096
PAST_LEN = 512

GRID_W = 64
D_ATT = D_MODEL
HD_QK = 64
HD_V = 2 * HD_QK
H_ATT = D_ATT // HD_V
D_SSD = D_MODEL
SSD_HEADDIM = 64
H_SSD = D_SSD // SSD_HEADDIM
SSD_GROUPS = 4
HEADS_PER_GROUP = H_SSD // SSD_GROUPS
D_STATE = 64
CONV_K = 3
CONV_DIM = D_SSD + 2 * SSD_GROUPS * D_STATE
D_INNER = D_ATT + D_SSD
D_PROJ = 4 * D_ATT + D_SSD + CONV_DIM + 2 * H_SSD
CHUNK = 128
Q_BLOCK = 128
ROPE_BASE = 10000.0
ROPE_FREQS = HD_QK // 4
EPS = 1e-6

kernel_name = "hymba_diffattn_ssd_prefix_diffusion_step"

F32 = jnp.float32


def rms_norm(x, g):
    xf = x.astype(F32)
    y = xf * lax.rsqrt(jnp.mean(xf * xf, axis=-1, keepdims=True) + EPS)
    return (y * g.astype(F32)).astype(x.dtype)


def adaln(cond, w_mod, b_mod):
    m = jax.nn.silu(cond) @ w_mod + b_mod
    shift, scale, gate = jnp.split(m, 3, axis=-1)
    return shift[:, None, :], scale[:, None, :], gate[:, None, :]


def split_proj(u):
    idx = np.cumsum([D_ATT, D_ATT, D_ATT, D_ATT, D_SSD, CONV_DIM]).tolist()
    return jnp.split(u, idx, axis=-1)


def axial_rope_tables(L):
    rows = L // GRID_W
    row_ids = jnp.repeat(jnp.arange(rows), GRID_W).astype(F32)
    col_ids = jnp.tile(jnp.arange(GRID_W), rows).astype(F32)
    inv = ROPE_BASE ** (-jnp.arange(ROPE_FREQS, dtype=F32) / ROPE_FREQS)
    ang_r = row_ids[:, None] * inv
    ang_c = col_ids[:, None] * inv
    return jnp.cos(ang_r), jnp.sin(ang_r), jnp.cos(ang_c), jnp.sin(ang_c)


def rotate(x, cos, sin):
    x1, x2 = jnp.split(x, 2, axis=-1)
    return jnp.concatenate([x1 * cos - x2 * sin, x2 * cos + x1 * sin], axis=-1)


def apply_rope(x, tables):
    cr, sr, cc, sc = [t.astype(x.dtype)[:, None, None, :] for t in tables]
    xr, xc = jnp.split(x, 2, axis=-1)
    return jnp.concatenate([rotate(xr, cr, sr), rotate(xc, cc, sc)], axis=-1)


def diff_attention(q, k, v, lam):
    b, Lq = q.shape[0], q.shape[1]
    nb = Lq // Q_BLOCK
    qb = q.reshape(b, nb, Q_BLOCK, H_ATT, 2, HD_QK).transpose(1, 0, 2, 3, 4, 5)
    scale = 1.0 / math.sqrt(HD_QK)

    def block(qi):
        s = jnp.einsum('bqhcd,bkhcd->bchqk', qi, k).astype(F32) * scale
        p = jax.nn.softmax(s, axis=-1)
        a = p[:, 0] - lam * p[:, 1]
        return jnp.einsum('bhqk,bkhd->bqhd', a.astype(v.dtype), v)

    o = lax.map(block, qb)
    return o.transpose(1, 0, 2, 3, 4).reshape(b, Lq, H_ATT, HD_V)


def centred_conv(u, w, bias):
    L = u.shape[1]
    pad = CONV_K // 2
    up = jnp.pad(u, ((0, 0), (pad, pad), (0, 0)))
    out = bias
    for j in range(CONV_K):
        out = out + up[:, j:j + L] * w[j]
    return out


def ssd_scan(x, dt, A, B, C, h0):
    b, L, H, P = x.shape
    N = B.shape[-1]
    nc = L // CHUNK
    xc = x.astype(F32).reshape(b, nc, CHUNK, H, P)
    dtc = dt.reshape(b, nc, CHUNK, H)
    Bc = B.astype(F32).reshape(b, nc, CHUNK, H, N)
    Cc = C.astype(F32).reshape(b, nc, CHUNK, H, N)
    a_cum = jnp.cumsum(dtc * A, axis=2)
    seg = a_cum[:, :, :, None, :] - a_cum[:, :, None, :, :]
    mask = jnp.tril(jnp.ones((CHUNK, CHUNK), dtype=bool))[None, None, :, :, None]
    Lmat = jnp.exp(jnp.where(mask, seg, -jnp.inf))
    xdt = xc * dtc[..., None]
    cb = jnp.einsum('bcqhn,bcshn->bcqsh', Cc, Bc)
    y_diag = jnp.einsum('bcqsh,bcshp->bcqhp', cb * Lmat, xdt)
    decay_to_end = jnp.exp(a_cum[:, :, -1:, :] - a_cum)
    states = jnp.einsum('bcqhn,bcqh,bcqhp->bchpn', Bc, decay_to_end, xdt)
    chunk_decay = jnp.exp(a_cum[:, :, -1, :])

    def step(h, inp):
        st, dec = inp
        return h * dec[:, :, None, None] + st, h

    h_final, h_prev = lax.scan(step, h0.astype(F32),
                               (states.transpose(1, 0, 2, 3, 4), chunk_decay.transpose(1, 0, 2)))
    h_prev = h_prev.transpose(1, 0, 2, 3, 4)
    y_off = jnp.einsum('bcqhn,bchpn,bcqh->bcqhp', Cc, h_prev, jnp.exp(a_cum))
    return (y_diag + y_off).reshape(b, L, H, P), h_final


def ssd_branch(xbc_raw, dt_raw, z, conv_w, conv_b, dt_bias, A_log, D_skip, norm_g, h0):
    b, L, _ = xbc_raw.shape
    xbc = jax.nn.silu(centred_conv(xbc_raw, conv_w, conv_b))
    xs, Bm, Cm = jnp.split(xbc, [D_SSD, D_SSD + SSD_GROUPS * D_STATE], axis=-1)
    xs = xs.reshape(b, L, H_SSD, SSD_HEADDIM)
    Bm = jnp.repeat(Bm.reshape(b, L, SSD_GROUPS, D_STATE), HEADS_PER_GROUP, axis=2)
    Cm = jnp.repeat(Cm.reshape(b, L, SSD_GROUPS, D_STATE), HEADS_PER_GROUP, axis=2)
    dt = jax.nn.softplus(dt_raw.reshape(b, L, 2, H_SSD).astype(F32) + dt_bias.astype(F32))
    A = -jnp.exp(A_log.astype(F32))
    y_f, h_f = ssd_scan(xs, dt[:, :, 0], A[0], Bm, Cm, h0[:, 0])
    y_b, h_b = ssd_scan(jnp.flip(xs, 1), jnp.flip(dt[:, :, 1], 1), A[1],
                        jnp.flip(Bm, 1), jnp.flip(Cm, 1), h0[:, 1])
    y = y_f + jnp.flip(y_b, 1) + D_skip.astype(F32)[:, None] * xs.astype(F32)
    y = y.reshape(b, L, D_SSD).astype(z.dtype) * jax.nn.silu(z)
    return rms_norm(y, norm_g), jnp.stack([h_f, h_b], axis=1)


def layer(x, cond, w_mod, b_mod, norm_g, w_in, lq1, lk1, lq2, lk2, subln_g,
          conv_w, conv_b, dt_bias, A_log, D_skip, ssd_norm_g, w_out, lam_init,
          rope, k_prefix, v_prefix, h0):
    b, L, _ = x.shape
    shift, scale, gate = adaln(cond, w_mod, b_mod)
    h = rms_norm(x, norm_g) * (1.0 + scale) + shift
    q, k, v, g_att, z, xbc, dt_raw = split_proj(h @ w_in)
    q = q.reshape(b, L, H_ATT, 2, HD_QK)
    k = k.reshape(b, L, H_ATT, 2, HD_QK)
    v = v.reshape(b, L, H_ATT, HD_V)
    if rope is not None:
        q = apply_rope(q, rope)
        k = apply_rope(k, rope)
    k_all, v_all = k, v
    if k_prefix is not None:
        k_all = jnp.concatenate([k, k_prefix], axis=1)
        v_all = jnp.concatenate([v, v_prefix], axis=1)
    lam = (jnp.exp(jnp.sum(lq1.astype(F32) * lk1.astype(F32)))
           - jnp.exp(jnp.sum(lq2.astype(F32) * lk2.astype(F32))) + lam_init)
    att = diff_attention(q, k_all, v_all, lam)
    att = rms_norm(att, subln_g) * (1.0 - lam_init)
    att = att.reshape(b, L, D_ATT) * jax.nn.silu(g_att)
    if h0 is None:
        h0 = jnp.zeros((b, 2, H_SSD, SSD_HEADDIM, D_STATE), F32)
    ssd_y, h_fin = ssd_branch(xbc, dt_raw, z, conv_w, conv_b, dt_bias, A_log, D_skip,
                              ssd_norm_g, h0.astype(F32))
    out = jnp.concatenate([att, ssd_y], axis=-1) @ w_out
    return x + gate * out, k.reshape(b, L, H_ATT, 2 * HD_QK), v, h_fin


def setup_inputs(seed: int = 0) -> dict:
    key = jax.random.key(seed)
    ks = jax.random.split(key, 26)
    n = jax.random.normal
    dt0 = jnp.exp(jax.random.uniform(ks[18], (DEPTH, 2, H_SSD), minval=math.log(1e-3), maxval=math.log(1e-1)))
    return {
        "x_prompt": n(ks[0], (BATCH, SEQ, D_MODEL), F32),
        "x_sample": n(ks[1], (DEC_BATCH, DEC_SEQ, D_MODEL), F32),
        "cache_k": n(ks[2], (DEC_BATCH, DEPTH, PAST_LEN, H_ATT, 2 * HD_QK), F32),
        "cache_v": n(ks[3], (DEC_BATCH, DEPTH, PAST_LEN, H_ATT, HD_V), F32),
        "state_ssd": 0.5 * n(ks[4], (DEC_BATCH, DEPTH, 2, H_SSD, SSD_HEADDIM, D_STATE), F32),
        "c": n(ks[5], (DEC_BATCH, D_MODEL), F32),
        "c_ctx": n(ks[6], (D_MODEL,), F32),
        "w_mod": n(ks[7], (DEPTH, D_MODEL, 3 * D_MODEL), F32) * D_MODEL ** -0.5,
        "b_mod": 0.01 * n(ks[8], (DEPTH, 3 * D_MODEL), F32),
        "norm_g": 1.0 + 0.02 * n(ks[9], (DEPTH, D_MODEL), F32),
        "w_in": n(ks[10], (DEPTH, D_MODEL, D_PROJ), F32) * D_MODEL ** -0.5,
        "lambda_q1": 0.1 * n(ks[11], (DEPTH, HD_QK), F32),
        "lambda_k1": 0.1 * n(ks[12], (DEPTH, HD_QK), F32),
        "lambda_q2": 0.1 * n(ks[13], (DEPTH, HD_QK), F32),
        "lambda_k2": 0.1 * n(ks[14], (DEPTH, HD_QK), F32),
        "subln_g": 1.0 + 0.02 * n(ks[15], (DEPTH, HD_V), F32),
        "conv_w": n(ks[16], (DEPTH, CONV_K, CONV_DIM), F32) * CONV_K ** -0.5,
        "conv_b": 0.01 * n(ks[17], (DEPTH, CONV_DIM), F32),
        "dt_bias": dt0 + jnp.log(-jnp.expm1(-dt0)),
        "A_log": jnp.log(jax.random.uniform(ks[19], (DEPTH, 2, H_SSD), minval=1.0, maxval=16.0)),
        "D_skip": 1.0 + 0.02 * n(ks[20], (DEPTH, H_SSD), F32),
        "ssd_norm_g": 1.0 + 0.02 * n(ks[21], (DEPTH, D_SSD), F32),
        "w_out": n(ks[22], (DEPTH, D_INNER, D_MODEL), F32) * D_INNER ** -0.5,
        "final_g": 1.0 + 0.02 * n(ks[23], (D_MODEL,), F32),
    }


def reference(x_prompt, x_sample, cache_k, cache_v, state_ssd, c, c_ctx, w_mod, b_mod,
              norm_g, w_in, lambda_q1, lambda_k1, lambda_q2, lambda_k2, subln_g, conv_w,
              conv_b, dt_bias, A_log, D_skip, ssd_norm_g, w_out, final_g):
    b_dec, l_dec = x_sample.shape[0], x_sample.shape[1]
    l_past = cache_k.shape[2]
    rope = axial_rope_tables(l_dec)
    xp, xs = x_prompt, x_sample
    ks_new, vs_new, hs_new = [], [], []
    for l in range(DEPTH):
        lam_init = 0.8 - 0.6 * math.exp(-0.3 * l)
        p = (w_mod[l], b_mod[l], norm_g[l], w_in[l], lambda_q1[l], lambda_k1[l],
             lambda_q2[l], lambda_k2[l], subln_g[l], conv_w[l], conv_b[l], dt_bias[l],
             A_log[l], D_skip[l], ssd_norm_g[l], w_out[l], lam_init)
        xp, k_ctx, v_ctx, h_ctx = layer(xp, c_ctx[None, :], *p, None, None, None, None)
        ks_new.append(k_ctx)
        vs_new.append(v_ctx)
        hs_new.append(h_ctx)
        kp = cache_k[:, l].reshape(b_dec, l_past, H_ATT, 2, HD_QK)
        vp = cache_v[:, l]
        xs, _, _, _ = layer(xs, c, *p, rope, kp, vp, state_ssd[:, l])
    y_prompt = rms_norm(xp, final_g)
    y_sample = rms_norm(xs, final_g)
    new_cache_k = jnp.stack(ks_new, axis=1)
    new_cache_v = jnp.stack(vs_new, axis=1)
    new_state_ssd = jnp.stack(hs_new, axis=1)
    return (y_prompt, y_sample, new_cache_k, new_cache_v, new_state_ssd)
```

```cpp
#include <hip/hip_runtime.h>
#include <hip/hip_cooperative_groups.h>
#include <cstdio>
#include <cstring>
#include <cstdint>
namespace cg = cooperative_groups;

#ifndef MK_COOP
#define MK_COOP 0
#endif

typedef unsigned short u16;
using bf16x8 = __attribute__((ext_vector_type(8))) short;
using s16x4  = __attribute__((ext_vector_type(4))) short;
using f32x4  = __attribute__((ext_vector_type(4))) float;
using f32x16 = __attribute__((ext_vector_type(16))) float;
using u32x4  = __attribute__((ext_vector_type(4))) unsigned;
using u32x2  = __attribute__((ext_vector_type(2))) unsigned;

constexpr int NTHR = 512;
constexpr int T_CTX = 4096, T_ALL = 20480;
constexpr int NPROJ = 6688, NPADW = 6784;
constexpr int LDS_BYTES = 135168;
constexpr float EPSF = 1e-6f;
constexpr float LAM_INIT = 0.2f;
#ifndef DBG_ST
#define DBG_ST 1
#endif

struct Params {
  const float *x_prompt, *x_sample, *cache_k, *cache_v, *state_ssd, *c, *c_ctx, *w_mod, *b_mod, *norm_g, *w_in,
      *lq1, *lk1, *lq2, *lk2, *subln_g, *conv_w, *conv_b, *dt_bias, *A_log, *D_skip, *ssd_norm_g, *w_out, *final_g;
  float* out;
  u16 *winT, *woutT, *qb, *kC, *kS, *vC, *vS, *zb, *xbc, *hb, *gb, *st;
  float *dtb, *modv, *rope, *misc, *cd, *ssqp, *ssq2p;
};

typedef __bf16 bf16v2 __attribute__((ext_vector_type(2)));
typedef float f32v2 __attribute__((ext_vector_type(2)));
__device__ __forceinline__ unsigned cvtpk(float lo, float hi) {
  f32v2 v = {lo, hi}; bf16v2 b = __builtin_convertvector(v, bf16v2); return __builtin_bit_cast(unsigned, b);
}
__device__ __forceinline__ u16 f2bf(float x) { __bf16 b = (__bf16)x; return __builtin_bit_cast(u16, b); }
__device__ __forceinline__ float bf2f(u16 x) { return __uint_as_float(((unsigned)x) << 16); }
__device__ __forceinline__ float bfs2f(short x) { return __uint_as_float(((unsigned)(u16)x) << 16); }
__device__ __forceinline__ float siluf(float v) { return v / (1.f + __expf(-v)); }
__device__ __forceinline__ bf16x8 pack8(const float* v) {
  u32x4 w = {cvtpk(v[0], v[1]), cvtpk(v[2], v[3]), cvtpk(v[4], v[5]), cvtpk(v[6], v[7])};
  return *reinterpret_cast<bf16x8*>(&w);
}
__device__ __forceinline__ f32x4 mfma16(bf16x8 a, bf16x8 b, f32x4 c) {
  return __builtin_amdgcn_mfma_f32_16x16x32_bf16(a, b, c, 0, 0, 0);
}

__device__ void p0_mod_item(const Params& p, int i, char* smem) {
  const int tid = threadIdx.x;
  float* sc = (float*)smem;
  float* red = sc + 5 * 1024;
  for (int idx = tid; idx < 5120; idx += NTHR) {
    int r = idx >> 10, k = idx & 1023;
    float v = (r == 0) ? p.c_ctx[k] : p.c[(r - 1) * 1024 + k];
    sc[idx] = v / (1.f + expf(-v));
  }
  __syncthreads();
  const int kq = tid >> 6, col = tid & 63, c0 = i * 64;
  float a0 = 0, a1 = 0, a2 = 0, a3 = 0, a4 = 0;
  const float* w = p.w_mod + (long)(kq * 128) * 3072 + c0 + col;
#pragma unroll 8
  for (int k = 0; k < 128; ++k) {
    float wv = w[(long)k * 3072];
    int kk = kq * 128 + k;
    a0 += sc[kk] * wv; a1 += sc[1024 + kk] * wv; a2 += sc[2048 + kk] * wv; a3 += sc[3072 + kk] * wv; a4 += sc[4096 + kk] * wv;
  }
  red[(kq * 5 + 0) * 64 + col] = a0; red[(kq * 5 + 1) * 64 + col] = a1; red[(kq * 5 + 2) * 64 + col] = a2;
  red[(kq * 5 + 3) * 64 + col] = a3; red[(kq * 5 + 4) * 64 + col] = a4;
  __syncthreads();
  if (tid < 320) {
    int r = tid >> 6, cc = tid & 63;
    float s = p.b_mod[c0 + cc];
    for (int q = 0; q < 8; ++q) s += red[(q * 5 + r) * 64 + cc];
    p.modv[r * 3072 + c0 + cc] = s;
  }
  if (i == 0 && tid == 511) {
    float s1 = 0, s2 = 0;
    for (int k = 0; k < 64; ++k) { s1 += p.lq1[k] * p.lk1[k]; s2 += p.lq2[k] * p.lk2[k]; }
    p.misc[0] = expf(s1) - expf(s2) + LAM_INIT;
  }
}

__device__ void p0_transpose_item(const float* __restrict__ src, int ldsrc, int nvalid, u16* __restrict__ dst, int lddst,
                                  int n0, int k0, const float* __restrict__ kscale, char* smem) {
  float* tile = (float*)smem;
  const int tid = threadIdx.x;
  {
    int r = tid >> 3, cc = (tid & 7) * 8;
    float sc = 1.f;
    if (kscale != nullptr && (k0 + r) >= 1024) sc = kscale[k0 + r - 1024];
#pragma unroll
    for (int e = 0; e < 8; ++e) {
      int n = n0 + cc + e;
      float v = (n < nvalid) ? src[(long)(k0 + r) * ldsrc + n] : 0.f;
      tile[r * 65 + cc + e] = v * sc;
    }
  }
  __syncthreads();
  {
    int n = tid >> 3, kk = (tid & 7) * 8;
    float v[8];
#pragma unroll
    for (int e = 0; e < 8; ++e) v[e] = tile[(kk + e) * 65 + n];
    *reinterpret_cast<bf16x8*>(dst + (long)(n0 + n) * lddst + k0 + kk) = pack8(v);
  }
}

__device__ void p0_rope_item(const Params& p) {
  const int tid = threadIdx.x;
  for (int idx = tid; idx < 1024; idx += NTHR) {
    int pos = idx >> 4, i = idx & 15;
    double inv = 1.0;
    for (int q = 0; q < i; ++q) inv *= 0.56234132519034908;
    double ang = (double)pos * inv;
    double kq = rint(ang * 0.63661977236758134);
    double r = ang - kq * 1.5707963267948966 - kq * 6.123233995736766e-17;
    double r2 = r * r;
    double s = r * (1.0 + r2 * (-1.0 / 6 + r2 * (1.0 / 120 + r2 * (-1.0 / 5040 + r2 * (1.0 / 362880 + r2 * (-1.0 / 39916800 + r2 * (1.0 / 6227020800.0 + r2 * (-1.0 / 1307674368000.0))))))));
    double cs = 1.0 + r2 * (-0.5 + r2 * (1.0 / 24 + r2 * (-1.0 / 720 + r2 * (1.0 / 40320 + r2 * (-1.0 / 3628800 + r2 * (1.0 / 479001600 + r2 * (-1.0 / 87178291200.0 + r2 * (1.0 / 20922789888000.0))))))));
    long kk = (long)kq; int qd = (int)(kk & 3);
    double so, co;
    if (qd == 0) { so = s; co = cs; } else if (qd == 1) { so = cs; co = -s; } else if (qd == 2) { so = -s; co = -cs; } else { so = -cs; co = s; }
    p.rope[idx * 2 + 0] = (float)co;
    p.rope[idx * 2 + 1] = (float)so;
  }
}

__device__ void phase0(const Params& p, char* smem) {
  constexpr int N_MOD = 48, N_WIN = 106 * 16, N_WOUT = 16 * 32, N_CACHE = 1024, N_ROPE = 1;
  constexpr int TOTAL = N_MOD + N_WIN + N_WOUT + N_CACHE + N_ROPE;
  const int tid = threadIdx.x;
  for (int it = blockIdx.x; it < TOTAL; it += gridDim.x) {
    int i = it;
    if (i < N_MOD) { p0_mod_item(p, i, smem); }
    else if ((i -= N_MOD) < N_WIN) {
      int nt = i >> 4, kt = i & 15;
      p0_transpose_item(p.w_in, NPROJ, NPROJ, p.winT, 1024, nt * 64, kt * 64, nullptr, smem);
    } else if ((i -= N_WIN) < N_WOUT) {
      int nt = i >> 5, kt = i & 31;
      p0_transpose_item(p.w_out, 1024, 1024, p.woutT, 2048, nt * 64, kt * 64, p.ssd_norm_g, smem);
    } else if ((i -= N_WOUT) < N_CACHE) {
      int tens = i >> 9, blk = i & 511;
      long e0 = (long)blk * 4096 + tid * 8;
      const float* src = (tens ? p.cache_v : p.cache_k) + e0;
      int b = (int)(e0 >> 19); long rem = e0 & ((1 << 19) - 1);
      u16* dst = (tens ? p.vS : p.kS) + ((long)b * 4608 + 4096) * 1024 + rem;
      float v[8];
      float4 x0 = *reinterpret_cast<const float4*>(src), x1 = *reinterpret_cast<const float4*>(src + 4);
      v[0] = x0.x; v[1] = x0.y; v[2] = x0.z; v[3] = x0.w; v[4] = x1.x; v[5] = x1.y; v[6] = x1.z; v[7] = x1.w;
      *reinterpret_cast<bf16x8*>(dst) = pack8(v);
    } else {
      p0_rope_item(p);
    }
    __syncthreads();
  }
}

__device__ void phase1(const Params& p, char* smem) {
  const int tid = threadIdx.x, lane = tid & 63, wid = tid >> 6;
  for (int it = blockIdx.x; it < T_ALL / 8; it += gridDim.x) {
    const int t = it * 8 + wid;
    const float* xr = (t < T_CTX) ? p.x_prompt + (long)t * 1024 : p.x_sample + (long)(t - T_CTX) * 1024;
    const int mr = (t < T_CTX) ? 0 : 1 + ((t - T_CTX) >> 12);
    float4 v[4]; float ss = 0;
#pragma unroll
    for (int i = 0; i < 4; ++i) {
      v[i] = *reinterpret_cast<const float4*>(xr + i * 256 + lane * 4);
      ss += v[i].x * v[i].x + v[i].y * v[i].y + v[i].z * v[i].z + v[i].w * v[i].w;
    }
#pragma unroll
    for (int o = 32; o >= 1; o >>= 1) ss += __shfl_xor(ss, o);
    const float rs = rsqrtf(ss * (1.f / 1024.f) + EPSF);
#pragma unroll
    for (int i = 0; i < 4; ++i) {
      int col = i * 256 + lane * 4;
      float4 g = *reinterpret_cast<const float4*>(p.norm_g + col);
      float4 sh = *reinterpret_cast<const float4*>(p.modv + mr * 3072 + col);
      float4 sc = *reinterpret_cast<const float4*>(p.modv + mr * 3072 + 1024 + col);
      float h0 = v[i].x * rs * g.x * (1.f + sc.x) + sh.x;
      float h1 = v[i].y * rs * g.y * (1.f + sc.y) + sh.y;
      float h2 = v[i].z * rs * g.z * (1.f + sc.z) + sh.z;
      float h3 = v[i].w * rs * g.w * (1.f + sc.w) + sh.w;
      u32x2 w = {cvtpk(h0, h1), cvtpk(h2, h3)};
      *reinterpret_cast<u32x2*>(p.hb + (long)t * 1024 + col) = w;
    }
  }
}

constexpr int G_LD = 72;
constexpr int G_ABYTES = 256 * G_LD * 2, G_BBYTES = 128 * G_LD * 2, G_STAGE = G_ABYTES + G_BBYTES;

__device__ __forceinline__ void gemm_kloop(f32x4 (&acc)[4][4], const u16* __restrict__ A, int lda,
                                           const u16* __restrict__ B, int ldb, int nk, char* smem) {
  const int tid = threadIdx.x, lane = tid & 63, wid = tid >> 6, wm = wid >> 1, wn = wid & 1, fr = lane & 15, fq = lane >> 4;
  bf16x8 ra[4], rb[2];
  const int lr = tid >> 3, lc = (tid & 7) * 8;
  __syncthreads();
#pragma unroll
  for (int i = 0; i < 4; ++i) ra[i] = *reinterpret_cast<const bf16x8*>(A + (long)(lr + i * 64) * lda + lc);
#pragma unroll
  for (int i = 0; i < 2; ++i) rb[i] = *reinterpret_cast<const bf16x8*>(B + (long)(lr + i * 64) * ldb + lc);
  {
    u16* As = (u16*)smem; u16* Bs = (u16*)(smem + G_ABYTES);
#pragma unroll
    for (int i = 0; i < 4; ++i) *reinterpret_cast<bf16x8*>(As + (lr + i * 64) * G_LD + lc) = ra[i];
#pragma unroll
    for (int i = 0; i < 2; ++i) *reinterpret_cast<bf16x8*>(Bs + (lr + i * 64) * G_LD + lc) = rb[i];
  }
  __syncthreads();
  for (int kt = 0; kt < nk; ++kt) {
    if (kt + 1 < nk) {
#pragma unroll
      for (int i = 0; i < 4; ++i) ra[i] = *reinterpret_cast<const bf16x8*>(A + (long)(lr + i * 64) * lda + (kt + 1) * 64 + lc);
#pragma unroll
      for (int i = 0; i < 2; ++i) rb[i] = *reinterpret_cast<const bf16x8*>(B + (long)(lr + i * 64) * ldb + (kt + 1) * 64 + lc);
    }
    const u16* As = (const u16*)(smem + (kt & 1) * G_STAGE);
    const u16* Bs = (const u16*)(smem + (kt & 1) * G_STAGE + G_ABYTES);
#pragma unroll
    for (int ks = 0; ks < 2; ++ks) {
      bf16x8 a[4], b[4];
#pragma unroll
      for (int mi = 0; mi < 4; ++mi) a[mi] = *reinterpret_cast<const bf16x8*>(As + (wm * 64 + mi * 16 + fr) * G_LD + ks * 32 + fq * 8);
#pragma unroll
      for (int ni = 0; ni < 4; ++ni) b[ni] = *reinterpret_cast<const bf16x8*>(Bs + (wn * 64 + ni * 16 + fr) * G_LD + ks * 32 + fq * 8);
#pragma unroll
      for (int mi = 0; mi < 4; ++mi)
#pragma unroll
        for (int ni = 0; ni < 4; ++ni) acc[mi][ni] = mfma16(a[mi], b[ni], acc[mi][ni]);
    }
    if (kt + 1 < nk) {
      u16* As2 = (u16*)(smem + ((kt + 1) & 1) * G_STAGE); u16* Bs2 = (u16*)(smem + ((kt + 1) & 1) * G_STAGE + G_ABYTES);
#pragma unroll
      for (int i = 0; i < 4; ++i) *reinterpret_cast<bf16x8*>(As2 + (lr + i * 64) * G_LD + lc) = ra[i];
#pragma unroll
      for (int i = 0; i < 2; ++i) *reinterpret_cast<bf16x8*>(Bs2 + (lr + i * 64) * G_LD + lc) = rb[i];
    }
    __syncthreads();
  }
}

__device__ void phase2(const Params& p, char* smem) {
  const int tid = threadIdx.x, lane = tid & 63, wid = tid >> 6, wm = wid >> 1, wn = wid & 1, fr = lane & 15, fq = lane >> 4;
  constexpr int NT_N = 53, NT_M = 80;
  for (int it = blockIdx.x; it < NT_M * NT_N; it += gridDim.x) {
    const int mt = it / NT_N, nt = it - mt * NT_N;
    const int m0 = mt * 256, n0 = nt * 128;
    f32x4 acc[4][4];
#pragma unroll
    for (int mi = 0; mi < 4; ++mi)
#pragma unroll
      for (int ni = 0; ni < 4; ++ni) acc[mi][ni] = f32x4{0.f, 0.f, 0.f, 0.f};
    gemm_kloop(acc, p.hb + (long)m0 * 1024, 1024, p.winT + (long)n0 * 1024, 1024, 16, smem);
    const bool is_ctx = (m0 < T_CTX);
    const int seg = (n0 < 5120) ? (n0 >> 10) : (n0 < 6656 ? 5 : 6);
    const int cw = n0 + wn * 64;
    if (!is_ctx && seg <= 1) {
#pragma unroll
      for (int mi = 0; mi < 4; ++mi)
#pragma unroll
        for (int j = 0; j < 4; ++j) {
          int t = m0 + wm * 64 + mi * 16 + fq * 4 + j;
          int tl = (t - T_CTX) & 4095;
          int rid = tl >> 6, cid = tl & 63;
          float2 cr = *reinterpret_cast<const float2*>(p.rope + (rid * 16 + fr) * 2);
          float2 cc = *reinterpret_cast<const float2*>(p.rope + (cid * 16 + fr) * 2);
          float x1 = acc[mi][0][j], x2 = acc[mi][1][j];
          acc[mi][0][j] = x1 * cr.x - x2 * cr.y; acc[mi][1][j] = x2 * cr.x + x1 * cr.y;
          x1 = acc[mi][2][j]; x2 = acc[mi][3][j];
          acc[mi][2][j] = x1 * cc.x - x2 * cc.y; acc[mi][3][j] = x2 * cc.x + x1 * cc.y;
        }
    }
#pragma unroll
    for (int mi = 0; mi < 4; ++mi)
#pragma unroll
      for (int j = 0; j < 4; ++j) {
        const int t = m0 + wm * 64 + mi * 16 + fq * 4 + j;
#pragma unroll
        for (int ni = 0; ni < 4; ++ni) {
          const int n = cw + ni * 16 + fr;
          const float v = acc[mi][ni][j];
          if (seg == 0) {
            p.qb[(long)t * 1024 + n] = f2bf(v);
          } else if (seg == 1 || seg == 2) {
            const int c = n - seg * 1024;
            if (is_ctx) {
              (seg == 1 ? p.kC : p.vC)[(long)t * 1024 + c] = f2bf(v);
              p.out[(seg == 1 ? 20971520L : 25165824L) + (long)t * 1024 + c] = v;
            } else {
              int ts = t - T_CTX; int b = ts >> 12, tl = ts & 4095;
              (seg == 1 ? p.kS : p.vS)[((long)b * 4608 + tl) * 1024 + c] = f2bf(v);
            }
          } else if (seg == 3) {
            p.gb[(long)t * 1024 + (n - 3072)] = f2bf(siluf(v));
          } else if (seg == 4) {
            p.zb[(long)t * 1024 + (n - 4096)] = f2bf(siluf(v));
          } else if (seg == 5) {
            p.xbc[(long)t * 1536 + (n - 5120)] = f2bf(v);
          } else {
            if (n < NPROJ) p.dtb[(long)t * 32 + (n - 6656)] = v;
          }
        }
      }
  }
}

constexpr int SHM_V = 64 * 128 * 2, SHM_K = 64 * 128 * 2;
constexpr float ASCALE = 0.125f;
constexpr float ATHR = 8.f;
#define KSWZ(row, colB) ((row) * 256 + ((colB) ^ (((row) & 7) << 4)))
#define SBAR() __builtin_amdgcn_sched_barrier(0)
__device__ __forceinline__ int crow(int r, int hi) { return (r & 3) + 8 * (r >> 2) + 4 * hi; }

__device__ __forceinline__ void partialSM(f32x16& p0, f32x16& p1, float& m_reg, float& mn, float& alpha) {
  constexpr float C = ASCALE * 1.4426950408889634f;
  float pmax = p0[0];
#pragma unroll
  for (int r = 1; r < 16; ++r) pmax = fmaxf(pmax, p0[r]);
#pragma unroll
  for (int r = 0; r < 16; ++r) pmax = fmaxf(pmax, p1[r]);
  { auto rr = __builtin_amdgcn_permlane32_swap(__float_as_uint(pmax), __float_as_uint(pmax), false, false);
    pmax = fmaxf(__uint_as_float(rr[0]), __uint_as_float(rr[1])); }
  if (__builtin_expect(__all(pmax - m_reg <= ATHR / ASCALE), 1)) { mn = m_reg; alpha = 1.f; }
  else { mn = fmaxf(m_reg, pmax); alpha = __builtin_amdgcn_exp2f((m_reg - mn) * C); m_reg = mn; }
  float mnC = -mn * C;
#pragma unroll
  for (int r = 0; r < 16; ++r) p0[r] = fmaf(p0[r], C, mnC);
#pragma unroll
  for (int r = 0; r < 16; ++r) p1[r] = fmaf(p1[r], C, mnC);
#pragma unroll
  for (int r = 0; r < 16; ++r) p0[r] = __builtin_amdgcn_exp2f(p0[r]);
}
__device__ __forceinline__ void finishSM(f32x16& p0, f32x16& p1, float alpha, float& l_reg, bf16x8& pa0, bf16x8& pa1, bf16x8& pa2, bf16x8& pa3) {
#pragma unroll
  for (int r = 0; r < 16; ++r) p1[r] = __builtin_amdgcn_exp2f(p1[r]);
  float ps = 0;
#pragma unroll
  for (int r = 0; r < 16; ++r) ps += p0[r];
#pragma unroll
  for (int r = 0; r < 16; ++r) ps += p1[r];
  { auto rr = __builtin_amdgcn_permlane32_swap(__float_as_uint(ps), __float_as_uint(ps), false, false);
    ps = __uint_as_float(rr[0]) + __uint_as_float(rr[1]); }
  l_reg = l_reg * alpha + ps;
#define PK4(P, BASE, OUT) do { unsigned a0 = cvtpk(P[BASE + 0], P[BASE + 1]), a1 = cvtpk(P[BASE + 2], P[BASE + 3]);   \
    unsigned b0 = cvtpk(P[BASE + 4], P[BASE + 5]), b1 = cvtpk(P[BASE + 6], P[BASE + 7]);                              \
    auto r0 = __builtin_amdgcn_permlane32_swap(a0, b0, false, false); auto r1 = __builtin_amdgcn_permlane32_swap(a1, b1, false, false); \
    u32x4 w = {r0[0], r1[0], r0[1], r1[1]}; OUT = *reinterpret_cast<bf16x8*>(&w); } while (0)
  PK4(p0, 0, pa0); PK4(p0, 8, pa1); PK4(p1, 0, pa2); PK4(p1, 8, pa3);
#undef PK4
}
__device__ __forceinline__ void qkt(f32x16& p0, f32x16& p1, const u16* Ks, const bf16x8* qr, int r32, int hi, int comp) {
  p0 = f32x16{}; p1 = f32x16{};
#pragma unroll
  for (int d0 = 0; d0 < 4; ++d0) { int cb = (comp * 64 + d0 * 16 + hi * 8) * 2;
    bf16x8 b0 = *reinterpret_cast<const bf16x8*>((const char*)Ks + KSWZ(r32, cb));
    bf16x8 b1 = *reinterpret_cast<const bf16x8*>((const char*)Ks + KSWZ(32 + r32, cb));
    p0 = __builtin_amdgcn_mfma_f32_32x32x16_bf16(b0, qr[d0], p0, 0, 0, 0);
    p1 = __builtin_amdgcn_mfma_f32_32x32x16_bf16(b1, qr[d0], p1, 0, 0, 0); }
}
__device__ __forceinline__ int v_st(int k, int c) { const int kk = (k & ~0xC) | ((k & 4) << 1) | ((k & 8) >> 1); return ((kk >> 3) * 4 + (c >> 5)) * 512 + ((kk & 7) * 32 + (c & 31)) * 2; }
__device__ __forceinline__ int v_rd_base(int lane) { return ((lane & 3) << 3) | (((lane >> 2) & 3) << 6) | (((lane >> 4) & 1) << 5) | (((lane >> 5) & 1) << 8); }
constexpr int v_rd_off(int d0, int ks, int half) { return d0 * 512 + ks * 4096 + half * 2048; }
template <int OFF> __device__ __forceinline__ s16x4 tr_read(int vb) {
  s16x4 r; asm volatile("ds_read_b64_tr_b16 %0, %1 offset:%2" : "=&v"(r) : "v"(vb), "i"(OFF) : "memory"); return r;
}
template <int D0> __device__ __forceinline__ void pv_one(f32x16& od, int vb, bf16x8 pa0, bf16x8 pa1, bf16x8 pa2, bf16x8 pa3) {
  const s16x4 l0 = tr_read<v_rd_off(D0, 0, 0)>(vb), h0 = tr_read<v_rd_off(D0, 0, 1)>(vb), l1 = tr_read<v_rd_off(D0, 1, 0)>(vb), h1 = tr_read<v_rd_off(D0, 1, 1)>(vb);
  const s16x4 l2 = tr_read<v_rd_off(D0, 2, 0)>(vb), h2 = tr_read<v_rd_off(D0, 2, 1)>(vb), l3 = tr_read<v_rd_off(D0, 3, 0)>(vb), h3 = tr_read<v_rd_off(D0, 3, 1)>(vb);
  asm volatile("s_waitcnt lgkmcnt(0)" ::: "memory"); SBAR();
#define PK(L, H) (bf16x8){L[0], L[1], L[2], L[3], H[0], H[1], H[2], H[3]}
  od = __builtin_amdgcn_mfma_f32_32x32x16_bf16(pa0, PK(l0, h0), od, 0, 0, 0);
  od = __builtin_amdgcn_mfma_f32_32x32x16_bf16(pa1, PK(l1, h1), od, 0, 0, 0);
  od = __builtin_amdgcn_mfma_f32_32x32x16_bf16(pa2, PK(l2, h2), od, 0, 0, 0);
  od = __builtin_amdgcn_mfma_f32_32x32x16_bf16(pa3, PK(l3, h3), od, 0, 0, 0);
#undef PK
}
__device__ __forceinline__ void pv_d0(f32x16* o, int vb, bf16x8 pa0, bf16x8 pa1, bf16x8 pa2, bf16x8 pa3) {
  pv_one<0>(o[0], vb, pa0, pa1, pa2, pa3); pv_one<1>(o[1], vb, pa0, pa1, pa2, pa3); pv_one<2>(o[2], vb, pa0, pa1, pa2, pa3); pv_one<3>(o[3], vb, pa0, pa1, pa2, pa3);
}

__device__ __forceinline__ void attn_item(const Params& p, long tq0, int h, const u16* __restrict__ Kh, const u16* __restrict__ Vh, int seq, char* lds) {
  constexpr int LDK = 1024;
  const int tid = threadIdx.x, wid = tid >> 6, lane = tid & 63, r32 = lane & 31, hi = lane >> 5;
  const int comp = wid >> 2, qg = wid & 3;
  u16* V_lds = (u16*)lds; u16* K_lds = (u16*)(lds + 2 * SHM_V);
  float* wsl = (float*)(lds + 2 * SHM_V + 2 * SHM_K) + wid * 64; float* li_l = wsl; float* al_l = wsl + 32;
  float m_reg = -1e30f, l_reg = 0; f32x16 o[4] = {}; bf16x8 qr[4];
  const u16* Qw = p.qb + (tq0 + qg * 32 + r32) * 1024 + h * 128 + comp * 64 + hi * 8;
#pragma unroll
  for (int d0 = 0; d0 < 4; ++d0) qr[d0] = *reinterpret_cast<const bf16x8*>(Qw + d0 * 16);
  const int sr = tid >> 4, sc = (tid & 15) * 8, vst0 = v_st(sr, sc), vst1 = v_st(32 + sr, sc);
  const int vb0 = (int)(uintptr_t)V_lds + v_rd_base(lane);
  constexpr int SDEPTH = 1;
  struct { bf16x8 vs0, vs1, ks0, ks1; } sr_[SDEPTH];
#define SLOAD(i, k0) do { sr_[i].vs0 = *reinterpret_cast<const bf16x8*>(&Vh[(long)((k0) + sr) * LDK + sc]); sr_[i].vs1 = *reinterpret_cast<const bf16x8*>(&Vh[(long)((k0) + 32 + sr) * LDK + sc]); \
    sr_[i].ks0 = *reinterpret_cast<const bf16x8*>(&Kh[(long)((k0) + sr) * LDK + sc]); sr_[i].ks1 = *reinterpret_cast<const bf16x8*>(&Kh[(long)((k0) + 32 + sr) * LDK + sc]); } while (0)
#define SWRITE(b, i) do { *(bf16x8*)((char*)V_lds + (b) * SHM_V + vst0) = sr_[i].vs0;          \
    *(bf16x8*)((char*)V_lds + (b) * SHM_V + vst1) = sr_[i].vs1; int kc = sc * 2;               \
    *(bf16x8*)((char*)K_lds + (b) * SHM_K + KSWZ(sr, kc)) = sr_[i].ks0;                       \
    *(bf16x8*)((char*)K_lds + (b) * SHM_K + KSWZ(32 + sr, kc)) = sr_[i].ks1; } while (0)
#define SWAIT() do { if constexpr (SDEPTH == 2) asm volatile("s_waitcnt vmcnt(4)" ::: "memory"); else asm volatile("s_waitcnt vmcnt(0)" ::: "memory"); } while (0)
#define RESC(a) do { if (__any((a) < 1.f)) { if (hi == 0) al_l[r32] = (a); asm volatile("s_waitcnt lgkmcnt(0)" ::: "memory"); \
    _Pragma("unroll") for (int d = 0; d < 4; ++d) _Pragma("unroll") for (int r = 0; r < 16; ++r) o[d][r] *= al_l[crow(r, hi)]; } } while (0)
  f32x16 pA0, pA1, pB0, pB1; float mnA, mnB, alA, alB; bf16x8 pa0, pa1, pa2, pa3; const int NT = seq / 64;
  constexpr int SE = 0, SO = SDEPTH - 1;
  SLOAD(SE, 0); asm volatile("s_waitcnt vmcnt(0)" ::: "memory"); SWRITE(0, SE); __syncthreads();
  qkt(pA0, pA1, K_lds, qr, r32, hi, comp); partialSM(pA0, pA1, m_reg, mnA, alA);
  SLOAD(SO, 64); if constexpr (SDEPTH == 2) { if (2 < NT) SLOAD(SE, 2 * 64); }
  SWAIT(); SWRITE(1, SO); __syncthreads();
  for (int j = 1; j + 1 < NT; j += 2) {
    SBAR(); qkt(pB0, pB1, (u16*)((char*)K_lds + SHM_K), qr, r32, hi, comp);
    finishSM(pA0, pA1, alA, l_reg, pa0, pa1, pa2, pa3); SBAR();
    SLOAD(SO, (j + SDEPTH) * 64); SBAR();
    pv_d0(o, vb0, pa0, pa1, pa2, pa3); partialSM(pB0, pB1, m_reg, mnB, alB);
    __syncthreads(); SWAIT(); SWRITE(0, SE);
    RESC(alB); __syncthreads();
    SBAR(); qkt(pA0, pA1, K_lds, qr, r32, hi, comp);
    finishSM(pB0, pB1, alB, l_reg, pa0, pa1, pa2, pa3); SBAR();
    if (SDEPTH == 1 || j + 3 < NT) SLOAD(SE, (j + 1 + SDEPTH) * 64); SBAR();
    pv_d0(o, vb0 + (int)SHM_V, pa0, pa1, pa2, pa3); partialSM(pA0, pA1, m_reg, mnA, alA);
    __syncthreads(); SWAIT(); SWRITE(1, SO);
    RESC(alA); __syncthreads();
  }
  SBAR(); qkt(pB0, pB1, (u16*)((char*)K_lds + SHM_K), qr, r32, hi, comp);
  finishSM(pA0, pA1, alA, l_reg, pa0, pa1, pa2, pa3); SBAR();
  pv_d0(o, vb0, pa0, pa1, pa2, pa3); partialSM(pB0, pB1, m_reg, mnB, alB);
  __syncthreads(); RESC(alB);
  finishSM(pB0, pB1, alB, l_reg, pa0, pa1, pa2, pa3); SBAR();
  pv_d0(o, vb0 + (int)SHM_V, pa0, pa1, pa2, pa3);
  if (hi == 0) li_l[r32] = l_reg; asm volatile("s_waitcnt lgkmcnt(0)" ::: "memory");
  float rli[16];
#pragma unroll
  for (int r = 0; r < 16; ++r) rli[r] = 1.f / li_l[crow(r, hi)];
#undef SLOAD
#undef SWRITE
#undef SWAIT
#undef RESC
  __syncthreads();
  float* ex = (float*)lds;
  const float lam = p.misc[0];
  if (comp == 1) {
#pragma unroll
    for (int d0 = 0; d0 < 4; ++d0)
#pragma unroll
      for (int r = 0; r < 16; ++r) ex[((qg * 4 + d0) * 16 + r) * 64 + lane] = o[d0][r] * rli[r] * lam;
  }
  __syncthreads();
  if (comp == 0) {
    float ssq[16];
#pragma unroll
    for (int r = 0; r < 16; ++r) ssq[r] = 0.f;
#pragma unroll
    for (int d0 = 0; d0 < 4; ++d0)
#pragma unroll
      for (int r = 0; r < 16; ++r) {
        float v = o[d0][r] * rli[r] - ex[((qg * 4 + d0) * 16 + r) * 64 + lane];
        o[d0][r] = v; ssq[r] += v * v;
      }
#pragma unroll
    for (int r = 0; r < 16; ++r) {
      float s = ssq[r];
      s += __shfl_xor(s, 1); s += __shfl_xor(s, 2); s += __shfl_xor(s, 4); s += __shfl_xor(s, 8); s += __shfl_xor(s, 16);
      ssq[r] = rsqrtf(s * (1.f / 128.f) + EPSF) * (1.f - LAM_INIT);
    }
    float sg[4];
#pragma unroll
    for (int d0 = 0; d0 < 4; ++d0) sg[d0] = p.subln_g[d0 * 32 + r32];
    const long base = (tq0 + qg * 32 + 4 * hi) * 1024 + h * 128 + r32;
    const u16* gp = p.gb + base; u16* qp = p.qb + base;
#pragma unroll
    for (int r = 0; r < 16; ++r) {
      const int ro = ((r & 3) + 8 * (r >> 2)) * 1024;
      float g0 = bf2f(gp[ro]), g1 = bf2f(gp[ro + 32]), g2 = bf2f(gp[ro + 64]), g3 = bf2f(gp[ro + 96]);
      qp[ro] = f2bf(o[0][r] * ssq[r] * sg[0] * g0);
      qp[ro + 32] = f2bf(o[1][r] * ssq[r] * sg[1] * g1);
      qp[ro + 64] = f2bf(o[2][r] * ssq[r] * sg[2] * g2);
      qp[ro + 96] = f2bf(o[3][r] * ssq[r] * sg[3] * g3);
      SBAR();
    }
  }
  __syncthreads();
}

__device__ __forceinline__ void conv8(const Params& p, long tok_s, int L, int tpos, int ch0, float (&o)[8]) {
  const u16* base = p.xbc + (tok_s + tpos) * 1536 + ch0;
  bf16x8 r1 = *reinterpret_cast<const bf16x8*>(base);
  bf16x8 r0 = {0, 0, 0, 0, 0, 0, 0, 0}, r2 = {0, 0, 0, 0, 0, 0, 0, 0};
  if (tpos > 0) r0 = *reinterpret_cast<const bf16x8*>(base - 1536);
  if (tpos < L - 1) r2 = *reinterpret_cast<const bf16x8*>(base + 1536);
  const float* w = p.conv_w + ch0;
  const float* bb = p.conv_b + ch0;
#pragma unroll
  for (int e = 0; e < 8; ++e) {
    float v = bb[e] + w[e] * bfs2f(r0[e]) + w[1536 + e] * bfs2f(r1[e]) + w[3072 + e] * bfs2f(r2[e]);
    o[e] = siluf(v);
  }
}
__device__ __forceinline__ void chunk_geom(int cg, long& tok_s, int& L, int& tpos0) {
  if (cg < 32) { tok_s = (long)(cg >> 1) * 256; L = 256; tpos0 = (cg & 1) * 128; }
  else { int cs = cg - 32; tok_s = T_CTX + (long)(cs >> 5) * 4096; L = 4096; tpos0 = (cs & 31) * 128; }
}
__device__ __forceinline__ void ssd_dt_scan(const Params& p, long tok0, int head, float* dtv, float* cum, float* scn, float* tot) {
  const int tid = threadIdx.x, lane = tid & 63, wid = tid >> 6;
  if (tid < 256) {
    int d = tid >> 7, tl = tid & 127;
    float raw = p.dtb[(tok0 + tl) * 32 + d * 16 + head] + p.dt_bias[d * 16 + head];
    float dt = (raw > 20.f) ? raw : log1pf(expf(raw));
    float a = -expf(p.A_log[d * 16 + head]) * dt;
    dtv[d * 128 + tl] = dt;
    int li = d ? 127 - tl : tl;
    scn[d * 128 + li] = a;
  }
  __syncthreads();
  if (wid < 2) {
    int d = wid;
    float a0 = scn[d * 128 + 2 * lane], a1 = scn[d * 128 + 2 * lane + 1];
    float s = a0 + a1;
#pragma unroll
    for (int off = 1; off < 64; off <<= 1) { float t = __shfl_up(s, off); if (lane >= off) s += t; }
    float c0 = s - a1, c1 = s;
    int li0 = 2 * lane, li1 = 2 * lane + 1;
    cum[d * 128 + (d ? 127 - li0 : li0)] = c0;
    cum[d * 128 + (d ? 127 - li1 : li1)] = c1;
    if (lane == 63) tot[d] = c1;
  }
  __syncthreads();
}

__device__ void ssd_state_item(const Params& p, int cg, int head, char* smem) {
  const int tid = threadIdx.x, lane = tid & 63, wid = tid >> 6, fr = lane & 15, fq = lane >> 4;
  float* dtv = (float*)smem; float* cum = dtv + 256; float* scn = cum + 256; float* tot = scn + 256;
  u16* XsT = (u16*)(smem + 4096);
  u16* BT = XsT + 2 * 64 * 136;
  long tok_s; int L, tpos0; chunk_geom(cg, tok_s, L, tpos0);
  const long tok0 = (long)cg * 128;
  const int g = head >> 2;
  ssd_dt_scan(p, tok0, head, dtv, cum, scn, tot);
  const float tot0 = tot[0], tot1 = tot[1];
#pragma unroll
  for (int rep = 0; rep < 2; ++rep) {
    int id = tid + rep * NTHR; int tl = id >> 3, p0 = (id & 7) * 8;
    float xo[8], bo[8];
    conv8(p, tok_s, L, tpos0 + tl, head * 64 + p0, xo);
    conv8(p, tok_s, L, tpos0 + tl, 1024 + g * 64 + p0, bo);
    float s0 = dtv[tl] * __expf(tot0 - cum[tl]);
    float s1 = dtv[128 + tl] * __expf(tot1 - cum[128 + tl]);
#pragma unroll
    for (int e = 0; e < 8; ++e) {
      XsT[(p0 + e) * 136 + tl] = f2bf(xo[e] * s0);
      XsT[(64 + p0 + e) * 136 + tl] = f2bf(xo[e] * s1);
      BT[(p0 + e) * 136 + tl] = f2bf(bo[e]);
    }
  }
  __syncthreads();
  {
    const int d = wid >> 2, pb = wid & 3;
    f32x4 acc[4];
#pragma unroll
    for (int ni = 0; ni < 4; ++ni) acc[ni] = f32x4{0.f, 0.f, 0.f, 0.f};
#pragma unroll
    for (int ks = 0; ks < 4; ++ks) {
      bf16x8 a = *reinterpret_cast<const bf16x8*>(XsT + (d * 64 + pb * 16 + fr) * 136 + ks * 32 + fq * 8);
#pragma unroll
      for (int ni = 0; ni < 4; ++ni) {
        bf16x8 b = *reinterpret_cast<const bf16x8*>(BT + (ni * 16 + fr) * 136 + ks * 32 + fq * 8);
        acc[ni] = mfma16(a, b, acc[ni]);
      }
    }
    u16* dst = p.st + ((long)(cg * 16 + head) * 2 + d) * 4096;
#pragma unroll
    for (int ni = 0; ni < 4; ++ni)
#pragma unroll
      for (int j = 0; j < 4; ++j) dst[(pb * 16 + fq * 4 + j) * 64 + ni * 16 + fr] = f2bf(acc[ni][j]);
  }
  if (tid < 2) p.cd[(cg * 16 + head) * 2 + tid] = __expf(tot[tid]);
  __syncthreads();
}

__device__ void phase3(const Params& p, char* smem) {
  constexpr int N_AS = 1024, N_AC = 256, N_ST = 160 * 16;
  for (int it = blockIdx.x; it < N_AS + N_AC + N_ST * DBG_ST; it += gridDim.x) {
    if (it < N_AS + N_AC) {
      long tq0; int h, seq; const u16 *kp, *vp;
      if (it < N_AS) {
        int qbi = it & 31, b = it >> 8; h = (it >> 5) & 7;
        tq0 = T_CTX + (long)b * 4096 + qbi * 128; seq = 4608;
        kp = p.kS + (long)b * 4608 * 1024 + h * 128; vp = p.vS + (long)b * 4608 * 1024 + h * 128;
      } else {
        int i = it - N_AS; int qbi = i & 1, b = i >> 4; h = (i >> 1) & 7;
        tq0 = (long)b * 256 + qbi * 128; seq = 256;
        kp = p.kC + (long)b * 256 * 1024 + h * 128; vp = p.vC + (long)b * 256 * 1024 + h * 128;
      }
#ifndef DBG_NOATT
      attn_item(p, tq0, h, kp, vp, seq, smem);
#endif
    } else {
      int i = it - N_AS - N_AC;
      ssd_state_item(p, i >> 4, i & 15, smem);
    }
  }
}

__device__ void phase4(const Params& p, char* smem) {
  const int tid = threadIdx.x;
  for (int it = blockIdx.x; it < 256 + 1024; it += gridDim.x) {
    int seq, head, d, half, nc, c0; const float* h0p = nullptr; float* outp = nullptr;
    if (it < 256) { half = it & 1; d = (it >> 1) & 1; head = (it >> 2) & 15; int b = it >> 6; seq = 16 + b; nc = 32; c0 = 32 + b * 32;
      h0p = p.state_ssd + ((long)(b * 2 + d) * 16 + head) * 4096; }
    else { int i = it - 256; half = i & 1; d = (i >> 1) & 1; head = (i >> 2) & 15; int b = i >> 6; seq = b; nc = 2; c0 = b * 2;
      outp = p.out + 29360128L + ((long)(b * 2 + d) * 16 + head) * 4096; }
    (void)seq;
    const int e = half * 2048 + tid * 4;
    float h[4] = {0.f, 0.f, 0.f, 0.f};
    if (h0p) { float4 v = *reinterpret_cast<const float4*>(h0p + e); h[0] = v.x; h[1] = v.y; h[2] = v.z; h[3] = v.w; }
    for (int i = 0; i < nc; ++i) {
      int cgi = c0 + (d ? nc - 1 - i : i);
      u16* sp = p.st + ((long)(cgi * 16 + head) * 2 + d) * 4096 + e;
      float dec = p.cd[(cgi * 16 + head) * 2 + d];
      u32x2 sv = *reinterpret_cast<const u32x2*>(sp);
      u32x2 hw = {cvtpk(h[0], h[1]), cvtpk(h[2], h[3])};
      *reinterpret_cast<u32x2*>(sp) = hw;
      float s0 = __uint_as_float(sv[0] << 16), s1 = __uint_as_float(sv[0] & 0xffff0000u);
      float s2 = __uint_as_float(sv[1] << 16), s3 = __uint_as_float(sv[1] & 0xffff0000u);
      h[0] = h[0] * dec + s0; h[1] = h[1] * dec + s1; h[2] = h[2] * dec + s2; h[3] = h[3] * dec + s3;
    }
    if (outp) { float4 v = {h[0], h[1], h[2], h[3]}; *reinterpret_cast<float4*>(outp + e) = v; }
  }
}

__device__ void ssd_y_item(const Params& p, int cg, int head, char* smem) {
  const int tid = threadIdx.x, lane = tid & 63, wid = tid >> 6, fr = lane & 15, fq = lane >> 4;
  float* dtv = (float*)smem; float* cum = dtv + 256; float* scn = cum + 256; float* tot = scn + 256;
  float* Xf = (float*)(smem + 4096);
  u16* XdtT = (u16*)(smem + 4096 + 32768);
  u16* Cs = XdtT + 64 * 136;
  u16* Bs = Cs + 128 * 72;
  u16* Ms = Bs + 128 * 72;
  u16* Hs = Ms + 128 * 136;
  long tok_s; int L, tpos0; chunk_geom(cg, tok_s, L, tpos0);
  const long tok0 = (long)cg * 128;
  const int g = head >> 2;
  ssd_dt_scan(p, tok0, head, dtv, cum, scn, tot);
#pragma unroll
  for (int rep = 0; rep < 2; ++rep) {
    int id = tid + rep * NTHR; int tl = id >> 3, p0 = (id & 7) * 8;
    float xo[8], bo[8], co[8];
    conv8(p, tok_s, L, tpos0 + tl, head * 64 + p0, xo);
    conv8(p, tok_s, L, tpos0 + tl, 1024 + g * 64 + p0, bo);
    conv8(p, tok_s, L, tpos0 + tl, 1280 + g * 64 + p0, co);
#pragma unroll
    for (int e = 0; e < 8; ++e) Xf[tl * 64 + p0 + e] = xo[e];
    *reinterpret_cast<bf16x8*>(Bs + tl * 72 + p0) = pack8(bo);
    *reinterpret_cast<bf16x8*>(Cs + tl * 72 + p0) = pack8(co);
  }
  __syncthreads();
  f32x4 cb[8];
#pragma unroll
  for (int si = 0; si < 8; ++si) cb[si] = f32x4{0.f, 0.f, 0.f, 0.f};
#pragma unroll
  for (int ks = 0; ks < 2; ++ks) {
    bf16x8 a = *reinterpret_cast<const bf16x8*>(Cs + (wid * 16 + fr) * 72 + ks * 32 + fq * 8);
#pragma unroll
    for (int si = 0; si < 8; ++si) {
      bf16x8 b = *reinterpret_cast<const bf16x8*>(Bs + (si * 16 + fr) * 72 + ks * 32 + fq * 8);
      cb[si] = mfma16(a, b, cb[si]);
    }
  }
  f32x4 yacc[4];
#pragma unroll
  for (int pi = 0; pi < 4; ++pi) yacc[pi] = f32x4{0.f, 0.f, 0.f, 0.f};
#pragma unroll 1
  for (int d = 0; d < 2; ++d) {
#pragma unroll
    for (int rep = 0; rep < 2; ++rep) {
      int id = tid + rep * NTHR; int s = id >> 3, p0 = (id & 7) * 8;
      float dts = dtv[d * 128 + s];
#pragma unroll
      for (int e = 0; e < 8; ++e) XdtT[(p0 + e) * 136 + s] = f2bf(Xf[s * 64 + p0 + e] * dts);
    }
    {
      int pp = tid >> 3, ch = (tid & 7) * 8;
      const u16* src = p.st + ((long)(cg * 16 + head) * 2 + d) * 4096 + pp * 64 + ch;
      *reinterpret_cast<bf16x8*>(Hs + pp * 72 + ch) = *reinterpret_cast<const bf16x8*>(src);
    }
    float cq[4];
#pragma unroll
    for (int j = 0; j < 4; ++j) cq[j] = cum[d * 128 + wid * 16 + fq * 4 + j];
#pragma unroll
    for (int si = 0; si < 8; ++si) {
      int s = si * 16 + fr; float cs = cum[d * 128 + s];
#pragma unroll
      for (int j = 0; j < 4; ++j) {
        int q = wid * 16 + fq * 4 + j;
        bool keep = d ? (s >= q) : (s <= q);
        float v = keep ? cb[si][j] * __expf(cq[j] - cs) : 0.f;
        Ms[q * 136 + s] = f2bf(v);
      }
    }
    __syncthreads();
    f32x4 tmp[4];
#pragma unroll
    for (int pi = 0; pi < 4; ++pi) tmp[pi] = f32x4{0.f, 0.f, 0.f, 0.f};
#pragma unroll
    for (int ks = 0; ks < 4; ++ks) {
      bf16x8 a = *reinterpret_cast<const bf16x8*>(Ms + (wid * 16 + fr) * 136 + ks * 32 + fq * 8);
#pragma unroll
      for (int pi = 0; pi < 4; ++pi) {
        bf16x8 b = *reinterpret_cast<const bf16x8*>(XdtT + (pi * 16 + fr) * 136 + ks * 32 + fq * 8);
        yacc[pi] = mfma16(a, b, yacc[pi]);
      }
    }
#pragma unroll
    for (int ks = 0; ks < 2; ++ks) {
      bf16x8 a = *reinterpret_cast<const bf16x8*>(Cs + (wid * 16 + fr) * 72 + ks * 32 + fq * 8);
#pragma unroll
      for (int pi = 0; pi < 4; ++pi) {
        bf16x8 b = *reinterpret_cast<const bf16x8*>(Hs + (pi * 16 + fr) * 72 + ks * 32 + fq * 8);
        tmp[pi] = mfma16(a, b, tmp[pi]);
      }
    }
#pragma unroll
    for (int j = 0; j < 4; ++j) {
      float eq = __expf(cq[j]);
#pragma unroll
      for (int pi = 0; pi < 4; ++pi) yacc[pi][j] += eq * tmp[pi][j];
    }
    __syncthreads();
  }
  const float dsk = p.D_skip[head];
#pragma unroll
  for (int j = 0; j < 4; ++j) {
    int q = wid * 16 + fq * 4 + j;
    float ss = 0.f;
#pragma unroll
    for (int pi = 0; pi < 4; ++pi) {
      int pp = pi * 16 + fr;
      long idx = (tok0 + q) * 1024 + head * 64 + pp;
      float y = yacc[pi][j] + dsk * Xf[q * 64 + pp];
      float yg = y * bf2f(p.zb[idx]);
      p.zb[idx] = f2bf(yg);
      ss += yg * yg;
    }
    ss += __shfl_xor(ss, 1); ss += __shfl_xor(ss, 2); ss += __shfl_xor(ss, 4); ss += __shfl_xor(ss, 8);
    if (fr == 0) p.ssqp[(tok0 + q) * 16 + head] = ss;
  }
  __syncthreads();
}
__device__ void phase5(const Params& p, char* smem) {
  for (int it = blockIdx.x; it < 160 * 16; it += gridDim.x) ssd_y_item(p, it >> 4, it & 15, smem);
}

__device__ void phase6(const Params& p, char* smem) {
  const int tid = threadIdx.x, lane = tid & 63, wid = tid >> 6, wm = wid >> 1, wn = wid & 1, fr = lane & 15, fq = lane >> 4;
  for (int it = blockIdx.x; it < 80 * 8; it += gridDim.x) {
    const int mt = it >> 3, nt = it & 7;
    const int m0 = mt * 256, n0 = nt * 128;
    f32x4 acc[4][4];
#pragma unroll
    for (int mi = 0; mi < 4; ++mi)
#pragma unroll
      for (int ni = 0; ni < 4; ++ni) acc[mi][ni] = f32x4{0.f, 0.f, 0.f, 0.f};
    gemm_kloop(acc, p.zb + (long)m0 * 1024, 1024, p.woutT + (long)n0 * 2048 + 1024, 2048, 16, smem);
#pragma unroll
    for (int mi = 0; mi < 4; ++mi)
#pragma unroll
      for (int j = 0; j < 4; ++j) {
        int t = m0 + wm * 64 + mi * 16 + fq * 4 + j;
        const float4* sp = reinterpret_cast<const float4*>(p.ssqp + (long)t * 16);
        float4 a = sp[0], b = sp[1], c = sp[2], d = sp[3];
        float s = a.x + a.y + a.z + a.w + b.x + b.y + b.z + b.w + c.x + c.y + c.z + c.w + d.x + d.y + d.z + d.w;
        float r = rsqrtf(s * (1.f / 1024.f) + EPSF);
#pragma unroll
        for (int ni = 0; ni < 4; ++ni) acc[mi][ni][j] *= r;
      }
    gemm_kloop(acc, p.qb + (long)m0 * 1024, 1024, p.woutT + (long)n0 * 2048, 2048, 16, smem);
    const int mr = (m0 < T_CTX) ? 0 : 1 + ((m0 - T_CTX) >> 12);
#pragma unroll
    for (int mi = 0; mi < 4; ++mi)
#pragma unroll
      for (int j = 0; j < 4; ++j) {
        int t = m0 + wm * 64 + mi * 16 + fq * 4 + j;
        const float* xr = (t < T_CTX) ? p.x_prompt + (long)t * 1024 : p.x_sample + (long)(t - T_CTX) * 1024;
        float ss = 0.f;
#pragma unroll
        for (int ni = 0; ni < 4; ++ni) {
          int n = n0 + wn * 64 + ni * 16 + fr;
          float v = xr[n] + p.modv[mr * 3072 + 2048 + n] * acc[mi][ni][j];
          p.out[(long)t * 1024 + n] = v;
          ss += v * v;
        }
        ss += __shfl_xor(ss, 1); ss += __shfl_xor(ss, 2); ss += __shfl_xor(ss, 4); ss += __shfl_xor(ss, 8);
        if (fr == 0) p.ssq2p[(long)t * 16 + nt * 2 + wn] = ss;
      }
  }
}

__device__ void phase7(const Params& p, char* smem) {
  const int tid = threadIdx.x, lane = tid & 63, wid = tid >> 6;
  for (int it = blockIdx.x; it < T_ALL / 8; it += gridDim.x) {
    const int t = it * 8 + wid;
    float s = (lane < 16) ? p.ssq2p[(long)t * 16 + lane] : 0.f;
    s += __shfl_xor(s, 1); s += __shfl_xor(s, 2); s += __shfl_xor(s, 4); s += __shfl_xor(s, 8);
    s = __shfl(s, 0);
    const float rs = rsqrtf(s * (1.f / 1024.f) + EPSF);
    float* yr = p.out + (long)t * 1024;
#pragma unroll
    for (int i = 0; i < 4; ++i) {
      int col = i * 256 + lane * 4;
      float4 v = *reinterpret_cast<const float4*>(yr + col);
      float4 g = *reinterpret_cast<const float4*>(p.final_g + col);
      v.x *= rs * g.x; v.y *= rs * g.y; v.z *= rs * g.z; v.w *= rs * g.w;
      *reinterpret_cast<float4*>(yr + col) = v;
    }
  }
}

template <int PH> __device__ __forceinline__ void run_phase(const Params& p, char* smem) {
  if constexpr (PH == 0) phase0(p, smem);
  if constexpr (PH == 1) phase1(p, smem);
  if constexpr (PH == 2) phase2(p, smem);
  if constexpr (PH == 3) phase3(p, smem);
  if constexpr (PH == 4) phase4(p, smem);
  if constexpr (PH == 5) phase5(p, smem);
  if constexpr (PH == 6) phase6(p, smem);
  if constexpr (PH == 7) phase7(p, smem);
}

#if MK_COOP
__global__ void __launch_bounds__(NTHR) fwd_megakernel(Params p) {
  extern __shared__ __attribute__((aligned(16))) char smem[];
  cg::grid_group grid = cg::this_grid();
  phase0(p, smem); grid.sync();
  phase1(p, smem); grid.sync();
  phase2(p, smem); grid.sync();
  phase3(p, smem); grid.sync();
  phase4(p, smem); grid.sync();
  phase5(p, smem); grid.sync();
  phase6(p, smem); grid.sync();
  phase7(p, smem);
}
#else
template <int PH> __global__ void __launch_bounds__(NTHR) phase_kernel(Params p) {
  extern __shared__ __attribute__((aligned(16))) char smem[];
  run_phase<PH>(p, smem);
}
#endif

#ifndef XLAST
#define XLAST
#endif
#ifndef LAST_PHASE
#define LAST_PHASE 7
#endif
__global__ void dbg_copy(const uint4* __restrict__ src, uint4* __restrict__ dst, long n16) {
  for (long i = blockIdx.x * 256L + threadIdx.x; i < n16; i += gridDim.x * 256L) dst[i] = src[i];
}
extern "C" void kernel_launch(void* const* d_in, const int* in_sizes, int n_in, void* d_out, int out_size, void* d_ws, size_t ws_size,
                              hipStream_t stream) {
  Params p;
  memset(&p, 0, sizeof(p));
  const float* const* in = (const float* const*)d_in;
  p.x_prompt = in[0]; p.x_sample = in[1]; p.cache_k = in[2]; p.cache_v = in[3]; p.state_ssd = in[4]; p.c = in[5]; p.c_ctx = in[6];
  p.w_mod = in[7]; p.b_mod = in[8]; p.norm_g = in[9]; p.w_in = in[10]; p.lq1 = in[11]; p.lk1 = in[12]; p.lq2 = in[13]; p.lk2 = in[14];
  p.subln_g = in[15]; p.conv_w = in[16]; p.conv_b = in[17]; p.dt_bias = in[18]; p.A_log = in[19]; p.D_skip = in[20];
  p.ssd_norm_g = in[21]; p.w_out = in[22]; p.final_g = in[23];
  p.out = (float*)d_out;
  char* w = (char*)d_ws; size_t off = 0;
  auto take = [&](size_t bytes) { char* r = w + off; off += (bytes + 255) & ~(size_t)255; return r; };
  p.winT = (u16*)take((size_t)NPADW * 1024 * 2);
  p.woutT = (u16*)take((size_t)1024 * 2048 * 2);
  p.qb = (u16*)take((size_t)T_ALL * 1024 * 2);
  p.kC = (u16*)take((size_t)T_CTX * 1024 * 2);
  p.kS = (u16*)take((size_t)4 * 4608 * 1024 * 2);
  p.vC = (u16*)take((size_t)T_CTX * 1024 * 2);
  p.vS = (u16*)take((size_t)4 * 4608 * 1024 * 2);
  p.zb = (u16*)take((size_t)T_ALL * 1024 * 2);
  p.xbc = (u16*)take((size_t)T_ALL * 1536 * 2);
  p.dtb = (float*)take((size_t)T_ALL * 32 * 4);
  p.modv = (float*)take((size_t)5 * 3072 * 4);
  p.rope = (float*)take((size_t)64 * 16 * 2 * 4);
  p.misc = (float*)take(256);
  p.cd = (float*)take((size_t)160 * 16 * 2 * 4);
  p.ssqp = (float*)take((size_t)T_ALL * 16 * 4);
  p.ssq2p = (float*)take((size_t)T_ALL * 16 * 4);
  if (off > ws_size) { fprintf(stderr, "kernel_launch: workspace too small: need %zu have %zu\n", off, ws_size); return; }
  p.hb = (u16*)d_out;
  p.st = (u16*)d_out;
  p.gb = (u16*)d_out + (size_t)T_ALL * 1024;

#if MK_COOP
  static int grid_blocks = 0;
  if (!grid_blocks) {
    int dev = 0, cus = 0, per_cu = 0;
    hipGetDevice(&dev);
    hipDeviceGetAttribute(&cus, hipDeviceAttributeMultiprocessorCount, dev);
    hipFuncSetAttribute((const void*)fwd_megakernel, hipFuncAttributeMaxDynamicSharedMemorySize, LDS_BYTES);
    hipOccupancyMaxActiveBlocksPerMultiprocessor(&per_cu, (const void*)fwd_megakernel, NTHR, LDS_BYTES);
    if (per_cu < 1) per_cu = 1;
    grid_blocks = cus * per_cu;
  }
  void* args[] = {&p};
  hipError_t e = hipLaunchCooperativeKernel((const void*)fwd_megakernel, dim3(grid_blocks), dim3(NTHR), args, LDS_BYTES, stream);
  if (e != hipSuccess) fprintf(stderr, "cooperative launch failed: %s (grid %d)\n", hipGetErrorString(e), grid_blocks);
#else
  static int attr_done = 0;
  if (!attr_done) {
    hipFuncSetAttribute((const void*)phase_kernel<0>, hipFuncAttributeMaxDynamicSharedMemorySize, LDS_BYTES);
    hipFuncSetAttribute((const void*)phase_kernel<1>, hipFuncAttributeMaxDynamicSharedMemorySize, LDS_BYTES);
    hipFuncSetAttribute((const void*)phase_kernel<2>, hipFuncAttributeMaxDynamicSharedMemorySize, LDS_BYTES);
    hipFuncSetAttribute((const void*)phase_kernel<3>, hipFuncAttributeMaxDynamicSharedMemorySize, LDS_BYTES);
    hipFuncSetAttribute((const void*)phase_kernel<4>, hipFuncAttributeMaxDynamicSharedMemorySize, LDS_BYTES);
    hipFuncSetAttribute((const void*)phase_kernel<5>, hipFuncAttributeMaxDynamicSharedMemorySize, LDS_BYTES);
    hipFuncSetAttribute((const void*)phase_kernel<6>, hipFuncAttributeMaxDynamicSharedMemorySize, LDS_BYTES);
    hipFuncSetAttribute((const void*)phase_kernel<7>, hipFuncAttributeMaxDynamicSharedMemorySize, LDS_BYTES);
    attr_done = 1;
  }
  const int G = 256;
  if (LAST_PHASE >= 0) hipLaunchKernelGGL(phase_kernel<0>, dim3(G), dim3(NTHR), LDS_BYTES, stream, p);
  if (LAST_PHASE >= 1) hipLaunchKernelGGL(phase_kernel<1>, dim3(G), dim3(NTHR), LDS_BYTES, stream, p);
  if (LAST_PHASE >= 2) hipLaunchKernelGGL(phase_kernel<2>, dim3(G), dim3(NTHR), LDS_BYTES, stream, p);
  if (LAST_PHASE >= 3) hipLaunchKernelGGL(phase_kernel<3>, dim3(G), dim3(NTHR), LDS_BYTES, stream, p);
  if (LAST_PHASE >= 4) hipLaunchKernelGGL(phase_kernel<4>, dim3(G), dim3(NTHR), LDS_BYTES, stream, p);
  if (LAST_PHASE >= 5) hipLaunchKernelGGL(phase_kernel<5>, dim3(G), dim3(NTHR), LDS_BYTES, stream, p);
  if (LAST_PHASE >= 6) hipLaunchKernelGGL(phase_kernel<6>, dim3(G), dim3(NTHR), LDS_BYTES, stream, p);
  if (LAST_PHASE >= 7) hipLaunchKernelGGL(phase_kernel<7>, dim3(G), dim3(NTHR), LDS_BYTES, stream, p);
#if LAST_PHASE == 3
  hipLaunchKernelGGL(dbg_copy, dim3(1024), dim3(256), 0, stream, (const uint4*)p.qb, (uint4*)p.gb, (long)T_ALL * 1024 * 2 / 16);
#endif
#endif
}
```

```cpp
#include <hip/hip_runtime.h>
#include <hip/hip_cooperative_groups.h>
#include <cstdio>
#include <cstring>
#include <cstdint>
namespace cg = cooperative_groups;

#ifndef MK_COOP
#define MK_COOP 1
#endif

typedef unsigned short u16;
using bf16x8 = __attribute__((ext_vector_type(8))) short;
using s16x4  = __attribute__((ext_vector_type(4))) short;
using f32x4  = __attribute__((ext_vector_type(4))) float;
using f32x16 = __attribute__((ext_vector_type(16))) float;
using u32x4  = __attribute__((ext_vector_type(4))) unsigned;
using u32x2  = __attribute__((ext_vector_type(2))) unsigned;

constexpr int NTHR = 512;
constexpr int T_CTX = 4096, T_ALL = 20480;
constexpr int NPROJ = 6688, NPADW = 6784;
constexpr int LDS_BYTES = 135168;
constexpr float EPSF = 1e-6f;
constexpr float LAM_INIT = 0.2f;
#ifndef DBG_ST
#define DBG_ST 1
#endif

struct Params {
  const float *x_prompt, *x_sample, *cache_k, *cache_v, *state_ssd, *c, *c_ctx, *w_mod, *b_mod, *norm_g, *w_in,
      *lq1, *lk1, *lq2, *lk2, *subln_g, *conv_w, *conv_b, *dt_bias, *A_log, *D_skip, *ssd_norm_g, *w_out, *final_g;
  float* out;
  u16 *winT, *woutT, *qb, *kC, *kS, *vC, *vS, *zb, *xbc, *hb, *gb, *st;
  float *dtb, *modv, *rope, *misc, *cd, *ssqp, *ssq2p;
};

typedef __bf16 bf16v2 __attribute__((ext_vector_type(2)));
typedef float f32v2 __attribute__((ext_vector_type(2)));
__device__ __forceinline__ unsigned cvtpk(float lo, float hi) {
  f32v2 v = {lo, hi}; bf16v2 b = __builtin_convertvector(v, bf16v2); return __builtin_bit_cast(unsigned, b);
}
__device__ __forceinline__ u16 f2bf(float x) { __bf16 b = (__bf16)x; return __builtin_bit_cast(u16, b); }
__device__ __forceinline__ float bf2f(u16 x) { return __uint_as_float(((unsigned)x) << 16); }
__device__ __forceinline__ float bfs2f(short x) { return __uint_as_float(((unsigned)(u16)x) << 16); }
__device__ __forceinline__ float siluf(float v) { return v / (1.f + __expf(-v)); }
__device__ __forceinline__ bf16x8 pack8(const float* v) {
  u32x4 w = {cvtpk(v[0], v[1]), cvtpk(v[2], v[3]), cvtpk(v[4], v[5]), cvtpk(v[6], v[7])};
  return *reinterpret_cast<bf16x8*>(&w);
}
__device__ __forceinline__ f32x4 mfma16(bf16x8 a, bf16x8 b, f32x4 c) {
  return __builtin_amdgcn_mfma_f32_16x16x32_bf16(a, b, c, 0, 0, 0);
}

__device__ void p0_mod_item(const Params& p, int i, char* smem) {
  const int tid = threadIdx.x;
  float* sc = (float*)smem;
  float* red = sc + 5 * 1024;
  for (int idx = tid; idx < 5120; idx += NTHR) {
    int r = idx >> 10, k = idx & 1023;
    float v = (r == 0) ? p.c_ctx[k] : p.c[(r - 1) * 1024 + k];
    sc[idx] = v / (1.f + expf(-v));
  }
  __syncthreads();
  const int kq = tid >> 6, col = tid & 63, c0 = i * 64;
  float a0 = 0, a1 = 0, a2 = 0, a3 = 0, a4 = 0;
  const float* w = p.w_mod + (long)(kq * 128) * 3072 + c0 + col;
#pragma unroll 8
  for (int k = 0; k < 128; ++k) {
    float wv = w[(long)k * 3072];
    int kk = kq * 128 + k;
    a0 += sc[kk] * wv; a1 += sc[1024 + kk] * wv; a2 += sc[2048 + kk] * wv; a3 += sc[3072 + kk] * wv; a4 += sc[4096 + kk] * wv;
  }
  red[(kq * 5 + 0) * 64 + col] = a0; red[(kq * 5 + 1) * 64 + col] = a1; red[(kq * 5 + 2) * 64 + col] = a2;
  red[(kq * 5 + 3) * 64 + col] = a3; red[(kq * 5 + 4) * 64 + col] = a4;
  __syncthreads();
  if (tid < 320) {
    int r = tid >> 6, cc = tid & 63;
    float s = p.b_mod[c0 + cc];
    for (int q = 0; q < 8; ++q) s += red[(q * 5 + r) * 64 + cc];
    p.modv[r * 3072 + c0 + cc] = s;
  }
  if (i == 0 && tid == 511) {
    float s1 = 0, s2 = 0;
    for (int k = 0; k < 64; ++k) { s1 += p.lq1[k] * p.lk1[k]; s2 += p.lq2[k] * p.lk2[k]; }
    p.misc[0] = expf(s1) - expf(s2) + LAM_INIT;
  }
}

__device__ void p0_transpose_item(const float* __restrict__ src, int ldsrc, int nvalid, u16* __restrict__ dst, int lddst,
                                  int n0, int k0, const float* __restrict__ kscale, char* smem) {
  float* tile = (float*)smem;
  const int tid = threadIdx.x;
  {
    int r = tid >> 3, cc = (tid & 7) * 8;
    float sc = 1.f;
    if (kscale != nullptr && (k0 + r) >= 1024) sc = kscale[k0 + r - 1024];
#pragma unroll
    for (int e = 0; e < 8; ++e) {
      int n = n0 + cc + e;
      float v = (n < nvalid) ? src[(long)(k0 + r) * ldsrc + n] : 0.f;
      tile[r * 65 + cc + e] = v * sc;
    }
  }
  __syncthreads();
  {
    int n = tid >> 3, kk = (tid & 7) * 8;
    float v[8];
#pragma unroll
    for (int e = 0; e < 8; ++e) v[e] = tile[(kk + e) * 65 + n];
    *reinterpret_cast<bf16x8*>(dst + (long)(n0 + n) * lddst + k0 + kk) = pack8(v);
  }
}

__device__ void p0_rope_item(const Params& p) {
  const int tid = threadIdx.x;
  for (int idx = tid; idx < 1024; idx += NTHR) {
    int pos = idx >> 4, i = idx & 15;
    double inv = 1.0;
    for (int q = 0; q < i; ++q) inv *= 0.56234132519034908;
    double ang = (double)pos * inv;
    double kq = rint(ang * 0.63661977236758134);
    double r = ang - kq * 1.5707963267948966 - kq * 6.123233995736766e-17;
    double r2 = r * r;
    double s = r * (1.0 + r2 * (-1.0 / 6 + r2 * (1.0 / 120 + r2 * (-1.0 / 5040 + r2 * (1.0 / 362880 + r2 * (-1.0 / 39916800 + r2 * (1.0 / 6227020800.0 + r2 * (-1.0 / 1307674368000.0))))))));
    double cs = 1.0 + r2 * (-0.5 + r2 * (1.0 / 24 + r2 * (-1.0 / 720 + r2 * (1.0 / 40320 + r2 * (-1.0 / 3628800 + r2 * (1.0 / 479001600 + r2 * (-1.0 / 87178291200.0 + r2 * (1.0 / 20922789888000.0))))))));
    long kk = (long)kq; int qd = (int)(kk & 3);
    double so, co;
    if (qd == 0) { so = s; co = cs; } else if (qd == 1) { so = cs; co = -s; } else if (qd == 2) { so = -s; co = -cs; } else { so = -cs; co = s; }
    p.rope[idx * 2 + 0] = (float)co;
    p.rope[idx * 2 + 1] = (float)so;
  }
}

__device__ void phase0(const Params& p, char* smem) {
  constexpr int N_MOD = 48, N_WIN = 106 * 16, N_WOUT = 16 * 32, N_CACHE = 1024, N_ROPE = 1;
  constexpr int TOTAL = N_MOD + N_WIN + N_WOUT + N_CACHE + N_ROPE;
  const int tid = threadIdx.x;
  for (int it = blockIdx.x; it < TOTAL; it += gridDim.x) {
    int i = it;
    if (i < N_MOD) { p0_mod_item(p, i, smem); }
    else if ((i -= N_MOD) < N_WIN) {
      int nt = i >> 4, kt = i & 15;
      p0_transpose_item(p.w_in, NPROJ, NPROJ, p.winT, 1024, nt * 64, kt * 64, nullptr, smem);
    } else if ((i -= N_WIN) < N_WOUT) {
      int nt = i >> 5, kt = i & 31;
      p0_transpose_item(p.w_out, 1024, 1024, p.woutT, 2048, nt * 64, kt * 64, p.ssd_norm_g, smem);
    } else if ((i -= N_WOUT) < N_CACHE) {
      int tens = i >> 9, blk = i & 511;
      long e0 = (long)blk * 4096 + tid * 8;
      const float* src = (tens ? p.cache_v : p.cache_k) + e0;
      int b = (int)(e0 >> 19); long rem = e0 & ((1 << 19) - 1);
      u16* dst = (tens ? p.vS : p.kS) + ((long)b * 4608 + 4096) * 1024 + rem;
      float v[8];
      float4 x0 = *reinterpret_cast<const float4*>(src), x1 = *reinterpret_cast<const float4*>(src + 4);
      v[0] = x0.x; v[1] = x0.y; v[2] = x0.z; v[3] = x0.w; v[4] = x1.x; v[5] = x1.y; v[6] = x1.z; v[7] = x1.w;
      *reinterpret_cast<bf16x8*>(dst) = pack8(v);
    } else {
      p0_rope_item(p);
    }
    __syncthreads();
  }
}

__device__ void phase1(const Params& p, char* smem) {
  const int tid = threadIdx.x, lane = tid & 63, wid = tid >> 6;
  for (int it = blockIdx.x; it < T_ALL / 8; it += gridDim.x) {
    const int t = it * 8 + wid;
    const float* xr = (t < T_CTX) ? p.x_prompt + (long)t * 1024 : p.x_sample + (long)(t - T_CTX) * 1024;
    const int mr = (t < T_CTX) ? 0 : 1 + ((t - T_CTX) >> 12);
    float4 v[4]; float ss = 0;
#pragma unroll
    for (int i = 0; i < 4; ++i) {
      v[i] = *reinterpret_cast<const float4*>(xr + i * 256 + lane * 4);
      ss += v[i].x * v[i].x + v[i].y * v[i].y + v[i].z * v[i].z + v[i].w * v[i].w;
    }
#pragma unroll
    for (int o = 32; o >= 1; o >>= 1) ss += __shfl_xor(ss, o);
    const float rs = rsqrtf(ss * (1.f / 1024.f) + EPSF);
#pragma unroll
    for (int i = 0; i < 4; ++i) {
      int col = i * 256 + lane * 4;
      float4 g = *reinterpret_cast<const float4*>(p.norm_g + col);
      float4 sh = *reinterpret_cast<const float4*>(p.modv + mr * 3072 + col);
      float4 sc = *reinterpret_cast<const float4*>(p.modv + mr * 3072 + 1024 + col);
      float h0 = v[i].x * rs * g.x * (1.f + sc.x) + sh.x;
      float h1 = v[i].y * rs * g.y * (1.f + sc.y) + sh.y;
      float h2 = v[i].z * rs * g.z * (1.f + sc.z) + sh.z;
      float h3 = v[i].w * rs * g.w * (1.f + sc.w) + sh.w;
      u32x2 w = {cvtpk(h0, h1), cvtpk(h2, h3)};
      *reinterpret_cast<u32x2*>(p.hb + (long)t * 1024 + col) = w;
    }
  }
}

constexpr int G_LD = 72;
constexpr int G_ABYTES = 256 * G_LD * 2, G_BBYTES = 128 * G_LD * 2, G_STAGE = G_ABYTES + G_BBYTES;

__device__ __forceinline__ void gemm_kloop(f32x4 (&acc)[4][4], const u16* __restrict__ A, int lda,
                                           const u16* __restrict__ B, int ldb, int nk, char* smem) {
  const int tid = threadIdx.x, lane = tid & 63, wid = __builtin_amdgcn_readfirstlane(tid >> 6), wm = wid >> 1, wn = wid & 1, fr = lane & 15, fq = lane >> 4;
  bf16x8 ra[4], rb[2];
  const int lr = tid >> 3, lc = (tid & 7) * 8;
  __syncthreads();
#pragma unroll
  for (int i = 0; i < 4; ++i) ra[i] = *reinterpret_cast<const bf16x8*>(A + (long)(lr + i * 64) * lda + lc);
#pragma unroll
  for (int i = 0; i < 2; ++i) rb[i] = *reinterpret_cast<const bf16x8*>(B + (long)(lr + i * 64) * ldb + lc);
  {
    u16* As = (u16*)smem; u16* Bs = (u16*)(smem + G_ABYTES);
#pragma unroll
    for (int i = 0; i < 4; ++i) *reinterpret_cast<bf16x8*>(As + (lr + i * 64) * G_LD + lc) = ra[i];
#pragma unroll
    for (int i = 0; i < 2; ++i) *reinterpret_cast<bf16x8*>(Bs + (lr + i * 64) * G_LD + lc) = rb[i];
  }
  __syncthreads();
  for (int kt = 0; kt < nk; ++kt) {
    if (kt + 1 < nk) {
#pragma unroll
      for (int i = 0; i < 4; ++i) ra[i] = *reinterpret_cast<const bf16x8*>(A + (long)(lr + i * 64) * lda + (kt + 1) * 64 + lc);
#pragma unroll
      for (int i = 0; i < 2; ++i) rb[i] = *reinterpret_cast<const bf16x8*>(B + (long)(lr + i * 64) * ldb + (kt + 1) * 64 + lc);
    }
    const u16* As = (const u16*)(smem + (kt & 1) * G_STAGE);
    const u16* Bs = (const u16*)(smem + (kt & 1) * G_STAGE + G_ABYTES);
#pragma unroll
    for (int ks = 0; ks < 2; ++ks) {
      bf16x8 a[4], b[4];
#pragma unroll
      for (int mi = 0; mi < 4; ++mi) a[mi] = *reinterpret_cast<const bf16x8*>(As + (wm * 64 + mi * 16 + fr) * G_LD + ks * 32 + fq * 8);
#pragma unroll
      for (int ni = 0; ni < 4; ++ni) b[ni] = *reinterpret_cast<const bf16x8*>(Bs + (wn * 64 + ni * 16 + fr) * G_LD + ks * 32 + fq * 8);
#pragma unroll
      for (int mi = 0; mi < 4; ++mi)
#pragma unroll
        for (int ni = 0; ni < 4; ++ni) acc[mi][ni] = mfma16(a[mi], b[ni], acc[mi][ni]);
    }
    if (kt + 1 < nk) {
      u16* As2 = (u16*)(smem + ((kt + 1) & 1) * G_STAGE); u16* Bs2 = (u16*)(smem + ((kt + 1) & 1) * G_STAGE + G_ABYTES);
#pragma unroll
      for (int i = 0; i < 4; ++i) *reinterpret_cast<bf16x8*>(As2 + (lr + i * 64) * G_LD + lc) = ra[i];
#pragma unroll
      for (int i = 0; i < 2; ++i) *reinterpret_cast<bf16x8*>(Bs2 + (lr + i * 64) * G_LD + lc) = rb[i];
    }
    __syncthreads();
  }
}

__device__ void phase2(const Params& p, char* smem) {
  const int tid = threadIdx.x, lane = tid & 63, wid = __builtin_amdgcn_readfirstlane(tid >> 6), wm = wid >> 1, wn = wid & 1, fr = lane & 15, fq = lane >> 4;
  constexpr int NT_N = 53, NT_M = 80;
  for (int it = blockIdx.x; it < NT_M * NT_N; it += gridDim.x) {
    const int mt = it / NT_N, nt = it - mt * NT_N;
    const int m0 = mt * 256, n0 = nt * 128;
    f32x4 acc[4][4];
#pragma unroll
    for (int mi = 0; mi < 4; ++mi)
#pragma unroll
      for (int ni = 0; ni < 4; ++ni) acc[mi][ni] = f32x4{0.f, 0.f, 0.f, 0.f};
    gemm_kloop(acc, p.hb + (long)m0 * 1024, 1024, p.winT + (long)n0 * 1024, 1024, 16, smem);
    const bool is_ctx = (m0 < T_CTX);
    const int seg = (n0 < 5120) ? (n0 >> 10) : (n0 < 6656 ? 5 : 6);
    const int cw = n0 + wn * 64;
    if (!is_ctx && seg <= 1) {
#pragma unroll
      for (int mi = 0; mi < 4; ++mi)
#pragma unroll
        for (int j = 0; j < 4; ++j) {
          int t = m0 + wm * 64 + mi * 16 + fq * 4 + j;
          int tl = (t - T_CTX) & 4095;
          int rid = tl >> 6, cid = tl & 63;
          float2 cr = *reinterpret_cast<const float2*>(p.rope + (rid * 16 + fr) * 2);
          float2 cc = *reinterpret_cast<const float2*>(p.rope + (cid * 16 + fr) * 2);
          float x1 = acc[mi][0][j], x2 = acc[mi][1][j];
          acc[mi][0][j] = x1 * cr.x - x2 * cr.y; acc[mi][1][j] = x2 * cr.x + x1 * cr.y;
          x1 = acc[mi][2][j]; x2 = acc[mi][3][j];
          acc[mi][2][j] = x1 * cc.x - x2 * cc.y; acc[mi][3][j] = x2 * cc.x + x1 * cc.y;
        }
    }
#pragma unroll
    for (int mi = 0; mi < 4; ++mi)
#pragma unroll
      for (int j = 0; j < 4; ++j) {
        const int t = m0 + wm * 64 + mi * 16 + fq * 4 + j;
#pragma unroll
        for (int ni = 0; ni < 4; ++ni) {
          const int n = cw + ni * 16 + fr;
          const float v = acc[mi][ni][j];
          if (seg == 0) {
            p.qb[(long)t * 1024 + n] = f2bf(v);
          } else if (seg == 1 || seg == 2) {
            const int c = n - seg * 1024;
            if (is_ctx) {
              (seg == 1 ? p.kC : p.vC)[(long)t * 1024 + c] = f2bf(v);
              p.out[(seg == 1 ? 20971520L : 25165824L) + (long)t * 1024 + c] = v;
            } else {
              int ts = t - T_CTX; int b = ts >> 12, tl = ts & 4095;
              (seg == 1 ? p.kS : p.vS)[((long)b * 4608 + tl) * 1024 + c] = f2bf(v);
            }
          } else if (seg == 3) {
            p.gb[(long)t * 1024 + (n - 3072)] = f2bf(siluf(v));
          } else if (seg == 4) {
            p.zb[(long)t * 1024 + (n - 4096)] = f2bf(siluf(v));
          } else if (seg == 5) {
            p.xbc[(long)t * 1536 + (n - 5120)] = f2bf(v);
          } else {
            if (n < NPROJ) p.dtb[(long)t * 32 + (n - 6656)] = v;
          }
        }
      }
  }
}

constexpr int SHM_V = 64 * 128 * 2, SHM_K = 64 * 128 * 2;
constexpr float ASCALE = 0.125f;
constexpr float ATHR = 8.f;
#define KSWZ(row, colB) ((row) * 256 + ((colB) ^ (((row) & 7) << 4)))
#define SBAR() __builtin_amdgcn_sched_barrier(0)
__device__ __forceinline__ int crow(int r, int hi) { return (r & 3) + 8 * (r >> 2) + 4 * hi; }

__device__ __forceinline__ void partialSM(f32x16& p0, f32x16& p1, float& m_reg, float& mn, float& alpha) {
  constexpr float C = ASCALE * 1.4426950408889634f;
  float pmax = p0[0];
#pragma unroll
  for (int r = 1; r < 16; ++r) pmax = fmaxf(pmax, p0[r]);
#pragma unroll
  for (int r = 0; r < 16; ++r) pmax = fmaxf(pmax, p1[r]);
  { auto rr = __builtin_amdgcn_permlane32_swap(__float_as_uint(pmax), __float_as_uint(pmax), false, false);
    pmax = fmaxf(__uint_as_float(rr[0]), __uint_as_float(rr[1])); }
  if (__builtin_expect(__all(pmax - m_reg <= ATHR / ASCALE), 1)) { mn = m_reg; alpha = 1.f; }
  else { mn = fmaxf(m_reg, pmax); alpha = __builtin_amdgcn_exp2f((m_reg - mn) * C); m_reg = mn; }
  float mnC = -mn * C;
#pragma unroll
  for (int r = 0; r < 16; ++r) p0[r] = fmaf(p0[r], C, mnC);
#pragma unroll
  for (int r = 0; r < 16; ++r) p1[r] = fmaf(p1[r], C, mnC);
#pragma unroll
  for (int r = 0; r < 16; ++r) p0[r] = __builtin_amdgcn_exp2f(p0[r]);
}
__device__ __forceinline__ void finishSM(f32x16& p0, f32x16& p1, float alpha, float& l_reg, bf16x8& pa0, bf16x8& pa1, bf16x8& pa2, bf16x8& pa3) {
#pragma unroll
  for (int r = 0; r < 16; ++r) p1[r] = __builtin_amdgcn_exp2f(p1[r]);
  float ps = 0;
#pragma unroll
  for (int r = 0; r < 16; ++r) ps += p0[r];
#pragma unroll
  for (int r = 0; r < 16; ++r) ps += p1[r];
  { auto rr = __builtin_amdgcn_permlane32_swap(__float_as_uint(ps), __float_as_uint(ps), false, false);
    ps = __uint_as_float(rr[0]) + __uint_as_float(rr[1]); }
  l_reg = l_reg * alpha + ps;
#define PK4(P, BASE, OUT) do { unsigned a0 = cvtpk(P[BASE + 0], P[BASE + 1]), a1 = cvtpk(P[BASE + 2], P[BASE + 3]);   \
    unsigned b0 = cvtpk(P[BASE + 4], P[BASE + 5]), b1 = cvtpk(P[BASE + 6], P[BASE + 7]);                              \
    auto r0 = __builtin_amdgcn_permlane32_swap(a0, b0, false, false); auto r1 = __builtin_amdgcn_permlane32_swap(a1, b1, false, false); \
    u32x4 w = {r0[0], r1[0], r0[1], r1[1]}; OUT = *reinterpret_cast<bf16x8*>(&w); } while (0)
  PK4(p0, 0, pa0); PK4(p0, 8, pa1); PK4(p1, 0, pa2); PK4(p1, 8, pa3);
#undef PK4
}
__device__ __forceinline__ void qkt(f32x16& p0, f32x16& p1, const u16* Ks, const bf16x8* qr, int r32, int hi, int comp) {
  p0 = f32x16{}; p1 = f32x16{};
#pragma unroll
  for (int d0 = 0; d0 < 4; ++d0) { int cb = (comp * 64 + d0 * 16 + hi * 8) * 2;
    bf16x8 b0 = *reinterpret_cast<const bf16x8*>((const char*)Ks + KSWZ(r32, cb));
    bf16x8 b1 = *reinterpret_cast<const bf16x8*>((const char*)Ks + KSWZ(32 + r32, cb));
    p0 = __builtin_amdgcn_mfma_f32_32x32x16_bf16(b0, qr[d0], p0, 0, 0, 0);
    p1 = __builtin_amdgcn_mfma_f32_32x32x16_bf16(b1, qr[d0], p1, 0, 0, 0); }
}
__device__ __forceinline__ int v_st(int k, int c) { const int kk = (k & ~0xC) | ((k & 4) << 1) | ((k & 8) >> 1); return ((kk >> 3) * 4 + (c >> 5)) * 512 + ((kk & 7) * 32 + (c & 31)) * 2; }
__device__ __forceinline__ int v_rd_base(int lane) { return ((lane & 3) << 3) | (((lane >> 2) & 3) << 6) | (((lane >> 4) & 1) << 5) | (((lane >> 5) & 1) << 8); }
constexpr int v_rd_off(int d0, int ks, int half) { return d0 * 512 + ks * 4096 + half * 2048; }
template <int OFF> __device__ __forceinline__ s16x4 tr_read(int vb) {
  s16x4 r; asm volatile("ds_read_b64_tr_b16 %0, %1 offset:%2" : "=&v"(r) : "v"(vb), "i"(OFF) : "memory"); return r;
}
template <int D0> __device__ __forceinline__ void pv_one(f32x16& od, int vb, bf16x8 pa0, bf16x8 pa1, bf16x8 pa2, bf16x8 pa3) {
  const s16x4 l0 = tr_read<v_rd_off(D0, 0, 0)>(vb), h0 = tr_read<v_rd_off(D0, 0, 1)>(vb), l1 = tr_read<v_rd_off(D0, 1, 0)>(vb), h1 = tr_read<v_rd_off(D0, 1, 1)>(vb);
  const s16x4 l2 = tr_read<v_rd_off(D0, 2, 0)>(vb), h2 = tr_read<v_rd_off(D0, 2, 1)>(vb), l3 = tr_read<v_rd_off(D0, 3, 0)>(vb), h3 = tr_read<v_rd_off(D0, 3, 1)>(vb);
  asm volatile("s_waitcnt lgkmcnt(0)" ::: "memory"); SBAR();
#define PK(L, H) (bf16x8){L[0], L[1], L[2], L[3], H[0], H[1], H[2], H[3]}
  od = __builtin_amdgcn_mfma_f32_32x32x16_bf16(pa0, PK(l0, h0), od, 0, 0, 0);
  od = __builtin_amdgcn_mfma_f32_32x32x16_bf16(pa1, PK(l1, h1), od, 0, 0, 0);
  od = __builtin_amdgcn_mfma_f32_32x32x16_bf16(pa2, PK(l2, h2), od, 0, 0, 0);
  od = __builtin_amdgcn_mfma_f32_32x32x16_bf16(pa3, PK(l3, h3), od, 0, 0, 0);
#undef PK
}
__device__ __forceinline__ void pv_d0(f32x16* o, int vb, bf16x8 pa0, bf16x8 pa1, bf16x8 pa2, bf16x8 pa3) {
  pv_one<0>(o[0], vb, pa0, pa1, pa2, pa3); pv_one<1>(o[1], vb, pa0, pa1, pa2, pa3); pv_one<2>(o[2], vb, pa0, pa1, pa2, pa3); pv_one<3>(o[3], vb, pa0, pa1, pa2, pa3);
}

__device__ __forceinline__ void attn_item(const Params& p, long tq0, int h, const u16* __restrict__ Kh, const u16* __restrict__ Vh, int seq, char* lds) {
  constexpr int LDK = 1024;
  const int tid = threadIdx.x, wid = __builtin_amdgcn_readfirstlane(tid >> 6), lane = tid & 63, r32 = lane & 31, hi = lane >> 5;
  const int comp = wid >> 2, qg = wid & 3;
  u16* V_lds = (u16*)lds; u16* K_lds = (u16*)(lds + 2 * SHM_V);
  float* wsl = (float*)(lds + 2 * SHM_V + 2 * SHM_K) + wid * 64; float* li_l = wsl; float* al_l = wsl + 32;
  float m_reg = -1e30f, l_reg = 0; f32x16 o[4] = {}; bf16x8 qr[4];
  const u16* Qw = p.qb + (tq0 + qg * 32 + r32) * 1024 + h * 128 + comp * 64 + hi * 8;
#pragma unroll
  for (int d0 = 0; d0 < 4; ++d0) qr[d0] = *reinterpret_cast<const bf16x8*>(Qw + d0 * 16);
  const int sr = tid >> 4, sc = (tid & 15) * 8, vst0 = v_st(sr, sc), vst1 = v_st(32 + sr, sc);
  const int vb0 = (int)(uintptr_t)V_lds + v_rd_base(lane);
  constexpr int SDEPTH = 1;
  struct { bf16x8 vs0, vs1, ks0, ks1; } sr_[SDEPTH];
#define SLOAD(i, k0) do { sr_[i].vs0 = *reinterpret_cast<const bf16x8*>(&Vh[(long)((k0) + sr) * LDK + sc]); sr_[i].vs1 = *reinterpret_cast<const bf16x8*>(&Vh[(long)((k0) + 32 + sr) * LDK + sc]); \
    sr_[i].ks0 = *reinterpret_cast<const bf16x8*>(&Kh[(long)((k0) + sr) * LDK + sc]); sr_[i].ks1 = *reinterpret_cast<const bf16x8*>(&Kh[(long)((k0) + 32 + sr) * LDK + sc]); } while (0)
#define SWRITE(b, i) do { *(bf16x8*)((char*)V_lds + (b) * SHM_V + vst0) = sr_[i].vs0;          \
    *(bf16x8*)((char*)V_lds + (b) * SHM_V + vst1) = sr_[i].vs1; int kc = sc * 2;               \
    *(bf16x8*)((char*)K_lds + (b) * SHM_K + KSWZ(sr, kc)) = sr_[i].ks0;                       \
    *(bf16x8*)((char*)K_lds + (b) * SHM_K + KSWZ(32 + sr, kc)) = sr_[i].ks1; } while (0)
#define SWAIT() do { if constexpr (SDEPTH == 2) asm volatile("s_waitcnt vmcnt(4)" ::: "memory"); else asm volatile("s_waitcnt vmcnt(0)" ::: "memory"); } while (0)
#define RESC(a) do { if (__any((a) < 1.f)) { if (hi == 0) al_l[r32] = (a); asm volatile("s_waitcnt lgkmcnt(0)" ::: "memory"); \
    _Pragma("unroll") for (int d = 0; d < 4; ++d) _Pragma("unroll") for (int r = 0; r < 16; ++r) o[d][r] *= al_l[crow(r, hi)]; } } while (0)
  f32x16 pA0, pA1; float mnA, alA; bf16x8 pa0, pa1, pa2, pa3; const int NT = seq / 64;
  SLOAD(0, 0); asm volatile("s_waitcnt vmcnt(0)" ::: "memory"); SWRITE(0, 0); __syncthreads();
  for (int j = 0; j < NT; ++j) {
    const int cur = j & 1;
    if (j + 1 < NT) SLOAD(0, (j + 1) * 64);
    SBAR(); qkt(pA0, pA1, (u16*)((char*)K_lds + cur * SHM_K), qr, r32, hi, comp);
    partialSM(pA0, pA1, m_reg, mnA, alA);
    RESC(alA);
    finishSM(pA0, pA1, alA, l_reg, pa0, pa1, pa2, pa3); SBAR();
    pv_d0(o, vb0 + cur * (int)SHM_V, pa0, pa1, pa2, pa3);
    if (j + 1 < NT) { if (cur) SWRITE(0, 0); else SWRITE(1, 0); }
    __syncthreads();
  }
  if (hi == 0) li_l[r32] = l_reg; asm volatile("s_waitcnt lgkmcnt(0)" ::: "memory");
  float rli[16];
#pragma unroll
  for (int r = 0; r < 16; ++r) rli[r] = 1.f / li_l[crow(r, hi)];
#undef SLOAD
#undef SWRITE
#undef SWAIT
#undef RESC
  __syncthreads();
  float* ex = (float*)lds;
  const float lam = p.misc[0];
  if (comp == 1) {
#pragma unroll
    for (int d0 = 0; d0 < 4; ++d0)
#pragma unroll
      for (int r = 0; r < 16; ++r) ex[((qg * 4 + d0) * 16 + r) * 64 + lane] = o[d0][r] * rli[r] * lam;
  }
  __syncthreads();
  if (comp == 0) {
    float ssq[16];
#pragma unroll
    for (int r = 0; r < 16; ++r) ssq[r] = 0.f;
#pragma unroll
    for (int d0 = 0; d0 < 4; ++d0)
#pragma unroll
      for (int r = 0; r < 16; ++r) {
        float v = o[d0][r] * rli[r] - ex[((qg * 4 + d0) * 16 + r) * 64 + lane];
        o[d0][r] = v; ssq[r] += v * v;
      }
#pragma unroll
    for (int r = 0; r < 16; ++r) {
      float s = ssq[r];
      s += __shfl_xor(s, 1); s += __shfl_xor(s, 2); s += __shfl_xor(s, 4); s += __shfl_xor(s, 8); s += __shfl_xor(s, 16);
      ssq[r] = rsqrtf(s * (1.f / 128.f) + EPSF) * (1.f - LAM_INIT);
    }
    float sg[4];
#pragma unroll
    for (int d0 = 0; d0 < 4; ++d0) sg[d0] = p.subln_g[d0 * 32 + r32];
    const long base = (tq0 + qg * 32 + 4 * hi) * 1024 + h * 128 + r32;
    const u16* gp = p.gb + base; u16* qp = p.qb + base;
#pragma unroll
    for (int r = 0; r < 16; ++r) {
      const int ro = ((r & 3) + 8 * (r >> 2)) * 1024;
      float g0 = bf2f(gp[ro]), g1 = bf2f(gp[ro + 32]), g2 = bf2f(gp[ro + 64]), g3 = bf2f(gp[ro + 96]);
      qp[ro] = f2bf(o[0][r] * ssq[r] * sg[0] * g0);
      qp[ro + 32] = f2bf(o[1][r] * ssq[r] * sg[1] * g1);
      qp[ro + 64] = f2bf(o[2][r] * ssq[r] * sg[2] * g2);
      qp[ro + 96] = f2bf(o[3][r] * ssq[r] * sg[3] * g3);
      SBAR();
    }
  }
  __syncthreads();
}

__device__ __forceinline__ void conv8(const Params& p, long tok_s, int L, int tpos, int ch0, float (&o)[8]) {
  const u16* base = p.xbc + (tok_s + tpos) * 1536 + ch0;
  bf16x8 r1 = *reinterpret_cast<const bf16x8*>(base);
  bf16x8 r0 = {0, 0, 0, 0, 0, 0, 0, 0}, r2 = {0, 0, 0, 0, 0, 0, 0, 0};
  if (tpos > 0) r0 = *reinterpret_cast<const bf16x8*>(base - 1536);
  if (tpos < L - 1) r2 = *reinterpret_cast<const bf16x8*>(base + 1536);
  const float* w = p.conv_w + ch0;
  const float* bb = p.conv_b + ch0;
#pragma unroll
  for (int e = 0; e < 8; ++e) {
    float v = bb[e] + w[e] * bfs2f(r0[e]) + w[1536 + e] * bfs2f(r1[e]) + w[3072 + e] * bfs2f(r2[e]);
    o[e] = siluf(v);
  }
}
__device__ __forceinline__ void chunk_geom(int cg, long& tok_s, int& L, int& tpos0) {
  if (cg < 32) { tok_s = (long)(cg >> 1) * 256; L = 256; tpos0 = (cg & 1) * 128; }
  else { int cs = cg - 32; tok_s = T_CTX + (long)(cs >> 5) * 4096; L = 4096; tpos0 = (cs & 31) * 128; }
}
__device__ __forceinline__ void ssd_dt_scan(const Params& p, long tok0, int head, float* dtv, float* cum, float* scn, float* tot) {
  const int tid = threadIdx.x, lane = tid & 63, wid = tid >> 6;
  if (tid < 256) {
    int d = tid >> 7, tl = tid & 127;
    float raw = p.dtb[(tok0 + tl) * 32 + d * 16 + head] + p.dt_bias[d * 16 + head];
    float dt = (raw > 20.f) ? raw : log1pf(expf(raw));
    float a = -expf(p.A_log[d * 16 + head]) * dt;
    dtv[d * 128 + tl] = dt;
    int li = d ? 127 - tl : tl;
    scn[d * 128 + li] = a;
  }
  __syncthreads();
  if (wid < 2) {
    int d = wid;
    float a0 = scn[d * 128 + 2 * lane], a1 = scn[d * 128 + 2 * lane + 1];
    float s = a0 + a1;
#pragma unroll
    for (int off = 1; off < 64; off <<= 1) { float t = __shfl_up(s, off); if (lane >= off) s += t; }
    float c0 = s - a1, c1 = s;
    int li0 = 2 * lane, li1 = 2 * lane + 1;
    cum[d * 128 + (d ? 127 - li0 : li0)] = c0;
    cum[d * 128 + (d ? 127 - li1 : li1)] = c1;
    if (lane == 63) tot[d] = c1;
  }
  __syncthreads();
}

__device__ void ssd_state_item(const Params& p, int cg, int head, char* smem) {
  const int tid = threadIdx.x, lane = tid & 63, wid = tid >> 6, fr = lane & 15, fq = lane >> 4;
  float* dtv = (float*)smem; float* cum = dtv + 256; float* scn = cum + 256; float* tot = scn + 256;
  u16* XsT = (u16*)(smem + 4096);
  u16* BT = XsT + 2 * 64 * 136;
  long tok_s; int L, tpos0; chunk_geom(cg, tok_s, L, tpos0);
  const long tok0 = (long)cg * 128;
  const int g = head >> 2;
  ssd_dt_scan(p, tok0, head, dtv, cum, scn, tot);
  const float tot0 = tot[0], tot1 = tot[1];
#pragma unroll
  for (int rep = 0; rep < 2; ++rep) {
    int id = tid + rep * NTHR; int tl = id >> 3, p0 = (id & 7) * 8;
    float xo[8], bo[8];
    conv8(p, tok_s, L, tpos0 + tl, head * 64 + p0, xo);
    conv8(p, tok_s, L, tpos0 + tl, 1024 + g * 64 + p0, bo);
    float s0 = dtv[tl] * __expf(tot0 - cum[tl]);
    float s1 = dtv[128 + tl] * __expf(tot1 - cum[128 + tl]);
#pragma unroll
    for (int e = 0; e < 8; ++e) {
      XsT[(p0 + e) * 136 + tl] = f2bf(xo[e] * s0);
      XsT[(64 + p0 + e) * 136 + tl] = f2bf(xo[e] * s1);
      BT[(p0 + e) * 136 + tl] = f2bf(bo[e]);
    }
  }
  __syncthreads();
  {
    const int d = wid >> 2, pb = wid & 3;
    f32x4 acc[4];
#pragma unroll
    for (int ni = 0; ni < 4; ++ni) acc[ni] = f32x4{0.f, 0.f, 0.f, 0.f};
#pragma unroll
    for (int ks = 0; ks < 4; ++ks) {
      bf16x8 a = *reinterpret_cast<const bf16x8*>(XsT + (d * 64 + pb * 16 + fr) * 136 + ks * 32 + fq * 8);
#pragma unroll
      for (int ni = 0; ni < 4; ++ni) {
        bf16x8 b = *reinterpret_cast<const bf16x8*>(BT + (ni * 16 + fr) * 136 + ks * 32 + fq * 8);
        acc[ni] = mfma16(a, b, acc[ni]);
      }
    }
    u16* dst = p.st + ((long)(cg * 16 + head) * 2 + d) * 4096;
#pragma unroll
    for (int ni = 0; ni < 4; ++ni)
#pragma unroll
      for (int j = 0; j < 4; ++j) dst[(pb * 16 + fq * 4 + j) * 64 + ni * 16 + fr] = f2bf(acc[ni][j]);
  }
  if (tid < 2) p.cd[(cg * 16 + head) * 2 + tid] = __expf(tot[tid]);
  __syncthreads();
}

__device__ void phase3(const Params& p, char* smem) {
  constexpr int N_AS = 1024, N_AC = 256, N_ST = 160 * 16;
  for (int it = blockIdx.x; it < N_AS + N_AC + N_ST * DBG_ST; it += gridDim.x) {
    if (it < N_AS + N_AC) {
      long tq0; int h, seq; const u16 *kp, *vp;
      if (it < N_AS) {
        int qbi = it & 31, b = it >> 8; h = (it >> 5) & 7;
        tq0 = T_CTX + (long)b * 4096 + qbi * 128; seq = 4608;
        kp = p.kS + (long)b * 4608 * 1024 + h * 128; vp = p.vS + (long)b * 4608 * 1024 + h * 128;
      } else {
        int i = it - N_AS; int qbi = i & 1, b = i >> 4; h = (i >> 1) & 7;
        tq0 = (long)b * 256 + qbi * 128; seq = 256;
        kp = p.kC + (long)b * 256 * 1024 + h * 128; vp = p.vC + (long)b * 256 * 1024 + h * 128;
      }
#ifndef DBG_NOATT
      attn_item(p, tq0, h, kp, vp, seq, smem);
#endif
    } else {
      int i = it - N_AS - N_AC;
      ssd_state_item(p, i >> 4, i & 15, smem);
    }
  }
}

__device__ void phase4(const Params& p, char* smem) {
  const int tid = threadIdx.x;
  for (int it = blockIdx.x; it < 256 + 1024; it += gridDim.x) {
    int seq, head, d, half, nc, c0; const float* h0p = nullptr; float* outp = nullptr;
    if (it < 256) { half = it & 1; d = (it >> 1) & 1; head = (it >> 2) & 15; int b = it >> 6; seq = 16 + b; nc = 32; c0 = 32 + b * 32;
      h0p = p.state_ssd + ((long)(b * 2 + d) * 16 + head) * 4096; }
    else { int i = it - 256; half = i & 1; d = (i >> 1) & 1; head = (i >> 2) & 15; int b = i >> 6; seq = b; nc = 2; c0 = b * 2;
      outp = p.out + 29360128L + ((long)(b * 2 + d) * 16 + head) * 4096; }
    (void)seq;
    const int e = half * 2048 + tid * 4;
    float h[4] = {0.f, 0.f, 0.f, 0.f};
    if (h0p) { float4 v = *reinterpret_cast<const float4*>(h0p + e); h[0] = v.x; h[1] = v.y; h[2] = v.z; h[3] = v.w; }
    for (int i = 0; i < nc; ++i) {
      int cgi = c0 + (d ? nc - 1 - i : i);
      u16* sp = p.st + ((long)(cgi * 16 + head) * 2 + d) * 4096 + e;
      float dec = p.cd[(cgi * 16 + head) * 2 + d];
      u32x2 sv = *reinterpret_cast<const u32x2*>(sp);
      u32x2 hw = {cvtpk(h[0], h[1]), cvtpk(h[2], h[3])};
      *reinterpret_cast<u32x2*>(sp) = hw;
      float s0 = __uint_as_float(sv[0] << 16), s1 = __uint_as_float(sv[0] & 0xffff0000u);
      float s2 = __uint_as_float(sv[1] << 16), s3 = __uint_as_float(sv[1] & 0xffff0000u);
      h[0] = h[0] * dec + s0; h[1] = h[1] * dec + s1; h[2] = h[2] * dec + s2; h[3] = h[3] * dec + s3;
    }
    if (outp) { float4 v = {h[0], h[1], h[2], h[3]}; *reinterpret_cast<float4*>(outp + e) = v; }
  }
}

__device__ void ssd_y_item(const Params& p, int cg, int head, char* smem) {
  const int tid = threadIdx.x, lane = tid & 63, wid = tid >> 6, fr = lane & 15, fq = lane >> 4;
  float* dtv = (float*)smem; float* cum = dtv + 256; float* scn = cum + 256; float* tot = scn + 256;
  float* Xf = (float*)(smem + 4096);
  u16* XdtT = (u16*)(smem + 4096 + 32768);
  u16* Cs = XdtT + 64 * 136;
  u16* Bs = Cs + 128 * 72;
  u16* Ms = Bs + 128 * 72;
  u16* Hs = Ms + 128 * 136;
  long tok_s; int L, tpos0; chunk_geom(cg, tok_s, L, tpos0);
  const long tok0 = (long)cg * 128;
  const int g = head >> 2;
  ssd_dt_scan(p, tok0, head, dtv, cum, scn, tot);
#pragma unroll
  for (int rep = 0; rep < 2; ++rep) {
    int id = tid + rep * NTHR; int tl = id >> 3, p0 = (id & 7) * 8;
    float xo[8], bo[8], co[8];
    conv8(p, tok_s, L, tpos0 + tl, head * 64 + p0, xo);
    conv8(p, tok_s, L, tpos0 + tl, 1024 + g * 64 + p0, bo);
    conv8(p, tok_s, L, tpos0 + tl, 1280 + g * 64 + p0, co);
#pragma unroll
    for (int e = 0; e < 8; ++e) Xf[tl * 64 + p0 + e] = xo[e];
    *reinterpret_cast<bf16x8*>(Bs + tl * 72 + p0) = pack8(bo);
    *reinterpret_cast<bf16x8*>(Cs + tl * 72 + p0) = pack8(co);
  }
  __syncthreads();
  f32x4 cb[8];
#pragma unroll
  for (int si = 0; si < 8; ++si) cb[si] = f32x4{0.f, 0.f, 0.f, 0.f};
#pragma unroll
  for (int ks = 0; ks < 2; ++ks) {
    bf16x8 a = *reinterpret_cast<const bf16x8*>(Cs + (wid * 16 + fr) * 72 + ks * 32 + fq * 8);
#pragma unroll
    for (int si = 0; si < 8; ++si) {
      bf16x8 b = *reinterpret_cast<const bf16x8*>(Bs + (si * 16 + fr) * 72 + ks * 32 + fq * 8);
      cb[si] = mfma16(a, b, cb[si]);
    }
  }
  f32x4 yacc[4];
#pragma unroll
  for (int pi = 0; pi < 4; ++pi) yacc[pi] = f32x4{0.f, 0.f, 0.f, 0.f};
#pragma unroll 1
  for (int d = 0; d < 2; ++d) {
#pragma unroll
    for (int rep = 0; rep < 2; ++rep) {
      int id = tid + rep * NTHR; int s = id >> 3, p0 = (id & 7) * 8;
      float dts = dtv[d * 128 + s];
#pragma unroll
      for (int e = 0; e < 8; ++e) XdtT[(p0 + e) * 136 + s] = f2bf(Xf[s * 64 + p0 + e] * dts);
    }
    {
      int pp = tid >> 3, ch = (tid & 7) * 8;
      const u16* src = p.st + ((long)(cg * 16 + head) * 2 + d) * 4096 + pp * 64 + ch;
      *reinterpret_cast<bf16x8*>(Hs + pp * 72 + ch) = *reinterpret_cast<const bf16x8*>(src);
    }
    float cq[4];
#pragma unroll
    for (int j = 0; j < 4; ++j) cq[j] = cum[d * 128 + wid * 16 + fq * 4 + j];
#pragma unroll
    for (int si = 0; si < 8; ++si) {
      int s = si * 16 + fr; float cs = cum[d * 128 + s];
#pragma unroll
      for (int j = 0; j < 4; ++j) {
        int q = wid * 16 + fq * 4 + j;
        bool keep = d ? (s >= q) : (s <= q);
        float v = keep ? cb[si][j] * __expf(cq[j] - cs) : 0.f;
        Ms[q * 136 + s] = f2bf(v);
      }
    }
    __syncthreads();
    f32x4 tmp[4];
#pragma unroll
    for (int pi = 0; pi < 4; ++pi) tmp[pi] = f32x4{0.f, 0.f, 0.f, 0.f};
#pragma unroll
    for (int ks = 0; ks < 4; ++ks) {
      bf16x8 a = *reinterpret_cast<const bf16x8*>(Ms + (wid * 16 + fr) * 136 + ks * 32 + fq * 8);
#pragma unroll
      for (int pi = 0; pi < 4; ++pi) {
        bf16x8 b = *reinterpret_cast<const bf16x8*>(XdtT + (pi * 16 + fr) * 136 + ks * 32 + fq * 8);
        yacc[pi] = mfma16(a, b, yacc[pi]);
      }
    }
#pragma unroll
    for (int ks = 0; ks < 2; ++ks) {
      bf16x8 a = *reinterpret_cast<const bf16x8*>(Cs + (wid * 16 + fr) * 72 + ks * 32 + fq * 8);
#pragma unroll
      for (int pi = 0; pi < 4; ++pi) {
        bf16x8 b = *reinterpret_cast<const bf16x8*>(Hs + (pi * 16 + fr) * 72 + ks * 32 + fq * 8);
        tmp[pi] = mfma16(a, b, tmp[pi]);
      }
    }
#pragma unroll
    for (int j = 0; j < 4; ++j) {
      float eq = __expf(cq[j]);
#pragma unroll
      for (int pi = 0; pi < 4; ++pi) yacc[pi][j] += eq * tmp[pi][j];
    }
    __syncthreads();
  }
  const float dsk = p.D_skip[head];
#pragma unroll
  for (int j = 0; j < 4; ++j) {
    int q = wid * 16 + fq * 4 + j;
    float ss = 0.f;
#pragma unroll
    for (int pi = 0; pi < 4; ++pi) {
      int pp = pi * 16 + fr;
      long idx = (tok0 + q) * 1024 + head * 64 + pp;
      float y = yacc[pi][j] + dsk * Xf[q * 64 + pp];
      float yg = y * bf2f(p.zb[idx]);
      p.zb[idx] = f2bf(yg);
      ss += yg * yg;
    }
    ss += __shfl_xor(ss, 1); ss += __shfl_xor(ss, 2); ss += __shfl_xor(ss, 4); ss += __shfl_xor(ss, 8);
    if (fr == 0) p.ssqp[(tok0 + q) * 16 + head] = ss;
  }
  __syncthreads();
}
__device__ void phase5(const Params& p, char* smem) {
  for (int it = blockIdx.x; it < 160 * 16; it += gridDim.x) ssd_y_item(p, it >> 4, it & 15, smem);
}

__device__ void phase6(const Params& p, char* smem) {
  const int tid = threadIdx.x, lane = tid & 63, wid = __builtin_amdgcn_readfirstlane(tid >> 6), wm = wid >> 1, wn = wid & 1, fr = lane & 15, fq = lane >> 4;
  for (int it = blockIdx.x; it < 80 * 8; it += gridDim.x) {
    const int mt = it >> 3, nt = it & 7;
    const int m0 = mt * 256, n0 = nt * 128;
    f32x4 acc[4][4];
#pragma unroll
    for (int mi = 0; mi < 4; ++mi)
#pragma unroll
      for (int ni = 0; ni < 4; ++ni) acc[mi][ni] = f32x4{0.f, 0.f, 0.f, 0.f};
    gemm_kloop(acc, p.zb + (long)m0 * 1024, 1024, p.woutT + (long)n0 * 2048 + 1024, 2048, 16, smem);
    {
      const float* sq = p.ssqp + (long)m0 * 16;
      const int rl0 = wm * 64 + fq * 4;
#pragma unroll
      for (int mi = 0; mi < 4; ++mi)
#pragma unroll
        for (int j = 0; j < 4; ++j) {
          const float4* sp = reinterpret_cast<const float4*>(sq + (rl0 + mi * 16 + j) * 16);
          float4 a = sp[0], b = sp[1], c = sp[2], d = sp[3];
          float s = a.x + a.y + a.z + a.w + b.x + b.y + b.z + b.w + c.x + c.y + c.z + c.w + d.x + d.y + d.z + d.w;
          float r = rsqrtf(s * (1.f / 1024.f) + EPSF);
#pragma unroll
          for (int ni = 0; ni < 4; ++ni) acc[mi][ni][j] *= r;
        }
    }
    gemm_kloop(acc, p.qb + (long)m0 * 1024, 1024, p.woutT + (long)n0 * 2048, 2048, 16, smem);
    const int mr = (m0 < T_CTX) ? 0 : 1 + ((m0 - T_CTX) >> 12);
    const float* xb = (m0 < T_CTX) ? p.x_prompt + (long)m0 * 1024 : p.x_sample + (long)(m0 - T_CTX) * 1024;
    float* ob = p.out + (long)m0 * 1024;
    float* s2 = p.ssq2p + (long)m0 * 16 + nt * 2 + wn;
    const float* gp = p.modv + mr * 3072 + 2048 + n0 + wn * 64 + fr;
    const float gt0 = gp[0], gt1 = gp[16], gt2 = gp[32], gt3 = gp[48];
    const int cbase = (wm * 64 + fq * 4) * 1024 + n0 + wn * 64 + fr;
#pragma unroll
    for (int mi = 0; mi < 4; ++mi)
#pragma unroll
      for (int j = 0; j < 4; ++j) {
        const int o = cbase + (mi * 16 + j) * 1024;
        float v0 = xb[o] + gt0 * acc[mi][0][j];
        float v1 = xb[o + 16] + gt1 * acc[mi][1][j];
        float v2 = xb[o + 32] + gt2 * acc[mi][2][j];
        float v3 = xb[o + 48] + gt3 * acc[mi][3][j];
        ob[o] = v0; ob[o + 16] = v1; ob[o + 32] = v2; ob[o + 48] = v3;
        float ss = v0 * v0 + v1 * v1 + v2 * v2 + v3 * v3;
        ss += __shfl_xor(ss, 1); ss += __shfl_xor(ss, 2); ss += __shfl_xor(ss, 4); ss += __shfl_xor(ss, 8);
        if (fr == 0) s2[(wm * 64 + fq * 4 + mi * 16 + j) * 16] = ss;
      }
  }
}

__device__ void phase7(const Params& p, char* smem) {
  const int tid = threadIdx.x, lane = tid & 63, wid = tid >> 6;
  for (int it = blockIdx.x; it < T_ALL / 8; it += gridDim.x) {
    const int t = it * 8 + wid;
    float s = (lane < 16) ? p.ssq2p[(long)t * 16 + lane] : 0.f;
    s += __shfl_xor(s, 1); s += __shfl_xor(s, 2); s += __shfl_xor(s, 4); s += __shfl_xor(s, 8);
    s = __shfl(s, 0);
    const float rs = rsqrtf(s * (1.f / 1024.f) + EPSF);
    float* yr = p.out + (long)t * 1024;
#pragma unroll
    for (int i = 0; i < 4; ++i) {
      int col = i * 256 + lane * 4;
      float4 v = *reinterpret_cast<const float4*>(yr + col);
      float4 g = *reinterpret_cast<const float4*>(p.final_g + col);
      v.x *= rs * g.x; v.y *= rs * g.y; v.z *= rs * g.z; v.w *= rs * g.w;
      *reinterpret_cast<float4*>(yr + col) = v;
    }
  }
}

template <int PH> __device__ __forceinline__ void run_phase(const Params& p, char* smem) {
  if constexpr (PH == 0) phase0(p, smem);
  if constexpr (PH == 1) phase1(p, smem);
  if constexpr (PH == 2) phase2(p, smem);
  if constexpr (PH == 3) phase3(p, smem);
  if constexpr (PH == 4) phase4(p, smem);
  if constexpr (PH == 5) phase5(p, smem);
  if constexpr (PH == 6) phase6(p, smem);
  if constexpr (PH == 7) phase7(p, smem);
}

#if MK_COOP
__global__ void __launch_bounds__(NTHR) fwd_megakernel(Params p) {
  extern __shared__ __attribute__((aligned(16))) char smem[];
  cg::grid_group grid = cg::this_grid();
  phase0(p, smem); grid.sync();
  phase1(p, smem); grid.sync();
  phase2(p, smem); grid.sync();
  phase3(p, smem); grid.sync();
  phase4(p, smem); grid.sync();
  phase5(p, smem); grid.sync();
  phase6(p, smem); grid.sync();
  phase7(p, smem);
}
#else
template <int PH> __global__ void __launch_bounds__(NTHR) phase_kernel(Params p) {
  extern __shared__ __attribute__((aligned(16))) char smem[];
  run_phase<PH>(p, smem);
}
#endif

#ifndef XLAST
#define XLAST
#endif
#ifndef LAST_PHASE
#define LAST_PHASE 7
#endif
__global__ void dbg_copy(const uint4* __restrict__ src, uint4* __restrict__ dst, long n16) {
  for (long i = blockIdx.x * 256L + threadIdx.x; i < n16; i += gridDim.x * 256L) dst[i] = src[i];
}
extern "C" void kernel_launch(void* const* d_in, const int* in_sizes, int n_in, void* d_out, int out_size, void* d_ws, size_t ws_size,
                              hipStream_t stream) {
  Params p;
  memset(&p, 0, sizeof(p));
  const float* const* in = (const float* const*)d_in;
  p.x_prompt = in[0]; p.x_sample = in[1]; p.cache_k = in[2]; p.cache_v = in[3]; p.state_ssd = in[4]; p.c = in[5]; p.c_ctx = in[6];
  p.w_mod = in[7]; p.b_mod = in[8]; p.norm_g = in[9]; p.w_in = in[10]; p.lq1 = in[11]; p.lk1 = in[12]; p.lq2 = in[13]; p.lk2 = in[14];
  p.subln_g = in[15]; p.conv_w = in[16]; p.conv_b = in[17]; p.dt_bias = in[18]; p.A_log = in[19]; p.D_skip = in[20];
  p.ssd_norm_g = in[21]; p.w_out = in[22]; p.final_g = in[23];
  p.out = (float*)d_out;
  char* w = (char*)d_ws; size_t off = 0;
  auto take = [&](size_t bytes) { char* r = w + off; off += (bytes + 255) & ~(size_t)255; return r; };
  p.winT = (u16*)take((size_t)NPADW * 1024 * 2);
  p.woutT = (u16*)take((size_t)1024 * 2048 * 2);
  p.qb = (u16*)take((size_t)T_ALL * 1024 * 2);
  p.kC = (u16*)take((size_t)T_CTX * 1024 * 2);
  p.kS = (u16*)take((size_t)4 * 4608 * 1024 * 2);
  p.vC = (u16*)take((size_t)T_CTX * 1024 * 2);
  p.vS = (u16*)take((size_t)4 * 4608 * 1024 * 2);
  p.zb = (u16*)take((size_t)T_ALL * 1024 * 2);
  p.xbc = (u16*)take((size_t)T_ALL * 1536 * 2);
  p.dtb = (float*)take((size_t)T_ALL * 32 * 4);
  p.modv = (float*)take((size_t)5 * 3072 * 4);
  p.rope = (float*)take((size_t)64 * 16 * 2 * 4);
  p.misc = (float*)take(256);
  p.cd = (float*)take((size_t)160 * 16 * 2 * 4);
  p.ssqp = (float*)take((size_t)T_ALL * 16 * 4);
  p.ssq2p = (float*)take((size_t)T_ALL * 16 * 4);
  if (off > ws_size) { fprintf(stderr, "kernel_launch: workspace too small: need %zu have %zu\n", off, ws_size); return; }
  p.hb = (u16*)d_out;
  p.st = (u16*)d_out;
  p.gb = (u16*)d_out + (size_t)T_ALL * 1024;

#if MK_COOP
  static int grid_blocks = 0;
  if (!grid_blocks) {
    int dev = 0, cus = 0, per_cu = 0;
    hipGetDevice(&dev);
    hipDeviceGetAttribute(&cus, hipDeviceAttributeMultiprocessorCount, dev);
    hipFuncSetAttribute((const void*)fwd_megakernel, hipFuncAttributeMaxDynamicSharedMemorySize, LDS_BYTES);
    hipOccupancyMaxActiveBlocksPerMultiprocessor(&per_cu, (const void*)fwd_megakernel, NTHR, LDS_BYTES);
    if (per_cu < 1) per_cu = 1;
    grid_blocks = cus * per_cu;
  }
  void* args[] = {&p};
  hipError_t e = hipLaunchCooperativeKernel((const void*)fwd_megakernel, dim3(grid_blocks), dim3(NTHR), args, LDS_BYTES, stream);
  if (e != hipSuccess) fprintf(stderr, "cooperative launch failed: %s (grid %d)\n", hipGetErrorString(e), grid_blocks);
#else
  static int attr_done = 0;
  if (!attr_done) {
    hipFuncSetAttribute((const void*)phase_kernel<0>, hipFuncAttributeMaxDynamicSharedMemorySize, LDS_BYTES);
    hipFuncSetAttribute((const void*)phase_kernel<1>, hipFuncAttributeMaxDynamicSharedMemorySize, LDS_BYTES);
    hipFuncSetAttribute((const void*)phase_kernel<2>, hipFuncAttributeMaxDynamicSharedMemorySize, LDS_BYTES);
    hipFuncSetAttribute((const void*)phase_kernel<3>, hipFuncAttributeMaxDynamicSharedMemorySize, LDS_BYTES);
    hipFuncSetAttribute((const void*)phase_kernel<4>, hipFuncAttributeMaxDynamicSharedMemorySize, LDS_BYTES);
    hipFuncSetAttribute((const void*)phase_kernel<5>, hipFuncAttributeMaxDynamicSharedMemorySize, LDS_BYTES);
    hipFuncSetAttribute((const void*)phase_kernel<6>, hipFuncAttributeMaxDynamicSharedMemorySize, LDS_BYTES);
    hipFuncSetAttribute((const void*)phase_kernel<7>, hipFuncAttributeMaxDynamicSharedMemorySize, LDS_BYTES);
    attr_done = 1;
  }
  const int G = 256;
  if (LAST_PHASE >= 0) hipLaunchKernelGGL(phase_kernel<0>, dim3(G), dim3(NTHR), LDS_BYTES, stream, p);
  if (LAST_PHASE >= 1) hipLaunchKernelGGL(phase_kernel<1>, dim3(G), dim3(NTHR), LDS_BYTES, stream, p);
  if (LAST_PHASE >= 2) hipLaunchKernelGGL(phase_kernel<2>, dim3(G), dim3(NTHR), LDS_BYTES, stream, p);
  if (LAST_PHASE >= 3) hipLaunchKernelGGL(phase_kernel<3>, dim3(G), dim3(NTHR), LDS_BYTES, stream, p);
  if (LAST_PHASE >= 4) hipLaunchKernelGGL(phase_kernel<4>, dim3(G), dim3(NTHR), LDS_BYTES, stream, p);
  if (LAST_PHASE >= 5) hipLaunchKernelGGL(phase_kernel<5>, dim3(G), dim3(NTHR), LDS_BYTES, stream, p);
  if (LAST_PHASE >= 6) hipLaunchKernelGGL(phase_kernel<6>, dim3(G), dim3(NTHR), LDS_BYTES, stream, p);
  if (LAST_PHASE >= 7) hipLaunchKernelGGL(phase_kernel<7>, dim3(G), dim3(NTHR), LDS_BYTES, stream, p);
#if LAST_PHASE == 3
  hipLaunchKernelGGL(dbg_copy, dim3(1024), dim3(256), 0, stream, (const uint4*)p.qb, (uint4*)p.gb, (long)T_ALL * 1024 * 2 / 16);
#endif
#endif
}
```

```cpp
#include <hip/hip_runtime.h>
#include <hip/hip_cooperative_groups.h>
#include <cstdio>
#include <cstring>
#include <cstdint>
namespace cg = cooperative_groups;

#ifndef REP0
#define REP0 1
#endif
#ifndef REP1
#define REP1 1
#endif
#ifndef REP2
#define REP2 1
#endif
#ifndef REP6
#define REP6 1
#endif
__device__ __forceinline__ int opaque_tid() { int t = threadIdx.x; asm volatile("" : "+v"(t)); return t; }
#ifndef PROBE_MASK
#define PROBE_MASK 0
#endif
constexpr int SPLIT_FLAG0 = 3456;
#ifndef MK_COOP
#define MK_COOP 1
#endif

typedef unsigned short u16;
using bf16x8 = __attribute__((ext_vector_type(8))) short;
using s16x4  = __attribute__((ext_vector_type(4))) short;
using f32x4  = __attribute__((ext_vector_type(4))) float;
using f32x16 = __attribute__((ext_vector_type(16))) float;
using u32x4  = __attribute__((ext_vector_type(4))) unsigned;
using u32x2  = __attribute__((ext_vector_type(2))) unsigned;

constexpr int NTHR = 512;
constexpr int T_CTX = 4096, T_ALL = 20480;
constexpr int NPROJ = 6688, NPADW = 6912;
constexpr int LDS_BYTES = 135168;
constexpr float EPSF = 1e-6f;
constexpr float LAM_INIT = 0.2f;
#ifndef DBG_ST
#define DBG_ST 1
#endif

struct Params {
  const float *x_prompt, *x_sample, *cache_k, *cache_v, *state_ssd, *c, *c_ctx, *w_mod, *b_mod, *norm_g, *w_in,
      *lq1, *lk1, *lq2, *lk2, *subln_g, *conv_w, *conv_b, *dt_bias, *A_log, *D_skip, *ssd_norm_g, *w_out, *final_g;
  float* out;
  u16 *winT, *woutT, *qb, *kC, *kS, *vC, *vS, *zb, *xbc, *hb, *gb, *st;
  float *dtb, *modv, *rope, *misc, *cd, *ssqp, *ssq2p;
  unsigned* bar;
  int probe, pad_;
};

typedef __bf16 bf16v2 __attribute__((ext_vector_type(2)));
typedef float f32v2 __attribute__((ext_vector_type(2)));
__device__ __forceinline__ unsigned cvtpk(float lo, float hi) {
  f32v2 v = {lo, hi}; bf16v2 b = __builtin_convertvector(v, bf16v2); return __builtin_bit_cast(unsigned, b);
}
__device__ __forceinline__ u16 f2bf(float x) { __bf16 b = (__bf16)x; return __builtin_bit_cast(u16, b); }
__device__ __forceinline__ float bf2f(u16 x) { return __uint_as_float(((unsigned)x) << 16); }
__device__ __forceinline__ float bfs2f(short x) { return __uint_as_float(((unsigned)(u16)x) << 16); }
__device__ __forceinline__ float siluf(float v) { return v * __builtin_amdgcn_rcpf(1.f + __expf(-v)); }
__device__ __forceinline__ bf16x8 pack8(const float* v) {
  u32x4 w = {cvtpk(v[0], v[1]), cvtpk(v[2], v[3]), cvtpk(v[4], v[5]), cvtpk(v[6], v[7])};
  return *reinterpret_cast<bf16x8*>(&w);
}
__device__ __forceinline__ f32x4 mfma16(bf16x8 a, bf16x8 b, f32x4 c) {
  return __builtin_amdgcn_mfma_f32_16x16x32_bf16(a, b, c, 0, 0, 0);
}

__device__ void p0_mod_item(const Params& p, int i, char* smem) {
  const int tid = opaque_tid();
  float* sc = (float*)smem;
  float* red = sc + 5 * 1024;
  for (int idx = tid; idx < 5120; idx += NTHR) {
    int r = idx >> 10, k = idx & 1023;
    float v = (r == 0) ? p.c_ctx[k] : p.c[(r - 1) * 1024 + k];
    sc[idx] = v / (1.f + expf(-v));
  }
  __syncthreads();
  const int kg = tid >> 4, cq = tid & 15, c0 = i * 64;
  f32x4 a0 = {0, 0, 0, 0}, a1 = a0, a2 = a0, a3 = a0, a4 = a0;
  const float* w = p.w_mod + (long)(kg * 32) * 3072 + c0 + cq * 4;
#pragma unroll 8
  for (int k = 0; k < 32; ++k) {
    f32x4 wv = *reinterpret_cast<const f32x4*>(w + (long)k * 3072);
    int kk = kg * 32 + k;
    a0 += sc[kk] * wv; a1 += sc[1024 + kk] * wv; a2 += sc[2048 + kk] * wv; a3 += sc[3072 + kk] * wv; a4 += sc[4096 + kk] * wv;
  }
  *reinterpret_cast<f32x4*>(red + (kg * 5 + 0) * 64 + cq * 4) = a0; *reinterpret_cast<f32x4*>(red + (kg * 5 + 1) * 64 + cq * 4) = a1;
  *reinterpret_cast<f32x4*>(red + (kg * 5 + 2) * 64 + cq * 4) = a2; *reinterpret_cast<f32x4*>(red + (kg * 5 + 3) * 64 + cq * 4) = a3;
  *reinterpret_cast<f32x4*>(red + (kg * 5 + 4) * 64 + cq * 4) = a4;
  __syncthreads();
  if (tid < 320) {
    int r = tid >> 6, cc = tid & 63;
    float sum = p.b_mod[c0 + cc];
    for (int q = 0; q < 32; ++q) sum += red[(q * 5 + r) * 64 + cc];
    p.modv[r * 3072 + c0 + cc] = sum;
  }
  if (i == 0 && tid == 511) {
    float s1 = 0, s2 = 0;
    for (int k = 0; k < 64; ++k) { s1 += p.lq1[k] * p.lk1[k]; s2 += p.lq2[k] * p.lk2[k]; }
    p.misc[0] = expf(s1) - expf(s2) + LAM_INIT;
  }
}

__device__ void p0_transpose_item(const float* __restrict__ src, int ldsrc, int nvalid, u16* __restrict__ dst, int lddst,
                                  int n0, int k0, int kd0, const float* __restrict__ kscale, char* smem) {
  float* tile = (float*)smem;
  const int tid = opaque_tid();
  {
    int r = tid >> 3, cc = (tid & 7) * 8;
    float sc = 1.f;
    if (kscale != nullptr && (k0 + r) >= 1024) sc = kscale[k0 + r - 1024];
    float4 x0 = {0.f, 0.f, 0.f, 0.f}, x1 = {0.f, 0.f, 0.f, 0.f};
    if (n0 + cc < nvalid) {
      const float* sp = src + (long)(k0 + r) * ldsrc + n0 + cc;
      x0 = *reinterpret_cast<const float4*>(sp); x1 = *reinterpret_cast<const float4*>(sp + 4);
    }
    float* tp = tile + r * 65 + cc;
    tp[0] = x0.x * sc; tp[1] = x0.y * sc; tp[2] = x0.z * sc; tp[3] = x0.w * sc;
    tp[4] = x1.x * sc; tp[5] = x1.y * sc; tp[6] = x1.z * sc; tp[7] = x1.w * sc;
  }
  __syncthreads();
  {
    int n = tid >> 3, kk = (tid & 7) * 8;
    float v[8];
#pragma unroll
    for (int e = 0; e < 8; ++e) v[e] = tile[(kk + e) * 65 + n];
    *reinterpret_cast<bf16x8*>(dst + (long)(n0 + n) * lddst + kd0 + kk) = pack8(v);
  }
}

__device__ void p0_transpose4(const float* __restrict__ src, int ldsrc, int nvalid, u16* __restrict__ dst, int lddst,
                              int n0, int k0, int kd0, const float* __restrict__ kscale, char* smem) {
  float* tile = (float*)smem;
  const int tid = opaque_tid();
  const int r = tid >> 3, cc = (tid & 7) * 8;
  float4 x0[4], x1[4]; float sc[4];
#pragma unroll
  for (int j = 0; j < 4; ++j) {
    const int kr = k0 + j * 64 + r;
    sc[j] = (kscale != nullptr && kr >= 1024) ? kscale[kr - 1024] : 1.f;
    x0[j] = float4{0.f, 0.f, 0.f, 0.f}; x1[j] = x0[j];
    if (n0 + cc < nvalid) {
      const float* sp = src + (long)kr * ldsrc + n0 + cc;
      x0[j] = *reinterpret_cast<const float4*>(sp); x1[j] = *reinterpret_cast<const float4*>(sp + 4);
    }
  }
#pragma unroll
  for (int j = 0; j < 4; ++j) {
    float* tp = tile + j * 4160 + r * 65 + cc;
    tp[0] = x0[j].x * sc[j]; tp[1] = x0[j].y * sc[j]; tp[2] = x0[j].z * sc[j]; tp[3] = x0[j].w * sc[j];
    tp[4] = x1[j].x * sc[j]; tp[5] = x1[j].y * sc[j]; tp[6] = x1[j].z * sc[j]; tp[7] = x1[j].w * sc[j];
  }
  __syncthreads();
  const int n = tid >> 3, kk = (tid & 7) * 8;
#pragma unroll
  for (int j = 0; j < 4; ++j) {
    float v[8];
#pragma unroll
    for (int e = 0; e < 8; ++e) v[e] = tile[j * 4160 + (kk + e) * 65 + n];
    *reinterpret_cast<bf16x8*>(dst + (long)(n0 + n) * lddst + kd0 + j * 64 + kk) = pack8(v);
  }
}

__device__ void p0_rope_item(const Params& p) {
  const int tid = opaque_tid();
  for (int idx = tid; idx < 1024; idx += NTHR) {
    int pos = idx >> 4, i = idx & 15;
    double inv = 1.0;
    for (int q = 0; q < i; ++q) inv *= 0.56234132519034908;
    double ang = (double)pos * inv;
    double kq = rint(ang * 0.63661977236758134);
    double r = ang - kq * 1.5707963267948966 - kq * 6.123233995736766e-17;
    double r2 = r * r;
    double s = r * (1.0 + r2 * (-1.0 / 6 + r2 * (1.0 / 120 + r2 * (-1.0 / 5040 + r2 * (1.0 / 362880 + r2 * (-1.0 / 39916800 + r2 * (1.0 / 6227020800.0 + r2 * (-1.0 / 1307674368000.0))))))));
    double cs = 1.0 + r2 * (-0.5 + r2 * (1.0 / 24 + r2 * (-1.0 / 720 + r2 * (1.0 / 40320 + r2 * (-1.0 / 3628800 + r2 * (1.0 / 479001600 + r2 * (-1.0 / 87178291200.0 + r2 * (1.0 / 20922789888000.0))))))));
    long kk = (long)kq; int qd = (int)(kk & 3);
    double so, co;
    if (qd == 0) { so = s; co = cs; } else if (qd == 1) { so = cs; co = -s; } else if (qd == 2) { so = -s; co = -cs; } else { so = -cs; co = s; }
    p.rope[idx * 2 + 0] = (float)co;
    p.rope[idx * 2 + 1] = (float)so;
  }
}

__device__ void phase0_pre_item(const Params& p, int i, char* smem) {
  const int tid = opaque_tid();
  constexpr int N_WIN = 108 * 4, N_WOUT = 16 * 8, N_CACHE = 256, N_ROPE = 1;
    if (i < N_WIN) {
      int nt = i >> 2, kq = i & 3;
      p0_transpose4(p.w_in, NPROJ, NPROJ, p.winT, 1024, nt * 64, kq * 256, kq * 256, nullptr, smem);
      __syncthreads();
    } else if ((i -= N_WIN) < N_WOUT) {
      int nt = i >> 3, kq = i & 7;
      p0_transpose4(p.w_out, 1024, 1024, p.woutT + (kq >= 4 ? 1024 * 1024 : 0), 1024, nt * 64, kq * 256, (kq & 3) * 256, p.ssd_norm_g, smem);
      __syncthreads();
    } else if ((i -= N_WOUT) < N_CACHE) {
      float4 xa[4], xb[4];
#pragma unroll
      for (int j = 0; j < 4; ++j) {
        const int piece = i * 4 + j, tens = piece >> 9, blk = piece & 511;
        const float* src = (tens ? p.cache_v : p.cache_k) + (long)blk * 4096 + tid * 8;
        xa[j] = *reinterpret_cast<const float4*>(src); xb[j] = *reinterpret_cast<const float4*>(src + 4);
      }
#pragma unroll
      for (int j = 0; j < 4; ++j) {
        const int piece = i * 4 + j, tens = piece >> 9, blk = piece & 511;
        const long e0 = (long)blk * 4096 + tid * 8;
        const int b = (int)(e0 >> 19); const long rem = e0 & ((1 << 19) - 1);
        u16* dst = (tens ? p.vS : p.kS) + ((long)b * 4608 + 4096) * 1024 + rem;
        float v[8] = {xa[j].x, xa[j].y, xa[j].z, xa[j].w, xb[j].x, xb[j].y, xb[j].z, xb[j].w};
        *reinterpret_cast<bf16x8*>(dst) = pack8(v);
      }
    } else if ((i -= N_CACHE) < N_ROPE) {
      p0_rope_item(p);
    }
}
__device__ void phase0(const Params& p, char* smem) {
  constexpr int N_PRE = 108 * 4 + 16 * 8 + 256 + 1;
  if (gridDim.x == 256) {
    if (blockIdx.x < 48) { p0_mod_item(p, blockIdx.x, smem); __syncthreads(); }
    else { for (int i = blockIdx.x - 48; i < N_PRE; i += 208) phase0_pre_item(p, i, smem); }
  } else {
    for (int it = blockIdx.x; it < 48 + N_PRE; it += gridDim.x) {
      if (it < 48) { p0_mod_item(p, it, smem); __syncthreads(); } else phase0_pre_item(p, it - 48, smem);
    }
  }
}

__device__ void phase1(const Params& p, char* smem) {
  const int tid = opaque_tid(), lane = tid & 63, wid = tid >> 6;
  (void)tid;
  for (int i = blockIdx.x; i < T_ALL / 32; i += gridDim.x) {
      float4 v[4][4]; float ss[4];
#pragma unroll
      for (int rr = 0; rr < 4; ++rr) {
        const int t = i * 32 + rr * 8 + wid;
        const float* xr = (t < T_CTX) ? p.x_prompt + (long)t * 1024 : p.x_sample + (long)(t - T_CTX) * 1024;
#pragma unroll
        for (int q = 0; q < 4; ++q) v[rr][q] = *reinterpret_cast<const float4*>(xr + q * 256 + lane * 4);
      }
#pragma unroll
      for (int rr = 0; rr < 4; ++rr) {
        float a = 0.f;
#pragma unroll
        for (int q = 0; q < 4; ++q) a += v[rr][q].x * v[rr][q].x + v[rr][q].y * v[rr][q].y + v[rr][q].z * v[rr][q].z + v[rr][q].w * v[rr][q].w;
#pragma unroll
        for (int o = 32; o >= 1; o >>= 1) a += __shfl_xor(a, o);
        ss[rr] = rsqrtf(a * (1.f / 1024.f) + EPSF);
      }
#pragma unroll
      for (int rr = 0; rr < 4; ++rr) {
        const int t = i * 32 + rr * 8 + wid;
        const int mr = (t < T_CTX) ? 0 : 1 + ((t - T_CTX) >> 12);
        const float rs = ss[rr];
#pragma unroll
        for (int q = 0; q < 4; ++q) {
          int col = q * 256 + lane * 4;
          float4 g = *reinterpret_cast<const float4*>(p.norm_g + col);
          float4 sh = *reinterpret_cast<const float4*>(p.modv + mr * 3072 + col);
          float4 sc = *reinterpret_cast<const float4*>(p.modv + mr * 3072 + 1024 + col);
          float h0 = v[rr][q].x * rs * g.x * (1.f + sc.x) + sh.x;
          float h1 = v[rr][q].y * rs * g.y * (1.f + sc.y) + sh.y;
          float h2 = v[rr][q].z * rs * g.z * (1.f + sc.z) + sh.z;
          float h3 = v[rr][q].w * rs * g.w * (1.f + sc.w) + sh.w;
          u32x2 w = {cvtpk(h0, h1), cvtpk(h2, h3)};
          *reinterpret_cast<u32x2*>(p.hb + (long)t * 1024 + col) = w;
        }
      }
  }
}

constexpr int G_LD = 72;
constexpr int G_ABYTES = 256 * G_LD * 2, G_BBYTES = 128 * G_LD * 2, G_STAGE = G_ABYTES + G_BBYTES;

__device__ __forceinline__ void gemm_kloop(f32x4 (&acc)[4][4], const u16* __restrict__ A, int lda,
                                           const u16* __restrict__ B, int ldb, int nk, char* smem) {
  const int tid = opaque_tid(), lane = tid & 63, wid = __builtin_amdgcn_readfirstlane(tid >> 6), wm = wid >> 1, wn = wid & 1, fr = lane & 15, fq = lane >> 4;
  bf16x8 ra[4], rb[2];
  const int lr = tid >> 3, lc = (tid & 7) * 8;
  __syncthreads();
#pragma unroll
  for (int i = 0; i < 4; ++i) ra[i] = *reinterpret_cast<const bf16x8*>(A + (long)(lr + i * 64) * lda + lc);
#pragma unroll
  for (int i = 0; i < 2; ++i) rb[i] = *reinterpret_cast<const bf16x8*>(B + (long)(lr + i * 64) * ldb + lc);
  {
    u16* As = (u16*)smem; u16* Bs = (u16*)(smem + G_ABYTES);
#pragma unroll
    for (int i = 0; i < 4; ++i) *reinterpret_cast<bf16x8*>(As + (lr + i * 64) * G_LD + lc) = ra[i];
#pragma unroll
    for (int i = 0; i < 2; ++i) *reinterpret_cast<bf16x8*>(Bs + (lr + i * 64) * G_LD + lc) = rb[i];
  }
  __syncthreads();
  for (int kt = 0; kt < nk; ++kt) {
    if (kt + 1 < nk) {
#pragma unroll
      for (int i = 0; i < 4; ++i) ra[i] = *reinterpret_cast<const bf16x8*>(A + (long)(lr + i * 64) * lda + (kt + 1) * 64 + lc);
#pragma unroll
      for (int i = 0; i < 2; ++i) rb[i] = *reinterpret_cast<const bf16x8*>(B + (long)(lr + i * 64) * ldb + (kt + 1) * 64 + lc);
    }
    const u16* As = (const u16*)(smem + (kt & 1) * G_STAGE);
    const u16* Bs = (const u16*)(smem + (kt & 1) * G_STAGE + G_ABYTES);
#pragma unroll
    for (int ks = 0; ks < 2; ++ks) {
      bf16x8 a[4], b[4];
#pragma unroll
      for (int mi = 0; mi < 4; ++mi) a[mi] = *reinterpret_cast<const bf16x8*>(As + (wm * 64 + mi * 16 + fr) * G_LD + ks * 32 + fq * 8);
#pragma unroll
      for (int ni = 0; ni < 4; ++ni) b[ni] = *reinterpret_cast<const bf16x8*>(Bs + (wn * 64 + ni * 16 + fr) * G_LD + ks * 32 + fq * 8);
#pragma unroll
      for (int mi = 0; mi < 4; ++mi)
#pragma unroll
        for (int ni = 0; ni < 4; ++ni) acc[mi][ni] = mfma16(a[mi], b[ni], acc[mi][ni]);
    }
    if (kt + 1 < nk) {
      u16* As2 = (u16*)(smem + ((kt + 1) & 1) * G_STAGE); u16* Bs2 = (u16*)(smem + ((kt + 1) & 1) * G_STAGE + G_ABYTES);
#pragma unroll
      for (int i = 0; i < 4; ++i) *reinterpret_cast<bf16x8*>(As2 + (lr + i * 64) * G_LD + lc) = ra[i];
#pragma unroll
      for (int i = 0; i < 2; ++i) *reinterpret_cast<bf16x8*>(Bs2 + (lr + i * 64) * G_LD + lc) = rb[i];
    }
    __syncthreads();
  }
}

namespace pg8 {
#define PG8_LAS __attribute__((address_space(3)))
typedef unsigned short bf16_t;
typedef short bf16x8 __attribute__((ext_vector_type(8)));
typedef float f32x4 __attribute__((ext_vector_type(4)));
typedef unsigned u32x4 __attribute__((ext_vector_type(4)));
constexpr int BM = 256, BK = 64, HALF = 128, HTB = HALF * BK * 2  , STAGE_BYTES = 8 * HTB, NXCD = 8, WGM = 4;

__host__ __device__ __forceinline__ int lds_byte(int r, int c) { const int st = (r >> 4) * 2 + (c >> 5), rr = r & 15, cc = c & 31, ob = rr * 64 + cc * 2; return st * 1024 + (ob ^ (((ob >> 9) & 1) << 5)); }
__host__ __device__ __forceinline__ void stage_rc(int b, int& R, int& C) { const int st = b / 1024, sb = b % 1024, swz = sb ^ (((sb >> 9) & 1) << 5); R = (st >> 1) * 16 + swz / 64; C = (st & 1) * 32 + (swz % 64) / 2; }
__host__ __device__ __forceinline__ int perm32(int rho) { const int n = rho >> 4, i = rho & 15; return 8 * (i >> 2) + 4 * n + (i & 3); }

struct Unit { int pm, pn, seg, split; };
struct Gemm { const bf16_t* A; const bf16_t* Bt; int M, N, K; const bf16_t* A2; const bf16_t* Bt2; };

struct StaticOrder {
    int nM, nN, nwg, G, c;
    __host__ __device__ void init(int M, int N, int G_, int c_) { nM = M / BM; nN = N / BM; nwg = nM * nN; G = G_; c = c_; }
    __host__ __device__ bool tile_at(long L, Unit& u) const {
        if (L >= nwg) return false;
        int wgid = (int)L; { const int q = nwg / NXCD, r = nwg % NXCD, xcd = wgid % NXCD, off = wgid / NXCD; wgid = (xcd < r ? xcd * (q + 1) : r * (q + 1) + (xcd - r) * q) + off; }
        const int nig = WGM * nN, gid = wgid / nig, fm = gid * WGM, gsz = (nM - fm) < WGM ? (nM - fm) : WGM;
        u.pm = fm + ((wgid % nig) % gsz); u.pn = (wgid % nig) / gsz; u.seg = 0; u.split = 0; return true;
    }
    __host__ __device__ bool next(int i, Unit& u) const { return tile_at((long)i * G + c, u); }
    __device__ __forceinline__ void a_ready(const Unit&) const {}
    __device__ __forceinline__ void done(const Unit&) const {}
};
template <class Epi, class Sched, bool STAMP = false>
__device__ __forceinline__ void gemm_phase(PG8_LAS unsigned char* lds, const Gemm g, const Sched& S, const Epi& E, unsigned long long* stamps) {
    const int tid = opaque_tid(), wid = __builtin_amdgcn_readfirstlane(tid >> 6), lane = tid & 63, wr = wid >> 2, wc = wid & 3, fr = lane & 15, fq = lane >> 4;
    const int K = g.K, nt = K / BK;
    int ts_lo = 0, ts_hi = 0, nts = 0; const unsigned long long rt_entry = STAMP ? (unsigned long long)wall_clock64() : 0ull;
#define PG8_STAMP() do { if (STAMP && wid == 0 && nts < 64) { const unsigned long long _c = (unsigned long long)clock64(); \
        ts_lo = (lane == nts) ? (int)(unsigned)_c : ts_lo; ts_hi = (lane == nts) ? (int)(unsigned)(_c >> 32) : ts_hi; ++nts; } } while (0)
    PG8_STAMP();
    unsigned voffA[2], voffB[2];
#pragma unroll
    for (int i = 0; i < 2; ++i) { int R, C; stage_rc(tid * 16 + i * 8192, R, C); const int Rb = Epi::PERM ? ((R & ~31) + perm32(R & 31)) : R;
        voffA[i] = (unsigned)(R * K + C) * 2u; voffB[i] = (unsigned)(Rb * K + C) * 2u; }
    const size_t kstep = (size_t)(BK * 2);
    const size_t hstep = (size_t)HALF * K * 2;
    const size_t tstep = 2 * hstep;
    const unsigned ldsw = (unsigned)wid * 1024u;
    const int aoff = lds_byte(wr * 64 + fr, fq * 8), boff = lds_byte(wc * 32 + fr, fq * 8);
#define PG8_SA(b, h) (((b) * 2 + (h)) * HTB)
#define PG8_SB(b, h) ((4 + (b) * 2 + (h)) * HTB)
#define PG8_STAGE(bufoff, gbase, voff) do { _Pragma("unroll") for (int _i = 0; _i < 2; ++_i) \
        __builtin_amdgcn_global_load_lds((const unsigned*)((const char*)(gbase) + (voff)[_i]), (PG8_LAS unsigned*)(lds + (bufoff) + ldsw + _i * 8192), 16, 0, 0); } while (0)
#define PG8_LDA(dst, b, h) do { _Pragma("unroll") for (int m = 0; m < 4; ++m) _Pragma("unroll") for (int k = 0; k < 2; ++k) dst[m][k] = *(const PG8_LAS bf16x8*)(lds + PG8_SA(b, h) + aoff + m * 2048 + k * 1024); } while (0)
#define PG8_LDB(dst, b, h) do { _Pragma("unroll") for (int n = 0; n < 2; ++n) _Pragma("unroll") for (int k = 0; k < 2; ++k) dst[n][k] = *(const PG8_LAS bf16x8*)(lds + PG8_SB(b, h) + boff + n * 2048 + k * 1024); } while (0)
#define PG8_MMA(ai, bj, At, Bt) do { __builtin_amdgcn_s_setprio(1); _Pragma("unroll") for (int m = 0; m < 4; ++m) _Pragma("unroll") for (int n = 0; n < 2; ++n) _Pragma("unroll") for (int k = 0; k < 2; ++k) \
        acc[ai][bj][m][n] = __builtin_amdgcn_mfma_f32_16x16x32_bf16(Bt[n][k], At[m][k], acc[ai][bj][m][n], 0, 0, 0); __builtin_amdgcn_s_setprio(0); } while (0)
#define PG8_WAIT_V(n) asm volatile("s_waitcnt vmcnt(" #n ")" ::: "memory")
#define PG8_WAIT_L(n) asm volatile("s_waitcnt lgkmcnt(" #n ")" ::: "memory")
#define PG8_BAR __builtin_amdgcn_s_barrier()
#define PG8_SCHED __builtin_amdgcn_sched_barrier(0)
    Unit cur, nxt; int ui = 0;
    if (!S.next(0, cur)) return;
    f32x4 acc[2][2][4][2];
#pragma unroll
    for (int a = 0; a < 2; ++a)
#pragma unroll
        for (int b = 0; b < 2; ++b)
#pragma unroll
            for (int m = 0; m < 4; ++m)
#pragma unroll
                for (int n = 0; n < 2; ++n) acc[a][b][m][n] = (f32x4){0.f, 0.f, 0.f, 0.f};
    bf16x8 At[4][2], B0[2][2], B1[2][2];
    const char* cA = (const char*)(cur.seg ? g.A2 : g.A) + (size_t)cur.pm * tstep; const char* cB = (const char*)(cur.seg ? g.Bt2 : g.Bt) + (size_t)cur.pn * tstep;
    S.a_ready(cur);
    PG8_STAGE(PG8_SB(0, 0), cB, voffB); PG8_STAGE(PG8_SA(0, 0), cA, voffA); PG8_STAGE(PG8_SB(0, 1), cB + hstep, voffB); PG8_STAGE(PG8_SA(0, 1), cA + hstep, voffA);
    if (wr == 1) PG8_BAR;
    PG8_WAIT_V(4); PG8_BAR;
    PG8_STAGE(PG8_SB(1, 0), cB + kstep, voffB); PG8_STAGE(PG8_SA(1, 0), cA + kstep, voffA); PG8_STAGE(PG8_SB(1, 1), cB + hstep + kstep, voffB);
    PG8_WAIT_V(6); PG8_BAR;
    PG8_STAMP();
    for (;;) {
        const bool has_next = S.next(ui + 1, nxt);
        const char* nA = has_next ? (const char*)(nxt.seg ? g.A2 : g.A) + (size_t)nxt.pm * tstep : cA; const char* nB = has_next ? (const char*)(nxt.seg ? g.Bt2 : g.Bt) + (size_t)nxt.pn * tstep : cB;
        for (int t = 0; t < nt; t += 2) {
            const bool last = (t == nt - 2);
            const char* a1 = cA + (size_t)(t + 1) * kstep;
            const char* a2 = last ? nA : cA + (size_t)(t + 2) * kstep; const char* b2 = last ? nB : cB + (size_t)(t + 2) * kstep;
            const char* a3 = a2 + kstep; const char* b3 = b2 + kstep;
            if (last && has_next) S.a_ready(nxt);
            PG8_LDB(B0, 0, 0); PG8_SCHED; PG8_LDA(At, 0, 0); PG8_STAGE(PG8_SA(1, 1), a1 + hstep, voffA);
            PG8_WAIT_L(8); PG8_BAR; PG8_WAIT_L(0); PG8_MMA(0, 0, At, B0); PG8_BAR; PG8_SCHED;
            PG8_LDB(B1, 0, 1); PG8_STAGE(PG8_SB(0, 0), b2, voffB);
            PG8_BAR; PG8_WAIT_L(0); PG8_MMA(0, 1, At, B1); PG8_BAR;
            PG8_LDA(At, 0, 1); PG8_STAGE(PG8_SA(0, 0), a2, voffA);
            PG8_BAR; PG8_WAIT_L(0); PG8_MMA(1, 0, At, B0); PG8_BAR; PG8_SCHED;
            PG8_STAGE(PG8_SB(0, 1), b2 + hstep, voffB);
            PG8_WAIT_V(6); PG8_BAR; PG8_MMA(1, 1, At, B1); PG8_BAR;
            PG8_LDB(B0, 1, 0); PG8_SCHED; PG8_LDA(At, 1, 0); PG8_STAGE(PG8_SA(0, 1), a2 + hstep, voffA);
            PG8_WAIT_L(8); PG8_BAR; PG8_WAIT_L(0); PG8_MMA(0, 0, At, B0); PG8_BAR; PG8_SCHED;
            PG8_LDB(B1, 1, 1); PG8_STAGE(PG8_SB(1, 0), b3, voffB);
            PG8_BAR; PG8_WAIT_L(0); PG8_MMA(0, 1, At, B1); PG8_BAR;
            PG8_LDA(At, 1, 1); PG8_STAGE(PG8_SA(1, 0), a3, voffA);
            PG8_BAR; PG8_WAIT_L(0); PG8_MMA(1, 0, At, B0); PG8_BAR; PG8_SCHED;
            PG8_STAGE(PG8_SB(1, 1), b3 + hstep, voffB);
            PG8_WAIT_V(6); PG8_BAR; PG8_MMA(1, 1, At, B1); PG8_BAR;
        }
        PG8_STAMP();
        if constexpr (!Epi::AFTER_DRAIN) { E(acc, cur, wr, wc, fr, fq); S.done(cur); }
        PG8_STAMP();
        if (!has_next) break;
        if (!(Epi::KEEP && cur.seg == 0))
#pragma unroll
        for (int a = 0; a < 2; ++a)
#pragma unroll
            for (int b = 0; b < 2; ++b)
#pragma unroll
                for (int m = 0; m < 4; ++m)
#pragma unroll
                    for (int n = 0; n < 2; ++n) acc[a][b][m][n] = (f32x4){0.f, 0.f, 0.f, 0.f};
        cur = nxt; cA = nA; cB = nB; ++ui;
    }
    PG8_WAIT_V(0);
    if (wr == 0) PG8_BAR;
    PG8_BAR;
    if constexpr (Epi::AFTER_DRAIN) { E.fused(acc, cur, wr, wc, fr, fq, lds, wid, lane); S.done(cur); }
    PG8_STAMP();
    if (STAMP && wid == 0) { stamps[lane] = lane < nts ? (((unsigned long long)(unsigned)ts_hi << 32) | (unsigned)ts_lo) : 0ull;
        if (lane == 62) stamps[62] = rt_entry; if (lane == 63) stamps[63] = (unsigned long long)wall_clock64(); }
#undef PG8_STAMP
#undef PG8_SA
#undef PG8_SB
#undef PG8_STAGE
#undef PG8_LDA
#undef PG8_LDB
#undef PG8_MMA
#undef PG8_WAIT_V
#undef PG8_WAIT_L
#undef PG8_BAR
#undef PG8_SCHED
}
}
template <int SEG> __device__ __forceinline__ void epi_proj_seg(const Params& p, const f32x4 (&acc)[2][2][4][2], int m0, int n0, int wr, int wc, int fr, int fq) {
  const bool is_ctx = (m0 < T_CTX);
  const bool do_rope = (SEG <= 1) && !is_ctx;
#pragma unroll
  for (int ai = 0; ai < 2; ++ai)
#pragma unroll
    for (int m = 0; m < 4; ++m) {
      const int t = m0 + ai * 128 + wr * 64 + m * 16 + fr;
      const int ts = t - T_CTX, bsm = ts >> 12, tl = ts & 4095;
      f32x4 rc[4];
      if (do_rope) {
        const int pos = (wc & 1) ? (tl & 63) : (tl >> 6);
        const f32x4* rp = reinterpret_cast<const f32x4*>(p.rope + (pos * 16 + 8 * (fq & 1)) * 2);
        rc[0] = rp[0]; rc[1] = rp[1]; rc[2] = rp[2]; rc[3] = rp[3];
      }
#pragma unroll
      for (int bj = 0; bj < 2; ++bj) {
        f32x4 v0 = acc[ai][bj][m][0], v1 = acc[ai][bj][m][1];
        const int n = n0 + bj * 128 + wc * 32 + 8 * fq;
        if (do_rope) {
          const float sgn = (fq < 2) ? -1.f : 1.f;
#pragma unroll
          for (int e = 0; e < 4; ++e) {
            float o0 = __shfl_xor(v0[e], 32), o1 = __shfl_xor(v1[e], 32);
            float c0 = rc[e >> 1][(e & 1) * 2], s0 = rc[e >> 1][(e & 1) * 2 + 1];
            float c1 = rc[2 + (e >> 1)][(e & 1) * 2], s1 = rc[2 + (e >> 1)][(e & 1) * 2 + 1];
            v0[e] = v0[e] * c0 + sgn * o0 * s0;
            v1[e] = v1[e] * c1 + sgn * o1 * s1;
          }
        }
        if (SEG == 3 || SEG == 4) {
#pragma unroll
          for (int e = 0; e < 4; ++e) { v0[e] = siluf(v0[e]); v1[e] = siluf(v1[e]); }
        }
        if (SEG == 6) {
          if (bj == 0 && wc == 0) {
            float* fo = p.dtb + (long)t * 32 + 8 * fq;
            *reinterpret_cast<f32x4*>(fo) = v0; *reinterpret_cast<f32x4*>(fo + 4) = v1;
          }
        } else {
          u32x4 w = {cvtpk(v0[0], v0[1]), cvtpk(v0[2], v0[3]), cvtpk(v1[0], v1[1]), cvtpk(v1[2], v1[3])};
          u16* dst;
          if (SEG == 0) dst = p.qb + (long)t * 1024 + n;
          else if (SEG == 1 || SEG == 2) {
            const int c = n - SEG * 1024;
            if (is_ctx) {
              dst = (SEG == 1 ? p.kC : p.vC) + (long)t * 1024 + c;
              float* fo = p.out + (SEG == 1 ? 20971520L : 25165824L) + (long)t * 1024 + c;
              __builtin_nontemporal_store(v0, reinterpret_cast<f32x4*>(fo)); __builtin_nontemporal_store(v1, reinterpret_cast<f32x4*>(fo + 4));
            } else dst = (SEG == 1 ? p.kS : p.vS) + ((long)bsm * 4608 + tl) * 1024 + c;
          } else if (SEG == 3) dst = p.gb + (long)t * 1024 + (n - 3072);
          else if (SEG == 4) dst = p.zb + (long)t * 1024 + (n - 4096);
          else dst = p.xbc + (long)t * 1536 + (n - 5120);
          *reinterpret_cast<u32x4*>(dst) = w;
        }
      }
    }
}
struct EpiProj {
  static constexpr bool PERM = true, AFTER_DRAIN = false, KEEP = false;
  const Params& p;
  __device__ __forceinline__ void operator()(const f32x4 (&acc)[2][2][4][2], const pg8::Unit& u, int wr, int wc, int fr, int fq) const {
    const int m0 = u.pm * 256, n0 = u.pn * 256;
    const int seg = (n0 < 5120) ? (n0 >> 10) : (n0 < 6656 ? 5 : 6);
    switch (seg) {
      case 0: epi_proj_seg<0>(p, acc, m0, n0, wr, wc, fr, fq); break;
      case 1: epi_proj_seg<1>(p, acc, m0, n0, wr, wc, fr, fq); break;
      case 2: epi_proj_seg<2>(p, acc, m0, n0, wr, wc, fr, fq); break;
      case 3: epi_proj_seg<3>(p, acc, m0, n0, wr, wc, fr, fq); break;
      case 4: epi_proj_seg<4>(p, acc, m0, n0, wr, wc, fr, fq); break;
      case 5: epi_proj_seg<5>(p, acc, m0, n0, wr, wc, fr, fq); break;
      default: epi_proj_seg<6>(p, acc, m0, n0, wr, wc, fr, fq); break;
    }
  }
};

__device__ void phase2(const Params& p, char* smem) {
  pg8::StaticOrder S; S.init(T_ALL, NPADW, (int)gridDim.x, (int)blockIdx.x);
  pg8::Gemm g{p.hb, p.winT, T_ALL, NPADW, 1024, p.hb, p.winT};
  EpiProj E{p};
  pg8::gemm_phase<EpiProj, pg8::StaticOrder, false>((PG8_LAS unsigned char*)smem, g, S, E, nullptr);
  __syncthreads();
}

constexpr int SHM_V = 64 * 128 * 2, SHM_K = 64 * 128 * 2;
constexpr float ASCALE = 0.125f;
constexpr float ATHR = 8.f;
#define KSWZ(row, colB) ((row) * 256 + ((colB) ^ (((row) & 7) << 4)))
#define SBAR() __builtin_amdgcn_sched_barrier(0)
__device__ __forceinline__ int crow(int r, int hi) { return (r & 3) + 8 * (r >> 2) + 4 * hi; }

__device__ __forceinline__ void partialSM(f32x16& p0, f32x16& p1, float& m_reg, float& mn, float& alpha) {
  constexpr float C = ASCALE * 1.4426950408889634f;
  float pmax = p0[0];
#pragma unroll
  for (int r = 1; r < 16; ++r) pmax = fmaxf(pmax, p0[r]);
#pragma unroll
  for (int r = 0; r < 16; ++r) pmax = fmaxf(pmax, p1[r]);
  { auto rr = __builtin_amdgcn_permlane32_swap(__float_as_uint(pmax), __float_as_uint(pmax), false, false);
    pmax = fmaxf(__uint_as_float(rr[0]), __uint_as_float(rr[1])); }
  if (__builtin_expect(__all(pmax - m_reg <= ATHR / ASCALE), 1)) { mn = m_reg; alpha = 1.f; }
  else { mn = fmaxf(m_reg, pmax); alpha = __builtin_amdgcn_exp2f((m_reg - mn) * C); m_reg = mn; }
  float mnC = -mn * C;
#pragma unroll
  for (int r = 0; r < 16; ++r) p0[r] = fmaf(p0[r], C, mnC);
#pragma unroll
  for (int r = 0; r < 16; ++r) p1[r] = fmaf(p1[r], C, mnC);
#pragma unroll
  for (int r = 0; r < 16; ++r) p0[r] = __builtin_amdgcn_exp2f(p0[r]);
}
__device__ __forceinline__ void finishSM(f32x16& p0, f32x16& p1, float alpha, float& l_reg, bf16x8& pa0, bf16x8& pa1, bf16x8& pa2, bf16x8& pa3) {
#pragma unroll
  for (int r = 0; r < 16; ++r) p1[r] = __builtin_amdgcn_exp2f(p1[r]);
  float ps = 0;
#pragma unroll
  for (int r = 0; r < 16; ++r) ps += p0[r];
#pragma unroll
  for (int r = 0; r < 16; ++r) ps += p1[r];
  { auto rr = __builtin_amdgcn_permlane32_swap(__float_as_uint(ps), __float_as_uint(ps), false, false);
    ps = __uint_as_float(rr[0]) + __uint_as_float(rr[1]); }
  l_reg = l_reg * alpha + ps;
#define PK4(P, BASE, OUT) do { unsigned a0 = cvtpk(P[BASE + 0], P[BASE + 1]), a1 = cvtpk(P[BASE + 2], P[BASE + 3]);   \
    unsigned b0 = cvtpk(P[BASE + 4], P[BASE + 5]), b1 = cvtpk(P[BASE + 6], P[BASE + 7]);                              \
    auto r0 = __builtin_amdgcn_permlane32_swap(a0, b0, false, false); auto r1 = __builtin_amdgcn_permlane32_swap(a1, b1, false, false); \
    u32x4 w = {r0[0], r1[0], r0[1], r1[1]}; OUT = *reinterpret_cast<bf16x8*>(&w); } while (0)
  PK4(p0, 0, pa0); PK4(p0, 8, pa1); PK4(p1, 0, pa2); PK4(p1, 8, pa3);
#undef PK4
}
__device__ __forceinline__ void qkt(f32x16& p0, f32x16& p1, const u16* Ks, const bf16x8* qr, int r32, int hi, int comp) {
  p0 = f32x16{}; p1 = f32x16{};
#pragma unroll
  for (int d0 = 0; d0 < 4; ++d0) { int cb = (comp * 64 + d0 * 16 + hi * 8) * 2;
    bf16x8 b0 = *reinterpret_cast<const bf16x8*>((const char*)Ks + KSWZ(r32, cb));
    bf16x8 b1 = *reinterpret_cast<const bf16x8*>((const char*)Ks + KSWZ(32 + r32, cb));
    bf16x8 q = qr[d0];
    p0 = __builtin_amdgcn_mfma_f32_32x32x16_bf16(b0, q, p0, 0, 0, 0);
    p1 = __builtin_amdgcn_mfma_f32_32x32x16_bf16(b1, q, p1, 0, 0, 0); }
}
__device__ __forceinline__ int v_st(int k, int c) { const int kk = (k & ~0xC) | ((k & 4) << 1) | ((k & 8) >> 1); return ((kk >> 3) * 4 + (c >> 5)) * 512 + ((kk & 7) * 32 + (c & 31)) * 2; }
__device__ __forceinline__ int v_rd_base(int lane) { return ((lane & 3) << 3) | (((lane >> 2) & 3) << 6) | (((lane >> 4) & 1) << 5) | (((lane >> 5) & 1) << 8); }
constexpr int v_rd_off(int d0, int ks, int half) { return d0 * 512 + ks * 4096 + half * 2048; }
template <int OFF> __device__ __forceinline__ s16x4 tr_read(int vb) {
  s16x4 r; asm volatile("ds_read_b64_tr_b16 %0, %1 offset:%2" : "=&v"(r) : "v"(vb), "i"(OFF) : "memory"); return r;
}
template <int D0> __device__ __forceinline__ void pv_one(f32x16& od, int vb, bf16x8 pa0, bf16x8 pa1, bf16x8 pa2, bf16x8 pa3) {
  const s16x4 l0 = tr_read<v_rd_off(D0, 0, 0)>(vb), h0 = tr_read<v_rd_off(D0, 0, 1)>(vb), l1 = tr_read<v_rd_off(D0, 1, 0)>(vb), h1 = tr_read<v_rd_off(D0, 1, 1)>(vb);
  const s16x4 l2 = tr_read<v_rd_off(D0, 2, 0)>(vb), h2 = tr_read<v_rd_off(D0, 2, 1)>(vb), l3 = tr_read<v_rd_off(D0, 3, 0)>(vb), h3 = tr_read<v_rd_off(D0, 3, 1)>(vb);
  asm volatile("s_waitcnt lgkmcnt(0)" ::: "memory"); SBAR();
#define PK(L, H) (bf16x8){L[0], L[1], L[2], L[3], H[0], H[1], H[2], H[3]}
  od = __builtin_amdgcn_mfma_f32_32x32x16_bf16(pa0, PK(l0, h0), od, 0, 0, 0);
  od = __builtin_amdgcn_mfma_f32_32x32x16_bf16(pa1, PK(l1, h1), od, 0, 0, 0);
  od = __builtin_amdgcn_mfma_f32_32x32x16_bf16(pa2, PK(l2, h2), od, 0, 0, 0);
  od = __builtin_amdgcn_mfma_f32_32x32x16_bf16(pa3, PK(l3, h3), od, 0, 0, 0);
#undef PK
}
__device__ __forceinline__ void pv_d0(f32x16* o, int vb, bf16x8 pa0, bf16x8 pa1, bf16x8 pa2, bf16x8 pa3) {
  pv_one<0>(o[0], vb, pa0, pa1, pa2, pa3); pv_one<1>(o[1], vb, pa0, pa1, pa2, pa3); pv_one<2>(o[2], vb, pa0, pa1, pa2, pa3); pv_one<3>(o[3], vb, pa0, pa1, pa2, pa3);
}

__device__ __forceinline__ void attn_item(const Params& p, long tq0, int h, const u16* __restrict__ Kh, const u16* __restrict__ Vh, int seq, char* lds) {
  constexpr int LDK = 1024;
  const int tid = opaque_tid(), wid = __builtin_amdgcn_readfirstlane(tid >> 6), lane = tid & 63, r32 = lane & 31, hi = lane >> 5;
  const int comp = wid >> 2, qg = wid & 3;
  u16* V_lds = (u16*)lds; u16* K_lds = (u16*)(lds + 2 * SHM_V);
  float* wsl = (float*)(lds + 2 * SHM_V + 2 * SHM_K) + wid * 64; float* li_l = wsl; float* al_l = wsl + 32;
  float m_reg = -1e30f, l_reg = 0; f32x16 o[4] = {};
  char* Q_lds = lds + 2 * SHM_V + 2 * SHM_K + 2048;
  {
#pragma unroll
    for (int i = 0; i < 4; ++i) {
      int id = tid + i * NTHR; int row = id >> 4, ch = id & 15;
      bf16x8 v = *reinterpret_cast<const bf16x8*>(p.qb + (tq0 + row) * 1024 + h * 128 + ch * 8);
      *reinterpret_cast<bf16x8*>(Q_lds + KSWZ(row, ch * 16)) = v;
    }
  }
  __syncthreads();
  bf16x8 qr[4];
#pragma unroll
  for (int d0 = 0; d0 < 4; ++d0) qr[d0] = *reinterpret_cast<const bf16x8*>(Q_lds + (qg * 32) * 256 + KSWZ(r32, (comp * 64 + d0 * 16 + hi * 8) * 2));
  const int sr = tid >> 4, sc = (tid & 15) * 8, vst0 = v_st(sr, sc), vst1 = v_st(32 + sr, sc);
  const int vb0 = (int)(uintptr_t)V_lds + v_rd_base(lane);
  constexpr int SDEPTH = 1;
  struct { bf16x8 vs0, vs1, ks0, ks1; } sr_[SDEPTH];
#define SLOAD(i, k0) do { sr_[i].vs0 = *reinterpret_cast<const bf16x8*>(&Vh[(long)((k0) + sr) * LDK + sc]); sr_[i].vs1 = *reinterpret_cast<const bf16x8*>(&Vh[(long)((k0) + 32 + sr) * LDK + sc]); \
    sr_[i].ks0 = *reinterpret_cast<const bf16x8*>(&Kh[(long)((k0) + sr) * LDK + sc]); sr_[i].ks1 = *reinterpret_cast<const bf16x8*>(&Kh[(long)((k0) + 32 + sr) * LDK + sc]); } while (0)
#define SWRITE(b, i) do { *(bf16x8*)((char*)V_lds + (b) * SHM_V + vst0) = sr_[i].vs0;          \
    *(bf16x8*)((char*)V_lds + (b) * SHM_V + vst1) = sr_[i].vs1; int kc = sc * 2;               \
    *(bf16x8*)((char*)K_lds + (b) * SHM_K + KSWZ(sr, kc)) = sr_[i].ks0;                       \
    *(bf16x8*)((char*)K_lds + (b) * SHM_K + KSWZ(32 + sr, kc)) = sr_[i].ks1; } while (0)
#define SWAIT() do { if constexpr (SDEPTH == 2) asm volatile("s_waitcnt vmcnt(4)" ::: "memory"); else asm volatile("s_waitcnt vmcnt(0)" ::: "memory"); } while (0)
#define RESC(a) do { if (__any((a) < 1.f)) { if (hi == 0) al_l[r32] = (a); asm volatile("s_waitcnt lgkmcnt(0)" ::: "memory"); \
    _Pragma("unroll") for (int d = 0; d < 4; ++d) _Pragma("unroll") for (int r = 0; r < 16; ++r) o[d][r] *= al_l[crow(r, hi)]; } } while (0)
  f32x16 pA0, pA1, pB0, pB1; float mnA, mnB, alA, alB; bf16x8 pa0, pa1, pa2, pa3; const int NT = seq / 64;
  constexpr int SE = 0, SO = SDEPTH - 1;
  SLOAD(SE, 0); asm volatile("s_waitcnt vmcnt(0)" ::: "memory"); SWRITE(0, SE); __syncthreads();
  qkt(pA0, pA1, K_lds, qr, r32, hi, comp); partialSM(pA0, pA1, m_reg, mnA, alA);
  SLOAD(SO, 64); if constexpr (SDEPTH == 2) { if (2 < NT) SLOAD(SE, 2 * 64); }
  SWAIT(); SWRITE(1, SO); __syncthreads();
  for (int j = 1; j + 1 < NT; j += 2) {
    SBAR(); qkt(pB0, pB1, (u16*)((char*)K_lds + SHM_K), qr, r32, hi, comp);
    finishSM(pA0, pA1, alA, l_reg, pa0, pa1, pa2, pa3); SBAR();
    SLOAD(SO, (j + SDEPTH) * 64); SBAR();
    pv_d0(o, vb0, pa0, pa1, pa2, pa3); partialSM(pB0, pB1, m_reg, mnB, alB);
    __syncthreads(); SWAIT(); SWRITE(0, SE);
    RESC(alB); __syncthreads();
    SBAR(); qkt(pA0, pA1, K_lds, qr, r32, hi, comp);
    finishSM(pB0, pB1, alB, l_reg, pa0, pa1, pa2, pa3); SBAR();
    if (SDEPTH == 1 || j + 3 < NT) SLOAD(SE, (j + 1 + SDEPTH) * 64); SBAR();
    pv_d0(o, vb0 + (int)SHM_V, pa0, pa1, pa2, pa3); partialSM(pA0, pA1, m_reg, mnA, alA);
    __syncthreads(); SWAIT(); SWRITE(1, SO);
    RESC(alA); __syncthreads();
  }
  SBAR(); qkt(pB0, pB1, (u16*)((char*)K_lds + SHM_K), qr, r32, hi, comp);
  finishSM(pA0, pA1, alA, l_reg, pa0, pa1, pa2, pa3); SBAR();
  pv_d0(o, vb0, pa0, pa1, pa2, pa3); partialSM(pB0, pB1, m_reg, mnB, alB);
  __syncthreads(); RESC(alB);
  finishSM(pB0, pB1, alB, l_reg, pa0, pa1, pa2, pa3); SBAR();
  pv_d0(o, vb0 + (int)SHM_V, pa0, pa1, pa2, pa3);
  if (hi == 0) li_l[r32] = l_reg; asm volatile("s_waitcnt lgkmcnt(0)" ::: "memory");
  float rli[16];
#pragma unroll
  for (int r = 0; r < 16; ++r) rli[r] = 1.f / li_l[crow(r, hi)];
#undef SLOAD
#undef SWRITE
#undef SWAIT
#undef RESC
  __syncthreads();
  float* ex = (float*)lds;
  const float lam = p.misc[0];
  if (comp == 1) {
#pragma unroll
    for (int d0 = 0; d0 < 4; ++d0)
#pragma unroll
      for (int r = 0; r < 16; ++r) ex[((qg * 4 + d0) * 16 + r) * 64 + lane] = o[d0][r] * rli[r] * lam;
  }
  __syncthreads();
  if (comp == 0) {
    float ssq[16];
#pragma unroll
    for (int r = 0; r < 16; ++r) ssq[r] = 0.f;
#pragma unroll
    for (int d0 = 0; d0 < 4; ++d0)
#pragma unroll
      for (int r = 0; r < 16; ++r) {
        float v = o[d0][r] * rli[r] - ex[((qg * 4 + d0) * 16 + r) * 64 + lane];
        o[d0][r] = v; ssq[r] += v * v;
      }
#pragma unroll
    for (int r = 0; r < 16; ++r) {
      float s = ssq[r];
      s += __shfl_xor(s, 1); s += __shfl_xor(s, 2); s += __shfl_xor(s, 4); s += __shfl_xor(s, 8); s += __shfl_xor(s, 16);
      ssq[r] = rsqrtf(s * (1.f / 128.f) + EPSF) * (1.f - LAM_INIT);
    }
    float sg[4];
#pragma unroll
    for (int d0 = 0; d0 < 4; ++d0) sg[d0] = p.subln_g[d0 * 32 + r32];
    const long base = (tq0 + qg * 32 + 4 * hi) * 1024 + h * 128 + r32;
    const u16* gp = p.gb + base; u16* qp = p.qb + base;
#pragma unroll
    for (int r = 0; r < 16; ++r) {
      const int ro = ((r & 3) + 8 * (r >> 2)) * 1024;
      float g0 = bf2f(gp[ro]), g1 = bf2f(gp[ro + 32]), g2 = bf2f(gp[ro + 64]), g3 = bf2f(gp[ro + 96]);
      qp[ro] = f2bf(o[0][r] * ssq[r] * sg[0] * g0);
      qp[ro + 32] = f2bf(o[1][r] * ssq[r] * sg[1] * g1);
      qp[ro + 64] = f2bf(o[2][r] * ssq[r] * sg[2] * g2);
      qp[ro + 96] = f2bf(o[3][r] * ssq[r] * sg[3] * g3);
      SBAR();
    }
  }
  __syncthreads();
}


template <int D0> __device__ __forceinline__ void pv_two(f32x16& oa, f32x16& ob, int vb, bf16x8 a0, bf16x8 a1, bf16x8 a2, bf16x8 a3, bf16x8 b0, bf16x8 b1, bf16x8 b2, bf16x8 b3) {
  const s16x4 l0 = tr_read<v_rd_off(D0, 0, 0)>(vb), h0 = tr_read<v_rd_off(D0, 0, 1)>(vb), l1 = tr_read<v_rd_off(D0, 1, 0)>(vb), h1 = tr_read<v_rd_off(D0, 1, 1)>(vb);
  const s16x4 l2 = tr_read<v_rd_off(D0, 2, 0)>(vb), h2 = tr_read<v_rd_off(D0, 2, 1)>(vb), l3 = tr_read<v_rd_off(D0, 3, 0)>(vb), h3 = tr_read<v_rd_off(D0, 3, 1)>(vb);
#define PK(L, H) (bf16x8){L[0], L[1], L[2], L[3], H[0], H[1], H[2], H[3]}
  asm volatile("s_waitcnt lgkmcnt(6)" ::: "memory"); SBAR();
  { const bf16x8 v0 = PK(l0, h0);
    oa = __builtin_amdgcn_mfma_f32_32x32x16_bf16(a0, v0, oa, 0, 0, 0);
    ob = __builtin_amdgcn_mfma_f32_32x32x16_bf16(b0, v0, ob, 0, 0, 0); }
  SBAR(); asm volatile("s_waitcnt lgkmcnt(4)" ::: "memory"); SBAR();
  { const bf16x8 v1 = PK(l1, h1);
    oa = __builtin_amdgcn_mfma_f32_32x32x16_bf16(a1, v1, oa, 0, 0, 0);
    ob = __builtin_amdgcn_mfma_f32_32x32x16_bf16(b1, v1, ob, 0, 0, 0); }
  SBAR(); asm volatile("s_waitcnt lgkmcnt(2)" ::: "memory"); SBAR();
  { const bf16x8 v2 = PK(l2, h2);
    oa = __builtin_amdgcn_mfma_f32_32x32x16_bf16(a2, v2, oa, 0, 0, 0);
    ob = __builtin_amdgcn_mfma_f32_32x32x16_bf16(b2, v2, ob, 0, 0, 0); }
  SBAR(); asm volatile("s_waitcnt lgkmcnt(0)" ::: "memory"); SBAR();
  { const bf16x8 v3 = PK(l3, h3);
    oa = __builtin_amdgcn_mfma_f32_32x32x16_bf16(a3, v3, oa, 0, 0, 0);
    ob = __builtin_amdgcn_mfma_f32_32x32x16_bf16(b3, v3, ob, 0, 0, 0); }
#undef PK
}

__device__ __forceinline__ void attn_epi(const Params& p, f32x16 (&o)[4], const float (&rli)[16], int comp, int qg, int lane, int r32, int hi,
                                         long row0, int h, float* ex, float lam, bool dry) {
  const long gbase_i = (row0 + 4 * hi) * 1024 + h * 128 + r32;
  u16 gv0[8][4];
  if (comp == 0) {
    const u16* gp0 = p.gb + gbase_i;
#pragma unroll
    for (int r = 0; r < 8; ++r) {
      const int ro = ((r & 3) + 8 * (r >> 2)) * 1024;
      gv0[r][0] = gp0[ro]; gv0[r][1] = gp0[ro + 32]; gv0[r][2] = gp0[ro + 64]; gv0[r][3] = gp0[ro + 96];
    }
  }
  __syncthreads();
  if (comp == 1) {
#pragma unroll
    for (int d0 = 0; d0 < 4; ++d0)
#pragma unroll
      for (int r = 0; r < 16; ++r) ex[((qg * 4 + d0) * 16 + r) * 64 + lane] = o[d0][r] * rli[r] * lam;
  }
  __syncthreads();
  if (comp == 0) {
    float ssq[16];
#pragma unroll
    for (int r = 0; r < 16; ++r) ssq[r] = 0.f;
#pragma unroll
    for (int d0 = 0; d0 < 4; ++d0)
#pragma unroll
      for (int r = 0; r < 16; ++r) {
        float v = o[d0][r] * rli[r] - ex[((qg * 4 + d0) * 16 + r) * 64 + lane];
        o[d0][r] = v; ssq[r] += v * v;
      }
#pragma unroll
    for (int r = 0; r < 16; ++r) {
      float s = ssq[r];
      s += __shfl_xor(s, 1); s += __shfl_xor(s, 2); s += __shfl_xor(s, 4); s += __shfl_xor(s, 8); s += __shfl_xor(s, 16);
      ssq[r] = rsqrtf(s * (1.f / 128.f) + EPSF) * (1.f - LAM_INIT);
    }
    float sg[4];
#pragma unroll
    for (int d0 = 0; d0 < 4; ++d0) sg[d0] = p.subln_g[d0 * 32 + r32];
    const u16* gp = p.gb + gbase_i; u16* qp = p.qb + gbase_i;
#pragma unroll
    for (int r = 0; r < 8; ++r) {
      const int ro = ((r & 3) + 8 * (r >> 2)) * 1024;
      if (!dry) {
        qp[ro] = f2bf(o[0][r] * ssq[r] * sg[0] * bf2f(gv0[r][0]));
        qp[ro + 32] = f2bf(o[1][r] * ssq[r] * sg[1] * bf2f(gv0[r][1]));
        qp[ro + 64] = f2bf(o[2][r] * ssq[r] * sg[2] * bf2f(gv0[r][2]));
        qp[ro + 96] = f2bf(o[3][r] * ssq[r] * sg[3] * bf2f(gv0[r][3]));
      }
    }
    SBAR();
    u16 gv1[8][4];
#pragma unroll
    for (int rr = 0; rr < 8; ++rr) {
      const int r = 8 + rr, ro = ((r & 3) + 8 * (r >> 2)) * 1024;
      gv1[rr][0] = gp[ro]; gv1[rr][1] = gp[ro + 32]; gv1[rr][2] = gp[ro + 64]; gv1[rr][3] = gp[ro + 96];
    }
    SBAR();
#pragma unroll
    for (int rr = 0; rr < 8; ++rr) {
      const int r = 8 + rr, ro = ((r & 3) + 8 * (r >> 2)) * 1024;
      if (!dry) {
        qp[ro] = f2bf(o[0][r] * ssq[r] * sg[0] * bf2f(gv1[rr][0]));
        qp[ro + 32] = f2bf(o[1][r] * ssq[r] * sg[1] * bf2f(gv1[rr][1]));
        qp[ro + 64] = f2bf(o[2][r] * ssq[r] * sg[2] * bf2f(gv1[rr][2]));
        qp[ro + 96] = f2bf(o[3][r] * ssq[r] * sg[3] * bf2f(gv1[rr][3]));
      }
    }
  }
}

__device__ __forceinline__ void attn_item2(const Params& p, long tq0, int h, const u16* __restrict__ Kh, const u16* __restrict__ Vh, int seq, char* lds, bool dry) {
  constexpr int LDK = 1024;
  const int tid = opaque_tid(), wid = __builtin_amdgcn_readfirstlane(tid >> 6), lane = tid & 63, r32 = lane & 31, hi = lane >> 5;
  const int comp = wid >> 2, qg = wid & 3;
  u16* V_lds = (u16*)lds; u16* K_lds = (u16*)(lds + 2 * SHM_V);
  float* wsl = (float*)(lds + 2 * SHM_V + 2 * SHM_K) + wid * 128; float* li_a = wsl; float* al_a = wsl + 32; float* li_b = wsl + 64; float* al_b = wsl + 96;
  char* Q_lds = lds + 2 * SHM_V + 2 * SHM_K + 4096;
  float m_a = -1e30f, l_a = 0, m_b = -1e30f, l_b = 0; f32x16 oa[4] = {}, ob[4] = {};
#pragma unroll
  for (int i = 0; i < 8; ++i) {
    int id = tid + i * NTHR; int row = id >> 4, ch = id & 15;
    bf16x8 v = *reinterpret_cast<const bf16x8*>(p.qb + (tq0 + row) * 1024 + h * 128 + ch * 8);
    *reinterpret_cast<bf16x8*>(Q_lds + KSWZ(row, ch * 16)) = v;
  }
  const char* qa_p = Q_lds + (qg * 64) * 256; const char* qb_p = qa_p + 32 * 256;
  const int vb0 = (int)(uintptr_t)V_lds + v_rd_base(lane);
  typedef __attribute__((address_space(3))) unsigned char lds_u8;
  typedef __attribute__((address_space(3))) unsigned lds_u32;
  lds_u8* ldsl = (lds_u8*)lds;
  int koff[2], voff[2];
#pragma unroll
  for (int i = 0; i < 2; ++i) {
    const int offb = ((i * 8 + wid) * 64 + lane) * 16;
    { const int row = offb >> 8, wb = offb & 255, colB = wb ^ ((row & 7) << 4); koff[i] = row * LDK + (colB >> 1); }
    { const int sub = offb >> 9, within = offb & 511, kkh = sub >> 2, cblk = sub & 3, e = within >> 1, kkl = e >> 5, cl = e & 31;
      const int kk = kkh * 8 + kkl, k = (kk & ~0xC) | ((kk & 4) << 1) | ((kk & 8) >> 1); voff[i] = k * LDK + cblk * 32 + cl; }
  }
#define DMA(buf, k0) do { _Pragma("unroll") for (int _i = 0; _i < 2; ++_i) { \
    __builtin_amdgcn_global_load_lds((const unsigned*)(Kh + (long)(k0) * LDK + koff[_i]), (lds_u32*)(ldsl + 2 * SHM_V + (buf) * SHM_K + (_i * 8 + wid) * 1024), 16, 0, 0); \
    __builtin_amdgcn_global_load_lds((const unsigned*)(Vh + (long)(k0) * LDK + voff[_i]), (lds_u32*)(ldsl + (buf) * SHM_V + (_i * 8 + wid) * 1024), 16, 0, 0); } } while (0)
#define RESC2(a, O, AL) do { if (__any((a) < 1.f)) { if (hi == 0) AL[r32] = (a); asm volatile("s_waitcnt lgkmcnt(0)" ::: "memory"); \
    _Pragma("unroll") for (int d = 0; d < 4; ++d) _Pragma("unroll") for (int r = 0; r < 16; ++r) O[d][r] *= AL[crow(r, hi)]; } } while (0)
  const int NT = seq / 64;
  DMA(0, 0); asm volatile("s_waitcnt vmcnt(0)" ::: "memory"); __syncthreads();
  for (int j = 0; j < NT; ++j) {
    const int cur = j & 1;
    if (j + 1 < NT) { if (cur) DMA(0, (j + 1) * 64); else DMA(1, (j + 1) * 64); }
    f32x16 pA0 = {}, pA1 = {}, pB0 = {}, pB1 = {};
    {
      const char* Ks = (const char*)K_lds + cur * SHM_K;
#pragma unroll
      for (int d0 = 0; d0 < 4; ++d0) { const int cb = (comp * 64 + d0 * 16 + hi * 8) * 2;
        bf16x8 k0 = *reinterpret_cast<const bf16x8*>(Ks + KSWZ(r32, cb));
        bf16x8 k1 = *reinterpret_cast<const bf16x8*>(Ks + KSWZ(32 + r32, cb));
        bf16x8 qa = *reinterpret_cast<const bf16x8*>(qa_p + KSWZ(r32, cb));
        bf16x8 qb = *reinterpret_cast<const bf16x8*>(qb_p + KSWZ(r32, cb));
        pA0 = __builtin_amdgcn_mfma_f32_32x32x16_bf16(k0, qa, pA0, 0, 0, 0);
        pA1 = __builtin_amdgcn_mfma_f32_32x32x16_bf16(k1, qa, pA1, 0, 0, 0);
        pB0 = __builtin_amdgcn_mfma_f32_32x32x16_bf16(k0, qb, pB0, 0, 0, 0);
        pB1 = __builtin_amdgcn_mfma_f32_32x32x16_bf16(k1, qb, pB1, 0, 0, 0); SBAR(); }
    }
    float mn, al; bf16x8 a0, a1, a2, a3, b0, b1, b2, b3;
    partialSM(pA0, pA1, m_a, mn, al); RESC2(al, oa, al_a); finishSM(pA0, pA1, al, l_a, a0, a1, a2, a3);
    partialSM(pB0, pB1, m_b, mn, al); RESC2(al, ob, al_b); finishSM(pB0, pB1, al, l_b, b0, b1, b2, b3);
    SBAR();
    const int vb = vb0 + cur * (int)SHM_V;
    pv_two<0>(oa[0], ob[0], vb, a0, a1, a2, a3, b0, b1, b2, b3);
    pv_two<1>(oa[1], ob[1], vb, a0, a1, a2, a3, b0, b1, b2, b3);
    pv_two<2>(oa[2], ob[2], vb, a0, a1, a2, a3, b0, b1, b2, b3);
    pv_two<3>(oa[3], ob[3], vb, a0, a1, a2, a3, b0, b1, b2, b3);
    asm volatile("s_waitcnt vmcnt(0)" ::: "memory");
    __syncthreads();
  }
#undef DMA
#undef RESC2
  if (hi == 0) { li_a[r32] = l_a; li_b[r32] = l_b; } asm volatile("s_waitcnt lgkmcnt(0)" ::: "memory");
  const float lam = p.misc[0];
  float* ex = (float*)lds;
  {
    float rli[16];
#pragma unroll
    for (int r = 0; r < 16; ++r) rli[r] = __builtin_amdgcn_rcpf(li_a[crow(r, hi)]);
    attn_epi(p, oa, rli, comp, qg, lane, r32, hi, tq0 + qg * 64, h, ex, lam, dry);
  }
  {
    float rli[16];
#pragma unroll
    for (int r = 0; r < 16; ++r) rli[r] = __builtin_amdgcn_rcpf(li_b[crow(r, hi)]);
    attn_epi(p, ob, rli, comp, qg, lane, r32, hi, tq0 + qg * 64 + 32, h, ex, lam, dry);
  }
  __syncthreads();
}

__device__ __forceinline__ void conv8(const Params& p, long tok_s, int L, int tpos, int ch0, float (&o)[8]) {
  const u16* base = p.xbc + (tok_s + tpos) * 1536 + ch0;
  bf16x8 r1 = *reinterpret_cast<const bf16x8*>(base);
  bf16x8 r0 = {0, 0, 0, 0, 0, 0, 0, 0}, r2 = {0, 0, 0, 0, 0, 0, 0, 0};
  if (tpos > 0) r0 = *reinterpret_cast<const bf16x8*>(base - 1536);
  if (tpos < L - 1) r2 = *reinterpret_cast<const bf16x8*>(base + 1536);
  const f32x4* w0 = reinterpret_cast<const f32x4*>(p.conv_w + ch0);
  const f32x4* w1 = reinterpret_cast<const f32x4*>(p.conv_w + 1536 + ch0);
  const f32x4* w2 = reinterpret_cast<const f32x4*>(p.conv_w + 3072 + ch0);
  const f32x4* bb = reinterpret_cast<const f32x4*>(p.conv_b + ch0);
  const f32x4 wa0 = w0[0], wa1 = w0[1], wb0 = w1[0], wb1 = w1[1], wc0 = w2[0], wc1 = w2[1], b0 = bb[0], b1 = bb[1];
#pragma unroll
  for (int e = 0; e < 4; ++e) {
    float v = b0[e] + wa0[e] * bfs2f(r0[e]) + wb0[e] * bfs2f(r1[e]) + wc0[e] * bfs2f(r2[e]);
    o[e] = siluf(v);
    float u = b1[e] + wa1[e] * bfs2f(r0[4 + e]) + wb1[e] * bfs2f(r1[4 + e]) + wc1[e] * bfs2f(r2[4 + e]);
    o[4 + e] = siluf(u);
  }
}
__device__ __forceinline__ int rotc(int r, int c) { return (c + ((r >> 3) << 3)) & 127; }
__device__ __forceinline__ void chunk_geom(int cg, long& tok_s, int& L, int& tpos0) {
  if (cg < 32) { tok_s = (long)(cg >> 1) * 256; L = 256; tpos0 = (cg & 1) * 128; }
  else { int cs = cg - 32; tok_s = T_CTX + (long)(cs >> 5) * 4096; L = 4096; tpos0 = (cs & 31) * 128; }
}
__device__ __forceinline__ void ssd_dt_scan(const Params& p, long tok0, int head, float* dtv, float* cum, float* scn, float* tot) {
  const int tid = opaque_tid(), lane = tid & 63, wid = tid >> 6;
  if (tid < 256) {
    int d = tid >> 7, tl = tid & 127;
    float raw = p.dtb[(tok0 + tl) * 32 + d * 16 + head] + p.dt_bias[d * 16 + head];
    float dt = (raw > 20.f) ? raw : log1pf(expf(raw));
    float a = -expf(p.A_log[d * 16 + head]) * dt;
    dtv[d * 128 + tl] = dt;
    int li = d ? 127 - tl : tl;
    scn[d * 128 + li] = a;
  }
  __syncthreads();
  if (wid < 2) {
    int d = wid;
    float a0 = scn[d * 128 + 2 * lane], a1 = scn[d * 128 + 2 * lane + 1];
    float s = a0 + a1;
#pragma unroll
    for (int off = 1; off < 64; off <<= 1) { float t = __shfl_up(s, off); if (lane >= off) s += t; }
    float c0 = s - a1, c1 = s;
    int li0 = 2 * lane, li1 = 2 * lane + 1;
    cum[d * 128 + (d ? 127 - li0 : li0)] = c0;
    cum[d * 128 + (d ? 127 - li1 : li1)] = c1;
    if (lane == 63) tot[d] = c1;
  }
  __syncthreads();
}

__device__ void ssd_state_item(const Params& p, int cg, int head, char* smem, bool dry) {
  const int tid = opaque_tid(), lane = tid & 63, wid = tid >> 6, fr = lane & 15, fq = lane >> 4;
  float* dtv = (float*)smem; float* cum = dtv + 256; float* scn = cum + 256; float* tot = scn + 256;
  u16* XsT = (u16*)(smem + 4096);
  u16* BT = XsT + 64 * 136;
  long tok_s; int L, tpos0; chunk_geom(cg, tok_s, L, tpos0);
  const long tok0 = (long)cg * 128;
  const int g = head >> 2;
  ssd_dt_scan(p, tok0, head, dtv, cum, scn, tot);
  const float tot0 = tot[0], tot1 = tot[1];
#pragma unroll
  for (int rep = 0; rep < 2; ++rep) {
    int id = tid + rep * NTHR; int tl = id >> 3, p0 = (id & 7) * 8;
    float xo[8], bo[8];
    conv8(p, tok_s, L, tpos0 + tl, head * 64 + p0, xo);
    conv8(p, tok_s, L, tpos0 + tl, 1024 + g * 64 + p0, bo);
    float s0 = dtv[tl] * __expf(tot0 - cum[tl]);
    float s1 = dtv[128 + tl] * __expf(tot1 - cum[128 + tl]);
    const int tc = rotc(p0, tl);
#pragma unroll
    for (int e = 0; e < 8; ++e) {
      XsT[(p0 + e) * 136 + tc] = f2bf(xo[e]);
      BT[(p0 + e) * 136 + tc] = f2bf(bo[e] * s0);
      BT[(64 + p0 + e) * 136 + tc] = f2bf(bo[e] * s1);
    }
  }
  __syncthreads();
  {
    const int d = wid >> 2, pb = wid & 3;
    f32x4 acc[4];
#pragma unroll
    for (int ni = 0; ni < 4; ++ni) acc[ni] = f32x4{0.f, 0.f, 0.f, 0.f};
#pragma unroll
    for (int ks = 0; ks < 4; ++ks) {
      bf16x8 a = *reinterpret_cast<const bf16x8*>(XsT + (pb * 16 + fr) * 136 + rotc(pb * 16 + fr, ks * 32 + fq * 8));
#pragma unroll
      for (int ni = 0; ni < 4; ++ni) {
        bf16x8 b = *reinterpret_cast<const bf16x8*>(BT + (d * 64 + ni * 16 + fr) * 136 + rotc(ni * 16 + fr, ks * 32 + fq * 8));
        acc[ni] = mfma16(a, b, acc[ni]);
      }
    }
    u16* dst = p.st + ((long)(cg * 16 + head) * 2 + d) * 4096;
#pragma unroll
    for (int ni = 0; ni < 4; ++ni)
#pragma unroll
      for (int j = 0; j < 4; ++j) { if (!dry) dst[(pb * 16 + fq * 4 + j) * 64 + ni * 16 + fr] = f2bf(acc[ni][j]); }
  }
  if (tid < 2 && !dry) p.cd[(cg * 16 + head) * 2 + tid] = __expf(tot[tid]);
  __syncthreads();
}

__device__ void ssd_state_item2(const Params& p, int it0, char* smem, bool dry) {
  const int tid = opaque_tid(), lane = tid & 63, wid = tid >> 6, fr = lane & 15, fq = lane >> 4;
  constexpr int RSTRIDE = 57344;
  {
    const int u = tid >> 8, t2 = tid & 255, cg = (it0 + u) >> 4, head = (it0 + u) & 15;
    float* dtv = (float*)(smem + u * RSTRIDE); float* scn = dtv + 512;
    const int d = t2 >> 7, tl = t2 & 127;
    float raw = p.dtb[((long)cg * 128 + tl) * 32 + d * 16 + head] + p.dt_bias[d * 16 + head];
    float dt = (raw > 20.f) ? raw : log1pf(expf(raw));
    float a = -expf(p.A_log[d * 16 + head]) * dt;
    dtv[d * 128 + tl] = dt;
    scn[d * 128 + (d ? 127 - tl : tl)] = a;
  }
  __syncthreads();
  if (wid < 4) {
    const int u = wid >> 1, d = wid & 1;
    float* dtv = (float*)(smem + u * RSTRIDE); float* cum = dtv + 256; float* scn = cum + 256; float* tot = scn + 256;
    float a0 = scn[d * 128 + 2 * lane], a1 = scn[d * 128 + 2 * lane + 1];
    float sacc = a0 + a1;
#pragma unroll
    for (int off = 1; off < 64; off <<= 1) { float t = __shfl_up(sacc, off); if (lane >= off) sacc += t; }
    float c0 = sacc - a1, c1 = sacc;
    int li0 = 2 * lane, li1 = 2 * lane + 1;
    cum[d * 128 + (d ? 127 - li0 : li0)] = c0;
    cum[d * 128 + (d ? 127 - li1 : li1)] = c1;
    if (lane == 63) tot[d] = c1;
  }
  __syncthreads();
#pragma unroll
  for (int u = 0; u < 2; ++u) {
    const int cg = (it0 + u) >> 4, head = (it0 + u) & 15, g = head >> 2;
    float* dtv = (float*)(smem + u * RSTRIDE); float* cum = dtv + 256; float* tot = dtv + 768;
    u16* XsT = (u16*)(smem + u * RSTRIDE + 4096); u16* BT = XsT + 64 * 136;
    long tok_s; int L, tpos0; chunk_geom(cg, tok_s, L, tpos0);
    const float tot0 = tot[0], tot1 = tot[1];
#pragma unroll
    for (int rep = 0; rep < 2; ++rep) {
      int id = tid + rep * NTHR; int tl = id >> 3, p0 = (id & 7) * 8;
      float xo[8], bo[8];
      conv8(p, tok_s, L, tpos0 + tl, head * 64 + p0, xo);
      conv8(p, tok_s, L, tpos0 + tl, 1024 + g * 64 + p0, bo);
      float s0 = dtv[tl] * __expf(tot0 - cum[tl]);
      float s1 = dtv[128 + tl] * __expf(tot1 - cum[128 + tl]);
      const int tc = rotc(p0, tl);
#pragma unroll
      for (int e = 0; e < 8; ++e) {
        XsT[(p0 + e) * 136 + tc] = f2bf(xo[e]);
        BT[(p0 + e) * 136 + tc] = f2bf(bo[e] * s0);
        BT[(64 + p0 + e) * 136 + tc] = f2bf(bo[e] * s1);
      }
    }
  }
  __syncthreads();
#pragma unroll
  for (int u = 0; u < 2; ++u) {
    const int cg = (it0 + u) >> 4, head = (it0 + u) & 15;
    const u16* XsT = (const u16*)(smem + u * RSTRIDE + 4096); const u16* BT = XsT + 64 * 136;
    const float* tot = (const float*)(smem + u * RSTRIDE) + 768;
    const int d = wid >> 2, pb = wid & 3;
    f32x4 acc[4];
#pragma unroll
    for (int ni = 0; ni < 4; ++ni) acc[ni] = f32x4{0.f, 0.f, 0.f, 0.f};
#pragma unroll
    for (int ks = 0; ks < 4; ++ks) {
      bf16x8 a = *reinterpret_cast<const bf16x8*>(XsT + (pb * 16 + fr) * 136 + rotc(pb * 16 + fr, ks * 32 + fq * 8));
#pragma unroll
      for (int ni = 0; ni < 4; ++ni) {
        bf16x8 b = *reinterpret_cast<const bf16x8*>(BT + (d * 64 + ni * 16 + fr) * 136 + rotc(ni * 16 + fr, ks * 32 + fq * 8));
        acc[ni] = mfma16(a, b, acc[ni]);
      }
    }
    u16* dst = p.st + ((long)(cg * 16 + head) * 2 + d) * 4096;
#pragma unroll
    for (int ni = 0; ni < 4; ++ni)
#pragma unroll
      for (int j = 0; j < 4; ++j) { if (!dry) dst[(pb * 16 + fq * 4 + j) * 64 + ni * 16 + fr] = f2bf(acc[ni][j]); }
    if (tid < 2 && !dry) p.cd[(cg * 16 + head) * 2 + tid] = __expf(tot[tid]);
  }
  __syncthreads();
}

__device__ void phase3_attn(const Params& p, char* smem, bool dry) {
  constexpr int N_AS = 512, N_AC = 128;
  for (int it = blockIdx.x; it < N_AS + N_AC; it += gridDim.x) {
    long tq0; int h, seq; const u16 *kp, *vp;
    if (it < N_AS) {
      int qbi = it & 15, b = it >> 7; h = (it >> 4) & 7;
      if (gridDim.x == 256) {
        const int r = it >> 8, bid = it & 255, slot = bid >> 3;
        const int bh = r * 16 + (bid & 7) * 2 + (slot >> 4);
        qbi = slot & 15; b = bh >> 3; h = bh & 7;
      }
      tq0 = T_CTX + (long)b * 4096 + qbi * 256; seq = 4608;
      kp = p.kS + (long)b * 4608 * 1024 + h * 128; vp = p.vS + (long)b * 4608 * 1024 + h * 128;
    } else {
      int i = it - N_AS; int b = i >> 3; h = i & 7;
      tq0 = (long)b * 256; seq = 256;
      kp = p.kC + (long)b * 256 * 1024 + h * 128; vp = p.vC + (long)b * 256 * 1024 + h * 128;
    }
    attn_item2(p, tq0, h, kp, vp, seq, smem, dry);
  }
}
__device__ void phase3_state(const Params& p, char* smem, bool dry) {
  int start = blockIdx.x, stride = gridDim.x, cnt = (160 * 8 - (int)blockIdx.x + (int)gridDim.x - 1) / (int)gridDim.x;
  if (gridDim.x == 256) { stride = 128; if (blockIdx.x < 128) { start = blockIdx.x; cnt = 4; } else { start = 512 + (blockIdx.x - 128); cnt = 6; } }
#pragma unroll 1
  for (int k = 0; k < cnt; ++k) ssd_state_item2(p, (start + k * stride) * 2, smem, dry);
}
__device__ void phase3(const Params& p, char* smem) {
  if (p.probe & 8) phase3_attn(p, smem, true);
  if (p.probe & 16) phase3_state(p, smem, true);
  phase3_attn(p, smem, false);
  phase3_state(p, smem, false);
}

__device__ void phase4(const Params& p, char* smem) {
  const int tid = opaque_tid();
  for (int it = blockIdx.x; it < 256 + 1024; it += gridDim.x) {
    int seq, head, d, half, nc, c0; const float* h0p = nullptr; float* outp = nullptr;
    if (it < 256) { half = it & 1; d = (it >> 1) & 1; head = (it >> 2) & 15; int b = it >> 6; seq = 16 + b; nc = 32; c0 = 32 + b * 32;
      h0p = p.state_ssd + ((long)(b * 2 + d) * 16 + head) * 4096; }
    else { int i = it - 256; half = i & 1; d = (i >> 1) & 1; head = (i >> 2) & 15; int b = i >> 6; seq = b; nc = 2; c0 = b * 2;
      outp = p.out + 29360128L + ((long)(b * 2 + d) * 16 + head) * 4096; }
    (void)seq;
    const int e = half * 2048 + tid * 4;
    float h[4] = {0.f, 0.f, 0.f, 0.f};
    if (h0p) { float4 v = *reinterpret_cast<const float4*>(h0p + e); h[0] = v.x; h[1] = v.y; h[2] = v.z; h[3] = v.w; }
    const int cstart = d ? c0 + nc - 1 : c0, cstep = d ? -1 : 1;
    for (int i0 = 0; i0 < nc; i0 += 8) {
      u32x2 sv[8]; float dc[8];
#pragma unroll
      for (int k = 0; k < 8; ++k) if (i0 + k < nc) {
        int cgi = cstart + (i0 + k) * cstep;
        sv[k] = *reinterpret_cast<const u32x2*>(p.st + ((long)(cgi * 16 + head) * 2 + d) * 4096 + e);
        dc[k] = p.cd[(cgi * 16 + head) * 2 + d];
      }
#pragma unroll
      for (int k = 0; k < 8; ++k) if (i0 + k < nc) {
        int cgi = cstart + (i0 + k) * cstep;
        u32x2 hw = {cvtpk(h[0], h[1]), cvtpk(h[2], h[3])};
        *reinterpret_cast<u32x2*>(p.st + ((long)(cgi * 16 + head) * 2 + d) * 4096 + e) = hw;
        float s0 = __uint_as_float(sv[k][0] << 16), s1 = __uint_as_float(sv[k][0] & 0xffff0000u);
        float s2 = __uint_as_float(sv[k][1] << 16), s3 = __uint_as_float(sv[k][1] & 0xffff0000u);
        h[0] = h[0] * dc[k] + s0; h[1] = h[1] * dc[k] + s1; h[2] = h[2] * dc[k] + s2; h[3] = h[3] * dc[k] + s3;
      }
    }
    if (outp) { float4 v = {h[0], h[1], h[2], h[3]}; *reinterpret_cast<float4*>(outp + e) = v; }
  }
}

__device__ void ssd_y_item(const Params& p, int cg, int head, char* smem, bool dry) {
  const int tid = opaque_tid(), lane = tid & 63, wid = tid >> 6, fr = lane & 15, fq = lane >> 4;
  float* dtv = (float*)smem; float* cum = dtv + 256; float* scn = cum + 256; float* tot = scn + 256;
  u16* XT = (u16*)(smem + 4096);
  u16* Cs = XT + 64 * 136;
  u16* Bs = Cs + 128 * 72;
  u16* Ms = Bs + 128 * 72;
  u16* Hs = Ms + 128 * 136;
  long tok_s; int L, tpos0; chunk_geom(cg, tok_s, L, tpos0);
  const long tok0 = (long)cg * 128;
  const int g = head >> 2;
  bf16x8 hpre[2];
  {
    const int pp = tid >> 3, ch = (tid & 7) * 8;
    hpre[0] = *reinterpret_cast<const bf16x8*>(p.st + ((long)(cg * 16 + head) * 2 + 0) * 4096 + pp * 64 + ch);
    hpre[1] = *reinterpret_cast<const bf16x8*>(p.st + ((long)(cg * 16 + head) * 2 + 1) * 4096 + pp * 64 + ch);
  }
  ssd_dt_scan(p, tok0, head, dtv, cum, scn, tot);
#pragma unroll
  for (int rep = 0; rep < 2; ++rep) {
    int id = tid + rep * NTHR; int tl = id >> 3, p0 = (id & 7) * 8;
    float xo[8], bo[8], co[8];
    conv8(p, tok_s, L, tpos0 + tl, head * 64 + p0, xo);
    conv8(p, tok_s, L, tpos0 + tl, 1024 + g * 64 + p0, bo);
    conv8(p, tok_s, L, tpos0 + tl, 1280 + g * 64 + p0, co);
#pragma unroll
    for (int e = 0; e < 8; ++e) XT[(p0 + e) * 136 + rotc(p0, tl)] = f2bf(xo[e]);
    *reinterpret_cast<bf16x8*>(Bs + tl * 72 + p0) = pack8(bo);
    *reinterpret_cast<bf16x8*>(Cs + tl * 72 + p0) = pack8(co);
  }
  __syncthreads();
  f32x4 cb[8];
#pragma unroll
  for (int si = 0; si < 8; ++si) cb[si] = f32x4{0.f, 0.f, 0.f, 0.f};
#pragma unroll
  for (int ks = 0; ks < 2; ++ks) {
    bf16x8 a = *reinterpret_cast<const bf16x8*>(Cs + (wid * 16 + fr) * 72 + ks * 32 + fq * 8);
#pragma unroll
    for (int si = 0; si < 8; ++si) {
      bf16x8 b = *reinterpret_cast<const bf16x8*>(Bs + (si * 16 + fr) * 72 + ks * 32 + fq * 8);
      cb[si] = mfma16(a, b, cb[si]);
    }
  }
  f32x4 yacc[4];
#pragma unroll
  for (int pi = 0; pi < 4; ++pi) yacc[pi] = f32x4{0.f, 0.f, 0.f, 0.f};
  u16 zpre[4][4];
#pragma unroll
  for (int j = 0; j < 4; ++j)
#pragma unroll
    for (int pi = 0; pi < 4; ++pi) zpre[j][pi] = p.zb[(tok0 + wid * 16 + fq * 4 + j) * 1024 + head * 64 + pi * 16 + fr];
  {
    {
      int pp = tid >> 3, ch = (tid & 7) * 8;
      *reinterpret_cast<bf16x8*>(Hs + pp * 72 + ch) = hpre[0];
      *reinterpret_cast<bf16x8*>(Hs + 64 * 72 + pp * 72 + ch) = hpre[1];
    }
    float cq0[4], cq1[4];
#pragma unroll
    for (int j = 0; j < 4; ++j) { cq0[j] = cum[wid * 16 + fq * 4 + j]; cq1[j] = cum[128 + wid * 16 + fq * 4 + j]; }
#pragma unroll
    for (int si = 0; si < 8; ++si) {
      const int s = si * 16 + fr;
      const float cs0 = cum[s], cs1 = cum[128 + s], dt0 = dtv[s], dt1 = dtv[128 + s];
#pragma unroll
      for (int j = 0; j < 4; ++j) {
        const int q = wid * 16 + fq * 4 + j;
        const float arg = (s < q) ? (cq0[j] - cs0) : (cq1[j] - cs1);
        const float w = (s < q) ? dt0 : ((s > q) ? dt1 : dt0 + dt1);
        const float v = cb[si][j] * __expf((s == q) ? 0.f : arg) * w;
        Ms[q * 136 + s] = f2bf(v);
      }
    }
    __syncthreads();
    f32x4 tmp0[4], tmp1[4];
#pragma unroll
    for (int pi = 0; pi < 4; ++pi) { tmp0[pi] = f32x4{0.f, 0.f, 0.f, 0.f}; tmp1[pi] = f32x4{0.f, 0.f, 0.f, 0.f}; }
#pragma unroll
    for (int ks = 0; ks < 4; ++ks) {
      bf16x8 a = *reinterpret_cast<const bf16x8*>(Ms + (wid * 16 + fr) * 136 + ks * 32 + fq * 8);
#pragma unroll
      for (int pi = 0; pi < 4; ++pi) {
        bf16x8 b = *reinterpret_cast<const bf16x8*>(XT + (pi * 16 + fr) * 136 + rotc(pi * 16 + fr, ks * 32 + fq * 8));
        yacc[pi] = mfma16(a, b, yacc[pi]);
      }
    }
#pragma unroll
    for (int ks = 0; ks < 2; ++ks) {
      bf16x8 a = *reinterpret_cast<const bf16x8*>(Cs + (wid * 16 + fr) * 72 + ks * 32 + fq * 8);
#pragma unroll
      for (int pi = 0; pi < 4; ++pi) {
        bf16x8 b0 = *reinterpret_cast<const bf16x8*>(Hs + (pi * 16 + fr) * 72 + ks * 32 + fq * 8);
        bf16x8 b1 = *reinterpret_cast<const bf16x8*>(Hs + 64 * 72 + (pi * 16 + fr) * 72 + ks * 32 + fq * 8);
        tmp0[pi] = mfma16(a, b0, tmp0[pi]);
        tmp1[pi] = mfma16(a, b1, tmp1[pi]);
      }
    }
#pragma unroll
    for (int j = 0; j < 4; ++j) {
      const float e0 = __expf(cq0[j]), e1 = __expf(cq1[j]);
#pragma unroll
      for (int pi = 0; pi < 4; ++pi) yacc[pi][j] += e0 * tmp0[pi][j] + e1 * tmp1[pi][j];
    }
  }
  const float dsk = p.D_skip[head];
#pragma unroll
  for (int j = 0; j < 4; ++j) {
    int q = wid * 16 + fq * 4 + j;
    float ss = 0.f;
#pragma unroll
    for (int pi = 0; pi < 4; ++pi) {
      int pp = pi * 16 + fr;
      long idx = (tok0 + q) * 1024 + head * 64 + pp;
      float y = yacc[pi][j] + dsk * bf2f(XT[pp * 136 + rotc(pp, q)]);
      float yg = y * bf2f(zpre[j][pi]);
      if (!dry) p.zb[idx] = f2bf(yg);
      ss += yg * yg;
    }
    ss += __shfl_xor(ss, 1); ss += __shfl_xor(ss, 2); ss += __shfl_xor(ss, 4); ss += __shfl_xor(ss, 8);
    if (fr == 0 && !dry) p.ssqp[(tok0 + q) * 16 + head] = ss;
  }
  __syncthreads();
}
__device__ void phase5(const Params& p, char* smem) {
  if (p.probe & 32) { for (int it = blockIdx.x; it < 160 * 16; it += gridDim.x) ssd_y_item(p, it >> 4, it & 15, smem, true); }
  for (int it = blockIdx.x; it < 160 * 16; it += gridDim.x) ssd_y_item(p, it >> 4, it & 15, smem, false);
}

struct SegOrder : pg8::StaticOrder {
  __device__ bool next(int i, pg8::Unit& u) const {
    if (G != 256 || nwg != 320) { if (!tile_at((long)(i >> 1) * G + c, u)) return false; u.seg = i & 1; return true; }
    if (i < 2) { tile_at(c, u); u.seg = i; return true; }
    if (i > 2 || c >= 128) return false;
    const int t2 = c & 63;
    tile_at(256 + t2, u); u.seg = c >> 6; u.split = 1 + t2; return true;
  }
};
struct EpiOut {
  static constexpr bool PERM = true, AFTER_DRAIN = false, KEEP = true;
  const Params& p;
  __device__ __forceinline__ void operator()(f32x4 (&acc)[2][2][4][2], const pg8::Unit& u, int wr, int wc, int fr, int fq) const {
    const int m0 = u.pm * 256, n0 = u.pn * 256;
    if (u.seg == 0) {
#pragma unroll
      for (int ai = 0; ai < 2; ++ai) {
        f32x4 sv[4][4];
#pragma unroll
        for (int m = 0; m < 4; ++m) {
          const int t = m0 + ai * 128 + wr * 64 + m * 16 + fr;
          const f32x4* sp = reinterpret_cast<const f32x4*>(p.ssqp + (long)t * 16);
          sv[m][0] = sp[0]; sv[m][1] = sp[1]; sv[m][2] = sp[2]; sv[m][3] = sp[3];
        }
        SBAR();
#pragma unroll
        for (int m = 0; m < 4; ++m) {
          const f32x4 sa = sv[m][0] + sv[m][1] + sv[m][2] + sv[m][3];
          const float r = rsqrtf((sa[0] + sa[1] + sa[2] + sa[3]) * (1.f / 1024.f) + EPSF);
#pragma unroll
          for (int bj = 0; bj < 2; ++bj)
#pragma unroll
            for (int n = 0; n < 2; ++n) acc[ai][bj][m][n] *= r;
        }
        SBAR();
      }
      if (u.split) {
        const int wid = wr * 4 + wc, lane = fq * 16 + fr;
        float* sc = reinterpret_cast<float*>(p.st) + (size_t)(u.split - 1) * 65536 + (wid * 64 + lane) * 4;
#pragma unroll
        for (int ai = 0; ai < 2; ++ai)
#pragma unroll
          for (int bj = 0; bj < 2; ++bj)
#pragma unroll
            for (int m = 0; m < 4; ++m)
              { *reinterpret_cast<f32x4*>(sc + ((((ai * 2 + bj) * 4 + m) * 2 + 0) * 2048)) = acc[ai][bj][m][0]; *reinterpret_cast<f32x4*>(sc + ((((ai * 2 + bj) * 4 + m) * 2 + 1) * 2048)) = acc[ai][bj][m][1]; }
        __builtin_amdgcn_fence(__ATOMIC_RELEASE, "agent");
        asm volatile("s_waitcnt vmcnt(0)" ::: "memory");
        if (lane == 0) __hip_atomic_fetch_add(p.bar + SPLIT_FLAG0 + (u.split - 1), 1u, __ATOMIC_RELAXED, __HIP_MEMORY_SCOPE_AGENT);
      }
      return;
    }
    if (u.split) {
      const int wid = wr * 4 + wc, lane = fq * 16 + fr;
      unsigned* fl = p.bar + SPLIT_FLAG0 + (u.split - 1);
      unsigned sp = 0;
      while (__hip_atomic_load(fl, __ATOMIC_RELAXED, __HIP_MEMORY_SCOPE_AGENT) < 8u) { __builtin_amdgcn_s_sleep(2); if (++sp > (1u << 22)) break; }
      __builtin_amdgcn_fence(__ATOMIC_ACQUIRE, "agent");
      asm volatile("s_waitcnt vmcnt(0)" ::: "memory");
    }
    const int mr = (m0 < T_CTX) ? 0 : 1 + ((m0 - T_CTX) >> 12);
    const float* xb = (m0 < T_CTX) ? p.x_prompt + (long)m0 * 1024 : p.x_sample + (long)(m0 - T_CTX) * 1024;
    const int c0 = n0 + wc * 32 + 8 * fq;
    const float* gbase = p.modv + mr * 3072 + 2048 + c0;
    const bool spl = (u.split != 0);
    const int pstr = spl ? 2048 : 0;
    const float* pbase = spl ? reinterpret_cast<const float*>(p.st) + (size_t)(u.split - 1) * 65536 + ((wr * 4 + wc) * 64 + fq * 16 + fr) * 4
                             : reinterpret_cast<const float*>(p.bar + SPLIT_FLAG0 + 64);
#pragma unroll
    for (int ai = 0; ai < 2; ++ai)
#pragma unroll
      for (int mp = 0; mp < 2; ++mp) {
        f32x4 xv[2][2][2];
#pragma unroll
        for (int mm = 0; mm < 2; ++mm) {
          const int m = mp * 2 + mm, rl = ai * 128 + wr * 64 + m * 16 + fr;
          const float* xr = xb + rl * 1024 + c0;
#pragma unroll
          for (int bj = 0; bj < 2; ++bj) {
            xv[mm][bj][0] = *reinterpret_cast<const f32x4*>(xr + bj * 128); xv[mm][bj][1] = *reinterpret_cast<const f32x4*>(xr + bj * 128 + 4);
          }
        }
        SBAR();
#pragma unroll
        for (int mm = 0; mm < 2; ++mm) {
          const int m = mp * 2 + mm, rl = ai * 128 + wr * 64 + m * 16 + fr;
          u16* orow = p.kC + (long)(m0 + rl) * 1024 + c0;
          const float* gp = gbase; asm volatile("" : "+v"(gp));
          float ss = 0.f;
#pragma unroll
          for (int bj = 0; bj < 2; ++bj) {
            const f32x4 g0 = *reinterpret_cast<const f32x4*>(gp + bj * 128), g1 = *reinterpret_cast<const f32x4*>(gp + bj * 128 + 4);
            const f32x4 q0 = *reinterpret_cast<const f32x4*>(pbase + ((((ai * 2 + bj) * 4 + m) * 2 + 0) * pstr));
            const f32x4 q1 = *reinterpret_cast<const f32x4*>(pbase + ((((ai * 2 + bj) * 4 + m) * 2 + 1) * pstr));
            f32x4 v0 = xv[mm][bj][0] + g0 * (acc[ai][bj][m][0] + q0);
            f32x4 v1 = xv[mm][bj][1] + g1 * (acc[ai][bj][m][1] + q1);
            u32x4 w = {cvtpk(v0[0], v0[1]), cvtpk(v0[2], v0[3]), cvtpk(v1[0], v1[1]), cvtpk(v1[2], v1[3])};
            *reinterpret_cast<u32x4*>(orow + bj * 128) = w;
#pragma unroll
            for (int e = 0; e < 4; ++e) {
              float lo = __uint_as_float(w[e] << 16), hi = __uint_as_float(w[e] & 0xffff0000u);
              ss += lo * lo + hi * hi;
            }
          }
          ss += __shfl_xor(ss, 16); ss += __shfl_xor(ss, 32);
          if (fq == 0) p.ssq2p[(long)(m0 + rl) * 16 + u.pn * 4 + wc] = ss;
        }
        SBAR();
      }
  }
};
__device__ void phase6(const Params& p, char* smem) {
  SegOrder S; S.init(T_ALL, 1024, (int)gridDim.x, (int)blockIdx.x);
  pg8::Gemm g{p.zb, p.woutT + 1024 * 1024, T_ALL, 1024, 1024, p.qb, p.woutT};
  EpiOut E{p};
  pg8::gemm_phase<EpiOut, SegOrder, false>((PG8_LAS unsigned char*)smem, g, S, E, nullptr);
  __syncthreads();
}

__device__ void phase7(const Params& p, char* smem) {
  const int tid = opaque_tid(), lane = tid & 63, wid = tid >> 6;
  for (int it = blockIdx.x; it < T_ALL / 32; it += gridDim.x) {
    u32x2 w[4][4]; float sq[4];
#pragma unroll
    for (int rr = 0; rr < 4; ++rr) {
      const int t = it * 32 + rr * 8 + wid;
      const u16* xr = p.kC + (long)t * 1024;
#pragma unroll
      for (int i = 0; i < 4; ++i) w[rr][i] = *reinterpret_cast<const u32x2*>(xr + i * 256 + lane * 4);
      sq[rr] = (lane < 16) ? p.ssq2p[(long)t * 16 + lane] : 0.f;
    }
#pragma unroll
    for (int rr = 0; rr < 4; ++rr) {
      const int t = it * 32 + rr * 8 + wid;
      float s = sq[rr];
      s += __shfl_xor(s, 1); s += __shfl_xor(s, 2); s += __shfl_xor(s, 4); s += __shfl_xor(s, 8);
      s = __shfl(s, 0);
      const float rs = rsqrtf(s * (1.f / 1024.f) + EPSF);
      float* yr = p.out + (long)t * 1024;
#pragma unroll
      for (int i = 0; i < 4; ++i) {
        int col = i * 256 + lane * 4;
        float4 g = *reinterpret_cast<const float4*>(p.final_g + col);
        float4 v;
        v.x = __uint_as_float(w[rr][i][0] << 16) * rs * g.x; v.y = __uint_as_float(w[rr][i][0] & 0xffff0000u) * rs * g.y;
        v.z = __uint_as_float(w[rr][i][1] << 16) * rs * g.z; v.w = __uint_as_float(w[rr][i][1] & 0xffff0000u) * rs * g.w;
        __builtin_nontemporal_store(v.x, yr + col); __builtin_nontemporal_store(v.y, yr + col + 1);
        __builtin_nontemporal_store(v.z, yr + col + 2); __builtin_nontemporal_store(v.w, yr + col + 3);
      }
    }
  }
}

#define XB_TMO      128
#define XB_XCNT(j)  (256  + 64 * (j))
#define XB_XSUB(j)  (1280 + 64 * (j))
#define XB_XGEN(j)  (2304 + 64 * (j))
#define XB_TOP      3328
#define XB_TOPGEN   3392
#define XCD_BAR_WORDS 3456
#define XB_SPIN_CAP (1u << 18)
#define XLAS __attribute__((address_space(3)))

__device__ __forceinline__ unsigned xb_ld(unsigned* p)              { return __hip_atomic_load(p, __ATOMIC_RELAXED, __HIP_MEMORY_SCOPE_AGENT); }
__device__ __forceinline__ unsigned xb_add(unsigned* p, unsigned v) { return __hip_atomic_fetch_add(p, v, __ATOMIC_RELAXED, __HIP_MEMORY_SCOPE_AGENT); }
__device__ __forceinline__ unsigned xb_xcc_id() { return (unsigned)__builtin_amdgcn_s_getreg((3 << 11) | 20) & 0xFu; }
#define XB_SPIN(cond, bar) do { unsigned _sp = 0; while (cond) { __builtin_amdgcn_s_sleep(1); \
    if ((++_sp & 255u) == 0u) { if (xb_ld(&(bar)[XB_TMO])) break; if (_sp > XB_SPIN_CAP) { atomicAdd(&(bar)[XB_TMO], 1u); break; } } } } while (0)

struct XcdBarrier {
    unsigned* bar; unsigned x;
    volatile XLAS unsigned* st;
};

__device__ __forceinline__ XcdBarrier xcd_barrier_post(unsigned* bar, volatile XLAS unsigned* st) {
    XcdBarrier b; b.bar = bar; b.x = xb_xcc_id(); b.st = st;
    if (threadIdx.x == 0) (void)xb_add(&bar[XB_XCNT(b.x)], 1u);
    return b;
}
__device__ __forceinline__ void xcd_barrier_complete(unsigned* bar, unsigned x, unsigned& nloc, unsigned& nx) {
    const unsigned G = gridDim.x * gridDim.y * gridDim.z;
    unsigned sum, cnt, mine, sp = 0u;
    for (;;) {
        sum = 0u; cnt = 0u; mine = 0u;
#pragma unroll
        for (unsigned j = 0; j < 16; ++j) { const unsigned c = xb_ld(&bar[XB_XCNT(j)]); sum += c; cnt += (c > 0u) ? 1u : 0u; mine = (j == x) ? c : mine; }
        if (sum == G) break;
        __builtin_amdgcn_s_sleep(1);
        if ((++sp & 255u) == 0u) { if (xb_ld(&bar[XB_TMO])) break; if (sp > XB_SPIN_CAP) { atomicAdd(&bar[XB_TMO], 1u); break; } }
    }
    nloc = mine > 0u ? mine : 1u; nx = cnt > 0u ? cnt : 1u;
}

__device__ __forceinline__ void xcd_barrier(const XcdBarrier& b) {
    asm volatile("s_waitcnt vmcnt(0)" ::: "memory");
    __syncthreads();
    if (threadIdx.x == 0) {
        unsigned* bar = b.bar;
        __builtin_amdgcn_s_waitcnt(0);
        unsigned nloc = b.st[0], nx = b.st[1];
        if (nloc == 0u) { xcd_barrier_complete(bar, b.x, nloc, nx); b.st[0] = nloc; b.st[1] = nx; }
        const unsigned old = xb_add(&bar[XB_XSUB(b.x)], 1u);
        const unsigned gen = old / nloc;
        if (old + 1u == (gen + 1u) * nloc) {
            __builtin_amdgcn_fence(__ATOMIC_RELEASE, "agent");
            asm volatile("s_waitcnt vmcnt(0)" ::: "memory");
            const unsigned og = xb_add(&bar[XB_TOP], 1u);
            const unsigned tg = og / nx;
            if (og + 1u == (tg + 1u) * nx) xb_add(&bar[XB_TOPGEN], 1u);
            else XB_SPIN(xb_ld(&bar[XB_TOPGEN]) == tg, bar);
            __builtin_amdgcn_fence(__ATOMIC_ACQUIRE, "agent");
            xb_add(&bar[XB_XGEN(b.x)], 1u);
            asm volatile("s_waitcnt vmcnt(0)" ::: "memory");
        } else {
            XB_SPIN(xb_ld(&bar[XB_XGEN(b.x)]) == gen, bar);
            __builtin_amdgcn_fence(__ATOMIC_ACQUIRE, "agent");
            asm volatile("s_waitcnt vmcnt(0)" ::: "memory");
        }
    }
    __syncthreads();
}

template <int PH> __device__ __forceinline__ void run_phase(const Params& p, char* smem) {
  if constexpr (PH == 0) phase0(p, smem);
  if constexpr (PH == 1) phase1(p, smem);
  if constexpr (PH == 2) phase2(p, smem);
  if constexpr (PH == 3) phase3(p, smem);
  if constexpr (PH == 4) phase4(p, smem);
  if constexpr (PH == 5) phase5(p, smem);
  if constexpr (PH == 6) phase6(p, smem);
  if constexpr (PH == 7) phase7(p, smem);
}

#if MK_COOP
__global__ void __launch_bounds__(NTHR) fwd_megakernel(Params p) {
  extern __shared__ __attribute__((aligned(16))) char smem[];
  cg::grid_group grid = cg::this_grid();
  __shared__ unsigned xb_st[4];
  if (threadIdx.x < 4) xb_st[threadIdx.x] = 0u;
  __syncthreads();
  if (p.probe == 0x7fffffff) grid.sync();
  const XcdBarrier xb = xcd_barrier_post(p.bar, (volatile XLAS unsigned*)xb_st);
  for (int r = 0; r < REP0; ++r) { phase0(p, smem); xcd_barrier(xb); }
  for (int r = 0; r < REP1; ++r) { phase1(p, smem); xcd_barrier(xb); }
  for (int r = 0; r < REP2; ++r) { phase2(p, smem); xcd_barrier(xb); }
  phase3(p, smem); xcd_barrier(xb);
  phase4(p, smem); xcd_barrier(xb);
  phase5(p, smem); xcd_barrier(xb);
  for (int r = 0; r < REP6; ++r) { phase6(p, smem); xcd_barrier(xb); }
  phase7(p, smem);
}
#else
template <int PH> __global__ void __launch_bounds__(NTHR) phase_kernel(Params p) {
  extern __shared__ __attribute__((aligned(16))) char smem[];
  run_phase<PH>(p, smem);
}
#endif

#ifndef XLAST
#define XLAST
#endif
#ifndef LAST_PHASE
#define LAST_PHASE 7
#endif
__global__ void dbg_copy(const uint4* __restrict__ src, uint4* __restrict__ dst, long n16) {
  for (long i = blockIdx.x * 256L + threadIdx.x; i < n16; i += gridDim.x * 256L) dst[i] = src[i];
}
extern "C" void kernel_launch(void* const* d_in, const int* in_sizes, int n_in, void* d_out, int out_size, void* d_ws, size_t ws_size,
                              hipStream_t stream) {
  Params p;
  memset(&p, 0, sizeof(p));
  const float* const* in = (const float* const*)d_in;
  p.x_prompt = in[0]; p.x_sample = in[1]; p.cache_k = in[2]; p.cache_v = in[3]; p.state_ssd = in[4]; p.c = in[5]; p.c_ctx = in[6];
  p.w_mod = in[7]; p.b_mod = in[8]; p.norm_g = in[9]; p.w_in = in[10]; p.lq1 = in[11]; p.lk1 = in[12]; p.lq2 = in[13]; p.lk2 = in[14];
  p.subln_g = in[15]; p.conv_w = in[16]; p.conv_b = in[17]; p.dt_bias = in[18]; p.A_log = in[19]; p.D_skip = in[20];
  p.ssd_norm_g = in[21]; p.w_out = in[22]; p.final_g = in[23];
  p.out = (float*)d_out;
  p.probe = PROBE_MASK;
  char* w = (char*)d_ws; size_t off = 0;
  auto take = [&](size_t bytes) { char* r = w + off; off += (bytes + 255) & ~(size_t)255; return r; };
  p.winT = (u16*)take((size_t)NPADW * 1024 * 2);
  p.woutT = (u16*)take((size_t)1024 * 2048 * 2);
  p.qb = (u16*)take((size_t)T_ALL * 1024 * 2);
  p.kC = (u16*)take((size_t)T_CTX * 1024 * 2);
  p.kS = (u16*)take((size_t)4 * 4608 * 1024 * 2);
  p.vC = (u16*)take((size_t)T_CTX * 1024 * 2);
  p.vS = (u16*)take((size_t)4 * 4608 * 1024 * 2);
  p.zb = (u16*)take((size_t)T_ALL * 1024 * 2);
  p.xbc = (u16*)take((size_t)T_ALL * 1536 * 2);
  p.dtb = (float*)take((size_t)T_ALL * 32 * 4);
  p.modv = (float*)take((size_t)5 * 3072 * 4);
  p.rope = (float*)take((size_t)64 * 16 * 2 * 4);
  p.misc = (float*)take(256);
  p.cd = (float*)take((size_t)160 * 16 * 2 * 4);
  p.ssqp = (float*)take((size_t)T_ALL * 16 * 4);
  p.ssq2p = (float*)take((size_t)T_ALL * 16 * 4);
  p.bar = (unsigned*)take((size_t)(XCD_BAR_WORDS + 64 + 65536) * 4);
  if (off > ws_size) { fprintf(stderr, "kernel_launch: workspace too small: need %zu have %zu\n", off, ws_size); return; }
  p.hb = (u16*)d_out;
  p.st = (u16*)d_out;
  p.gb = (u16*)d_out + (size_t)T_ALL * 1024;

#if MK_COOP
  static int grid_blocks = 0;
  if (!grid_blocks) {
    int dev = 0, cus = 0, per_cu = 0;
    hipGetDevice(&dev);
    hipDeviceGetAttribute(&cus, hipDeviceAttributeMultiprocessorCount, dev);
    hipFuncSetAttribute((const void*)fwd_megakernel, hipFuncAttributeMaxDynamicSharedMemorySize, LDS_BYTES);
    hipOccupancyMaxActiveBlocksPerMultiprocessor(&per_cu, (const void*)fwd_megakernel, NTHR, LDS_BYTES);
    if (per_cu < 1) per_cu = 1;
    grid_blocks = cus * per_cu;
  }
  (void)hipMemsetAsync(p.bar, 0, (size_t)(XCD_BAR_WORDS + 64 + 65536) * 4, stream);
  void* args[] = {&p};
  hipError_t e = hipLaunchCooperativeKernel((const void*)fwd_megakernel, dim3(grid_blocks), dim3(NTHR), args, LDS_BYTES, stream);
  if (e != hipSuccess) fprintf(stderr, "cooperative launch failed: %s (grid %d)\n", hipGetErrorString(e), grid_blocks);
#else
  static int attr_done = 0;
  if (!attr_done) {
    hipFuncSetAttribute((const void*)phase_kernel<0>, hipFuncAttributeMaxDynamicSharedMemorySize, LDS_BYTES);
    hipFuncSetAttribute((const void*)phase_kernel<1>, hipFuncAttributeMaxDynamicSharedMemorySize, LDS_BYTES);
    hipFuncSetAttribute((const void*)phase_kernel<2>, hipFuncAttributeMaxDynamicSharedMemorySize, LDS_BYTES);
    hipFuncSetAttribute((const void*)phase_kernel<3>, hipFuncAttributeMaxDynamicSharedMemorySize, LDS_BYTES);
    hipFuncSetAttribute((const void*)phase_kernel<4>, hipFuncAttributeMaxDynamicSharedMemorySize, LDS_BYTES);
    hipFuncSetAttribute((const void*)phase_kernel<5>, hipFuncAttributeMaxDynamicSharedMemorySize, LDS_BYTES);
    hipFuncSetAttribute((const void*)phase_kernel<6>, hipFuncAttributeMaxDynamicSharedMemorySize, LDS_BYTES);
    hipFuncSetAttribute((const void*)phase_kernel<7>, hipFuncAttributeMaxDynamicSharedMemorySize, LDS_BYTES);
    attr_done = 1;
  }
  const int G = 256;
  if (LAST_PHASE >= 0) hipLaunchKernelGGL(phase_kernel<0>, dim3(G), dim3(NTHR), LDS_BYTES, stream, p);
  if (LAST_PHASE >= 1) hipLaunchKernelGGL(phase_kernel<1>, dim3(G), dim3(NTHR), LDS_BYTES, stream, p);
  if (LAST_PHASE >= 2) hipLaunchKernelGGL(phase_kernel<2>, dim3(G), dim3(NTHR), LDS_BYTES, stream, p);
  if (LAST_PHASE >= 3) hipLaunchKernelGGL(phase_kernel<3>, dim3(G), dim3(NTHR), LDS_BYTES, stream, p);
  if (LAST_PHASE >= 4) hipLaunchKernelGGL(phase_kernel<4>, dim3(G), dim3(NTHR), LDS_BYTES, stream, p);
  if (LAST_PHASE >= 5) hipLaunchKernelGGL(phase_kernel<5>, dim3(G), dim3(NTHR), LDS_BYTES, stream, p);
  if (LAST_PHASE >= 6) hipLaunchKernelGGL(phase_kernel<6>, dim3(G), dim3(NTHR), LDS_BYTES, stream, p);
  if (LAST_PHASE >= 7) hipLaunchKernelGGL(phase_kernel<7>, dim3(G), dim3(NTHR), LDS_BYTES, stream, p);
#if LAST_PHASE == 3
  hipLaunchKernelGGL(dbg_copy, dim3(1024), dim3(256), 0, stream, (const uint4*)p.qb, (uint4*)p.gb, (long)T_ALL * 1024 * 2 / 16);
#endif
#endif
}
```

```cpp
#include <hip/hip_runtime.h>
#include <hip/hip_cooperative_groups.h>
#include <cstdio>
#include <cstring>
#include <cstdint>
namespace cg = cooperative_groups;

#ifndef REP0
#define REP0 1
#endif
#ifndef REP1
#define REP1 1
#endif
#ifndef REP2
#define REP2 1
#endif
#ifndef REP6
#define REP6 1
#endif
__device__ __forceinline__ int opaque_tid() { int t = threadIdx.x; asm volatile("" : "+v"(t)); return t; }
#ifndef PROBE_MASK
#define PROBE_MASK 0
#endif
constexpr int SPLIT_FLAG0 = 3456;
#ifndef MK_COOP
#define MK_COOP 1
#endif

typedef unsigned short u16;
using bf16x8 = __attribute__((ext_vector_type(8))) short;
using s16x4  = __attribute__((ext_vector_type(4))) short;
using f32x4  = __attribute__((ext_vector_type(4))) float;
using f32x16 = __attribute__((ext_vector_type(16))) float;
using u32x4  = __attribute__((ext_vector_type(4))) unsigned;
using u32x2  = __attribute__((ext_vector_type(2))) unsigned;

constexpr int NTHR = 512;
constexpr int T_CTX = 4096, T_ALL = 20480;
constexpr int NPROJ = 6688, NPADW = 6912;
constexpr int LDS_BYTES = 135168;
constexpr float EPSF = 1e-6f;
constexpr float LAM_INIT = 0.2f;
#ifndef DBG_ST
#define DBG_ST 1
#endif

struct Params {
  const float *x_prompt, *x_sample, *cache_k, *cache_v, *state_ssd, *c, *c_ctx, *w_mod, *b_mod, *norm_g, *w_in,
      *lq1, *lk1, *lq2, *lk2, *subln_g, *conv_w, *conv_b, *dt_bias, *A_log, *D_skip, *ssd_norm_g, *w_out, *final_g;
  float* out;
  u16 *winT, *woutT, *qb, *kC, *kS, *vC, *vS, *zb, *xbc, *hb, *gb, *st;
  float *dtb, *modv, *rope, *misc, *cd, *ssqp, *ssq2p;
  unsigned* bar;
  int probe, pad_;
};

typedef __bf16 bf16v2 __attribute__((ext_vector_type(2)));
typedef float f32v2 __attribute__((ext_vector_type(2)));
__device__ __forceinline__ unsigned cvtpk(float lo, float hi) {
  f32v2 v = {lo, hi}; bf16v2 b = __builtin_convertvector(v, bf16v2); return __builtin_bit_cast(unsigned, b);
}
__device__ __forceinline__ u16 f2bf(float x) { __bf16 b = (__bf16)x; return __builtin_bit_cast(u16, b); }
__device__ __forceinline__ float bf2f(u16 x) { return __uint_as_float(((unsigned)x) << 16); }
__device__ __forceinline__ float bfs2f(short x) { return __uint_as_float(((unsigned)(u16)x) << 16); }
__device__ __forceinline__ float siluf(float v) { return v * __builtin_amdgcn_rcpf(1.f + __expf(-v)); }
__device__ __forceinline__ bf16x8 pack8(const float* v) {
  u32x4 w = {cvtpk(v[0], v[1]), cvtpk(v[2], v[3]), cvtpk(v[4], v[5]), cvtpk(v[6], v[7])};
  return *reinterpret_cast<bf16x8*>(&w);
}
__device__ __forceinline__ f32x4 mfma16(bf16x8 a, bf16x8 b, f32x4 c) {
  return __builtin_amdgcn_mfma_f32_16x16x32_bf16(a, b, c, 0, 0, 0);
}

__device__ void p0_mod_item(const Params& p, int i, char* smem) {
  const int tid = opaque_tid();
  float* sc = (float*)smem;
  float* red = sc + 5 * 1024;
  for (int idx = tid; idx < 5120; idx += NTHR) {
    int r = idx >> 10, k = idx & 1023;
    float v = (r == 0) ? p.c_ctx[k] : p.c[(r - 1) * 1024 + k];
    sc[idx] = v / (1.f + expf(-v));
  }
  __syncthreads();
  const int kg = tid >> 4, cq = tid & 15, c0 = i * 64;
  f32x4 a0 = {0, 0, 0, 0}, a1 = a0, a2 = a0, a3 = a0, a4 = a0;
  const float* w = p.w_mod + (long)(kg * 32) * 3072 + c0 + cq * 4;
#pragma unroll 8
  for (int k = 0; k < 32; ++k) {
    f32x4 wv = *reinterpret_cast<const f32x4*>(w + (long)k * 3072);
    int kk = kg * 32 + k;
    a0 += sc[kk] * wv; a1 += sc[1024 + kk] * wv; a2 += sc[2048 + kk] * wv; a3 += sc[3072 + kk] * wv; a4 += sc[4096 + kk] * wv;
  }
  *reinterpret_cast<f32x4*>(red + (kg * 5 + 0) * 64 + cq * 4) = a0; *reinterpret_cast<f32x4*>(red + (kg * 5 + 1) * 64 + cq * 4) = a1;
  *reinterpret_cast<f32x4*>(red + (kg * 5 + 2) * 64 + cq * 4) = a2; *reinterpret_cast<f32x4*>(red + (kg * 5 + 3) * 64 + cq * 4) = a3;
  *reinterpret_cast<f32x4*>(red + (kg * 5 + 4) * 64 + cq * 4) = a4;
  __syncthreads();
  if (tid < 320) {
    int r = tid >> 6, cc = tid & 63;
    float sum = p.b_mod[c0 + cc];
    for (int q = 0; q < 32; ++q) sum += red[(q * 5 + r) * 64 + cc];
    p.modv[r * 3072 + c0 + cc] = sum;
  }
  if (i == 0 && tid == 511) {
    float s1 = 0, s2 = 0;
    for (int k = 0; k < 64; ++k) { s1 += p.lq1[k] * p.lk1[k]; s2 += p.lq2[k] * p.lk2[k]; }
    p.misc[0] = expf(s1) - expf(s2) + LAM_INIT;
  }
}

__device__ void p0_transpose_item(const float* __restrict__ src, int ldsrc, int nvalid, u16* __restrict__ dst, int lddst,
                                  int n0, int k0, int kd0, const float* __restrict__ kscale, char* smem) {
  float* tile = (float*)smem;
  const int tid = opaque_tid();
  {
    int r = tid >> 3, cc = (tid & 7) * 8;
    float sc = 1.f;
    if (kscale != nullptr && (k0 + r) >= 1024) sc = kscale[k0 + r - 1024];
    float4 x0 = {0.f, 0.f, 0.f, 0.f}, x1 = {0.f, 0.f, 0.f, 0.f};
    if (n0 + cc < nvalid) {
      const float* sp = src + (long)(k0 + r) * ldsrc + n0 + cc;
      x0 = *reinterpret_cast<const float4*>(sp); x1 = *reinterpret_cast<const float4*>(sp + 4);
    }
    float* tp = tile + r * 65 + cc;
    tp[0] = x0.x * sc; tp[1] = x0.y * sc; tp[2] = x0.z * sc; tp[3] = x0.w * sc;
    tp[4] = x1.x * sc; tp[5] = x1.y * sc; tp[6] = x1.z * sc; tp[7] = x1.w * sc;
  }
  __syncthreads();
  {
    int n = tid >> 3, kk = (tid & 7) * 8;
    float v[8];
#pragma unroll
    for (int e = 0; e < 8; ++e) v[e] = tile[(kk + e) * 65 + n];
    *reinterpret_cast<bf16x8*>(dst + (long)(n0 + n) * lddst + kd0 + kk) = pack8(v);
  }
}

__device__ void p0_transpose4(const float* __restrict__ src, int ldsrc, int nvalid, u16* __restrict__ dst, int lddst,
                              int n0, int k0, int kd0, const float* __restrict__ kscale, char* smem) {
  float* tile = (float*)smem;
  const int tid = opaque_tid();
  const int r = tid >> 3, cc = (tid & 7) * 8;
  float4 x0[4], x1[4]; float sc[4];
#pragma unroll
  for (int j = 0; j < 4; ++j) {
    const int kr = k0 + j * 64 + r;
    sc[j] = (kscale != nullptr && kr >= 1024) ? kscale[kr - 1024] : 1.f;
    x0[j] = float4{0.f, 0.f, 0.f, 0.f}; x1[j] = x0[j];
    if (n0 + cc < nvalid) {
      const float* sp = src + (long)kr * ldsrc + n0 + cc;
      const f32x4 y0 = __builtin_nontemporal_load(reinterpret_cast<const f32x4*>(sp)), y1 = __builtin_nontemporal_load(reinterpret_cast<const f32x4*>(sp + 4));
      x0[j] = float4{y0[0], y0[1], y0[2], y0[3]}; x1[j] = float4{y1[0], y1[1], y1[2], y1[3]};
    }
  }
#pragma unroll
  for (int j = 0; j < 4; ++j) {
    float* tp = tile + j * 4160 + r * 65 + cc;
    tp[0] = x0[j].x * sc[j]; tp[1] = x0[j].y * sc[j]; tp[2] = x0[j].z * sc[j]; tp[3] = x0[j].w * sc[j];
    tp[4] = x1[j].x * sc[j]; tp[5] = x1[j].y * sc[j]; tp[6] = x1[j].z * sc[j]; tp[7] = x1[j].w * sc[j];
  }
  __syncthreads();
  const int n = tid >> 3, kk = (tid & 7) * 8;
#pragma unroll
  for (int j = 0; j < 4; ++j) {
    float v[8];
#pragma unroll
    for (int e = 0; e < 8; ++e) v[e] = tile[j * 4160 + (kk + e) * 65 + n];
    *reinterpret_cast<bf16x8*>(dst + (long)(n0 + n) * lddst + kd0 + j * 64 + kk) = pack8(v);
  }
}

__device__ void p0_rope_item(const Params& p) {
  const int tid = opaque_tid();
  for (int idx = tid; idx < 1024; idx += NTHR) {
    int pos = idx >> 4, i = idx & 15;
    double inv = 1.0;
    for (int q = 0; q < i; ++q) inv *= 0.56234132519034908;
    double ang = (double)pos * inv;
    double kq = rint(ang * 0.63661977236758134);
    double r = ang - kq * 1.5707963267948966 - kq * 6.123233995736766e-17;
    double r2 = r * r;
    double s = r * (1.0 + r2 * (-1.0 / 6 + r2 * (1.0 / 120 + r2 * (-1.0 / 5040 + r2 * (1.0 / 362880 + r2 * (-1.0 / 39916800 + r2 * (1.0 / 6227020800.0 + r2 * (-1.0 / 1307674368000.0))))))));
    double cs = 1.0 + r2 * (-0.5 + r2 * (1.0 / 24 + r2 * (-1.0 / 720 + r2 * (1.0 / 40320 + r2 * (-1.0 / 3628800 + r2 * (1.0 / 479001600 + r2 * (-1.0 / 87178291200.0 + r2 * (1.0 / 20922789888000.0))))))));
    long kk = (long)kq; int qd = (int)(kk & 3);
    double so, co;
    if (qd == 0) { so = s; co = cs; } else if (qd == 1) { so = cs; co = -s; } else if (qd == 2) { so = -s; co = -cs; } else { so = -cs; co = s; }
    p.rope[idx * 2 + 0] = (float)co;
    p.rope[idx * 2 + 1] = (float)so;
  }
}

__device__ void phase0_pre_item(const Params& p, int i, char* smem) {
  const int tid = opaque_tid();
  constexpr int N_WIN = 108 * 4, N_WOUT = 16 * 8, N_CACHE = 256, N_ROPE = 1;
    if (i < N_WIN) {
      int nt = i >> 2, kq = i & 3;
      p0_transpose4(p.w_in, NPROJ, NPROJ, p.winT, 1024, nt * 64, kq * 256, kq * 256, nullptr, smem);
      __syncthreads();
    } else if ((i -= N_WIN) < N_WOUT) {
      int nt = i >> 3, kq = i & 7;
      p0_transpose4(p.w_out, 1024, 1024, p.woutT + (kq >= 4 ? 1024 * 1024 : 0), 1024, nt * 64, kq * 256, (kq & 3) * 256, p.ssd_norm_g, smem);
      __syncthreads();
    } else if ((i -= N_WOUT) < N_CACHE) {
      float4 xa[4], xb[4];
#pragma unroll
      for (int j = 0; j < 4; ++j) {
        const int piece = i * 4 + j, tens = piece >> 9, blk = piece & 511;
        const float* src = (tens ? p.cache_v : p.cache_k) + (long)blk * 4096 + tid * 8;
        xa[j] = *reinterpret_cast<const float4*>(src); xb[j] = *reinterpret_cast<const float4*>(src + 4);
      }
#pragma unroll
      for (int j = 0; j < 4; ++j) {
        const int piece = i * 4 + j, tens = piece >> 9, blk = piece & 511;
        const long e0 = (long)blk * 4096 + tid * 8;
        const int b = (int)(e0 >> 19); const long rem = e0 & ((1 << 19) - 1);
        u16* dst = (tens ? p.vS : p.kS) + ((long)b * 4608 + 4096) * 1024 + rem;
        float v[8] = {xa[j].x, xa[j].y, xa[j].z, xa[j].w, xb[j].x, xb[j].y, xb[j].z, xb[j].w};
        *reinterpret_cast<bf16x8*>(dst) = pack8(v);
      }
    } else if ((i -= N_CACHE) < N_ROPE) {
      p0_rope_item(p);
    }
}
__device__ void phase0(const Params& p, char* smem) {
  constexpr int N_PRE = 108 * 4 + 16 * 8 + 256 + 1;
  if (gridDim.x == 256) {
    if (blockIdx.x < 48) { p0_mod_item(p, blockIdx.x, smem); __syncthreads(); }
    else { for (int i = blockIdx.x - 48; i < N_PRE; i += 208) phase0_pre_item(p, i, smem); }
  } else {
    for (int it = blockIdx.x; it < 48 + N_PRE; it += gridDim.x) {
      if (it < 48) { p0_mod_item(p, it, smem); __syncthreads(); } else phase0_pre_item(p, it - 48, smem);
    }
  }
}

__device__ void phase1(const Params& p, char* smem) {
  const int tid = opaque_tid(), lane = tid & 63, wid = tid >> 6;
  (void)tid;
  for (int i = blockIdx.x; i < T_ALL / 32; i += gridDim.x) {
      float4 v[4][4]; float ss[4];
#pragma unroll
      for (int rr = 0; rr < 4; ++rr) {
        const int t = i * 32 + rr * 8 + wid;
        const float* xr = (t < T_CTX) ? p.x_prompt + (long)t * 1024 : p.x_sample + (long)(t - T_CTX) * 1024;
#pragma unroll
        for (int q = 0; q < 4; ++q) v[rr][q] = *reinterpret_cast<const float4*>(xr + q * 256 + lane * 4);
      }
#pragma unroll
      for (int rr = 0; rr < 4; ++rr) {
        float a = 0.f;
#pragma unroll
        for (int q = 0; q < 4; ++q) a += v[rr][q].x * v[rr][q].x + v[rr][q].y * v[rr][q].y + v[rr][q].z * v[rr][q].z + v[rr][q].w * v[rr][q].w;
#pragma unroll
        for (int o = 32; o >= 1; o >>= 1) a += __shfl_xor(a, o);
        ss[rr] = rsqrtf(a * (1.f / 1024.f) + EPSF);
      }
#pragma unroll
      for (int rr = 0; rr < 4; ++rr) {
        const int t = i * 32 + rr * 8 + wid;
        const int mr = (t < T_CTX) ? 0 : 1 + ((t - T_CTX) >> 12);
        const float rs = ss[rr];
#pragma unroll
        for (int q = 0; q < 4; ++q) {
          int col = q * 256 + lane * 4;
          float4 g = *reinterpret_cast<const float4*>(p.norm_g + col);
          float4 sh = *reinterpret_cast<const float4*>(p.modv + mr * 3072 + col);
          float4 sc = *reinterpret_cast<const float4*>(p.modv + mr * 3072 + 1024 + col);
          float h0 = v[rr][q].x * rs * g.x * (1.f + sc.x) + sh.x;
          float h1 = v[rr][q].y * rs * g.y * (1.f + sc.y) + sh.y;
          float h2 = v[rr][q].z * rs * g.z * (1.f + sc.z) + sh.z;
          float h3 = v[rr][q].w * rs * g.w * (1.f + sc.w) + sh.w;
          u32x2 w = {cvtpk(h0, h1), cvtpk(h2, h3)};
          *reinterpret_cast<u32x2*>(p.hb + (long)t * 1024 + col) = w;
        }
      }
  }
}

constexpr int G_LD = 72;
constexpr int G_ABYTES = 256 * G_LD * 2, G_BBYTES = 128 * G_LD * 2, G_STAGE = G_ABYTES + G_BBYTES;

__device__ __forceinline__ void gemm_kloop(f32x4 (&acc)[4][4], const u16* __restrict__ A, int lda,
                                           const u16* __restrict__ B, int ldb, int nk, char* smem) {
  const int tid = opaque_tid(), lane = tid & 63, wid = __builtin_amdgcn_readfirstlane(tid >> 6), wm = wid >> 1, wn = wid & 1, fr = lane & 15, fq = lane >> 4;
  bf16x8 ra[4], rb[2];
  const int lr = tid >> 3, lc = (tid & 7) * 8;
  __syncthreads();
#pragma unroll
  for (int i = 0; i < 4; ++i) ra[i] = *reinterpret_cast<const bf16x8*>(A + (long)(lr + i * 64) * lda + lc);
#pragma unroll
  for (int i = 0; i < 2; ++i) rb[i] = *reinterpret_cast<const bf16x8*>(B + (long)(lr + i * 64) * ldb + lc);
  {
    u16* As = (u16*)smem; u16* Bs = (u16*)(smem + G_ABYTES);
#pragma unroll
    for (int i = 0; i < 4; ++i) *reinterpret_cast<bf16x8*>(As + (lr + i * 64) * G_LD + lc) = ra[i];
#pragma unroll
    for (int i = 0; i < 2; ++i) *reinterpret_cast<bf16x8*>(Bs + (lr + i * 64) * G_LD + lc) = rb[i];
  }
  __syncthreads();
  for (int kt = 0; kt < nk; ++kt) {
    if (kt + 1 < nk) {
#pragma unroll
      for (int i = 0; i < 4; ++i) ra[i] = *reinterpret_cast<const bf16x8*>(A + (long)(lr + i * 64) * lda + (kt + 1) * 64 + lc);
#pragma unroll
      for (int i = 0; i < 2; ++i) rb[i] = *reinterpret_cast<const bf16x8*>(B + (long)(lr + i * 64) * ldb + (kt + 1) * 64 + lc);
    }
    const u16* As = (const u16*)(smem + (kt & 1) * G_STAGE);
    const u16* Bs = (const u16*)(smem + (kt & 1) * G_STAGE + G_ABYTES);
#pragma unroll
    for (int ks = 0; ks < 2; ++ks) {
      bf16x8 a[4], b[4];
#pragma unroll
      for (int mi = 0; mi < 4; ++mi) a[mi] = *reinterpret_cast<const bf16x8*>(As + (wm * 64 + mi * 16 + fr) * G_LD + ks * 32 + fq * 8);
#pragma unroll
      for (int ni = 0; ni < 4; ++ni) b[ni] = *reinterpret_cast<const bf16x8*>(Bs + (wn * 64 + ni * 16 + fr) * G_LD + ks * 32 + fq * 8);
#pragma unroll
      for (int mi = 0; mi < 4; ++mi)
#pragma unroll
        for (int ni = 0; ni < 4; ++ni) acc[mi][ni] = mfma16(a[mi], b[ni], acc[mi][ni]);
    }
    if (kt + 1 < nk) {
      u16* As2 = (u16*)(smem + ((kt + 1) & 1) * G_STAGE); u16* Bs2 = (u16*)(smem + ((kt + 1) & 1) * G_STAGE + G_ABYTES);
#pragma unroll
      for (int i = 0; i < 4; ++i) *reinterpret_cast<bf16x8*>(As2 + (lr + i * 64) * G_LD + lc) = ra[i];
#pragma unroll
      for (int i = 0; i < 2; ++i) *reinterpret_cast<bf16x8*>(Bs2 + (lr + i * 64) * G_LD + lc) = rb[i];
    }
    __syncthreads();
  }
}

namespace pg8 {
#define PG8_LAS __attribute__((address_space(3)))
typedef unsigned short bf16_t;
typedef short bf16x8 __attribute__((ext_vector_type(8)));
typedef float f32x4 __attribute__((ext_vector_type(4)));
typedef unsigned u32x4 __attribute__((ext_vector_type(4)));
constexpr int BM = 256, BK = 64, HALF = 128, HTB = HALF * BK * 2  , STAGE_BYTES = 8 * HTB, NXCD = 8, WGM = 4;

__host__ __device__ __forceinline__ int lds_byte(int r, int c) { const int st = (r >> 4) * 2 + (c >> 5), rr = r & 15, cc = c & 31, ob = rr * 64 + cc * 2; return st * 1024 + (ob ^ (((ob >> 9) & 1) << 5)); }
__host__ __device__ __forceinline__ void stage_rc(int b, int& R, int& C) { const int st = b / 1024, sb = b % 1024, swz = sb ^ (((sb >> 9) & 1) << 5); R = (st >> 1) * 16 + swz / 64; C = (st & 1) * 32 + (swz % 64) / 2; }
__host__ __device__ __forceinline__ int perm32(int rho) { const int n = rho >> 4, i = rho & 15; return 8 * (i >> 2) + 4 * n + (i & 3); }

struct Unit { int pm, pn, seg, split; };
struct Gemm { const bf16_t* A; const bf16_t* Bt; int M, N, K; const bf16_t* A2; const bf16_t* Bt2; };

struct StaticOrder {
    int nM, nN, nwg, G, c;
    __host__ __device__ void init(int M, int N, int G_, int c_) { nM = M / BM; nN = N / BM; nwg = nM * nN; G = G_; c = c_; }
    __host__ __device__ bool tile_at(long L, Unit& u) const {
        if (L >= nwg) return false;
        int wgid = (int)L; { const int q = nwg / NXCD, r = nwg % NXCD, xcd = wgid % NXCD, off = wgid / NXCD; wgid = (xcd < r ? xcd * (q + 1) : r * (q + 1) + (xcd - r) * q) + off; }
        const int nig = WGM * nN, gid = wgid / nig, fm = gid * WGM, gsz = (nM - fm) < WGM ? (nM - fm) : WGM;
        u.pm = fm + ((wgid % nig) % gsz); u.pn = (wgid % nig) / gsz; u.seg = 0; u.split = 0; return true;
    }
    __host__ __device__ bool next(int i, Unit& u) const { return tile_at((long)i * G + c, u); }
    __device__ __forceinline__ void a_ready(const Unit&) const {}
    __device__ __forceinline__ void done(const Unit&) const {}
};
template <class Epi, class Sched, bool STAMP = false>
__device__ __forceinline__ void gemm_phase(PG8_LAS unsigned char* lds, const Gemm g, const Sched& S, const Epi& E, unsigned long long* stamps) {
    const int tid = opaque_tid(), wid = __builtin_amdgcn_readfirstlane(tid >> 6), lane = tid & 63, wr = wid >> 2, wc = wid & 3, fr = lane & 15, fq = lane >> 4;
    const int K = g.K, nt = K / BK;
    int ts_lo = 0, ts_hi = 0, nts = 0; const unsigned long long rt_entry = STAMP ? (unsigned long long)wall_clock64() : 0ull;
#define PG8_STAMP() do { if (STAMP && wid == 0 && nts < 64) { const unsigned long long _c = (unsigned long long)clock64(); \
        ts_lo = (lane == nts) ? (int)(unsigned)_c : ts_lo; ts_hi = (lane == nts) ? (int)(unsigned)(_c >> 32) : ts_hi; ++nts; } } while (0)
    PG8_STAMP();
    unsigned voffA[2], voffB[2];
#pragma unroll
    for (int i = 0; i < 2; ++i) { int R, C; stage_rc(tid * 16 + i * 8192, R, C); const int Rb = Epi::PERM ? ((R & ~31) + perm32(R & 31)) : R;
        voffA[i] = (unsigned)(R * K + C) * 2u; voffB[i] = (unsigned)(Rb * K + C) * 2u; }
    const size_t kstep = (size_t)(BK * 2);
    const size_t hstep = (size_t)HALF * K * 2;
    const size_t tstep = 2 * hstep;
    const unsigned ldsw = (unsigned)wid * 1024u;
    const int aoff = lds_byte(wr * 64 + fr, fq * 8), boff = lds_byte(wc * 32 + fr, fq * 8);
#define PG8_SA(b, h) (((b) * 2 + (h)) * HTB)
#define PG8_SB(b, h) ((4 + (b) * 2 + (h)) * HTB)
#define PG8_STAGE(bufoff, gbase, voff) do { _Pragma("unroll") for (int _i = 0; _i < 2; ++_i) \
        __builtin_amdgcn_global_load_lds((const unsigned*)((const char*)(gbase) + (voff)[_i]), (PG8_LAS unsigned*)(lds + (bufoff) + ldsw + _i * 8192), 16, 0, 0); } while (0)
#define PG8_LDA(dst, b, h) do { _Pragma("unroll") for (int m = 0; m < 4; ++m) _Pragma("unroll") for (int k = 0; k < 2; ++k) dst[m][k] = *(const PG8_LAS bf16x8*)(lds + PG8_SA(b, h) + aoff + m * 2048 + k * 1024); } while (0)
#define PG8_LDB(dst, b, h) do { _Pragma("unroll") for (int n = 0; n < 2; ++n) _Pragma("unroll") for (int k = 0; k < 2; ++k) dst[n][k] = *(const PG8_LAS bf16x8*)(lds + PG8_SB(b, h) + boff + n * 2048 + k * 1024); } while (0)
#define PG8_MMA(ai, bj, At, Bt) do { __builtin_amdgcn_s_setprio(1); _Pragma("unroll") for (int m = 0; m < 4; ++m) _Pragma("unroll") for (int n = 0; n < 2; ++n) _Pragma("unroll") for (int k = 0; k < 2; ++k) \
        acc[ai][bj][m][n] = __builtin_amdgcn_mfma_f32_16x16x32_bf16(Bt[n][k], At[m][k], acc[ai][bj][m][n], 0, 0, 0); __builtin_amdgcn_s_setprio(0); } while (0)
#define PG8_WAIT_V(n) asm volatile("s_waitcnt vmcnt(" #n ")" ::: "memory")
#define PG8_WAIT_L(n) asm volatile("s_waitcnt lgkmcnt(" #n ")" ::: "memory")
#define PG8_BAR __builtin_amdgcn_s_barrier()
#define PG8_SCHED __builtin_amdgcn_sched_barrier(0)
    Unit cur, nxt; int ui = 0;
    if (!S.next(0, cur)) return;
    f32x4 acc[2][2][4][2];
#pragma unroll
    for (int a = 0; a < 2; ++a)
#pragma unroll
        for (int b = 0; b < 2; ++b)
#pragma unroll
            for (int m = 0; m < 4; ++m)
#pragma unroll
                for (int n = 0; n < 2; ++n) acc[a][b][m][n] = (f32x4){0.f, 0.f, 0.f, 0.f};
    bf16x8 At[4][2], B0[2][2], B1[2][2];
    const char* cA = (const char*)(cur.seg ? g.A2 : g.A) + (size_t)cur.pm * tstep; const char* cB = (const char*)(cur.seg ? g.Bt2 : g.Bt) + (size_t)cur.pn * tstep;
    S.a_ready(cur);
    PG8_STAGE(PG8_SB(0, 0), cB, voffB); PG8_STAGE(PG8_SA(0, 0), cA, voffA); PG8_STAGE(PG8_SB(0, 1), cB + hstep, voffB); PG8_STAGE(PG8_SA(0, 1), cA + hstep, voffA);
    if (wr == 1) PG8_BAR;
    PG8_WAIT_V(4); PG8_BAR;
    PG8_STAGE(PG8_SB(1, 0), cB + kstep, voffB); PG8_STAGE(PG8_SA(1, 0), cA + kstep, voffA); PG8_STAGE(PG8_SB(1, 1), cB + hstep + kstep, voffB);
    PG8_WAIT_V(6); PG8_BAR;
    PG8_STAMP();
    for (;;) {
        const bool has_next = S.next(ui + 1, nxt);
        const char* nA = has_next ? (const char*)(nxt.seg ? g.A2 : g.A) + (size_t)nxt.pm * tstep : cA; const char* nB = has_next ? (const char*)(nxt.seg ? g.Bt2 : g.Bt) + (size_t)nxt.pn * tstep : cB;
        for (int t = 0; t < nt; t += 2) {
            const bool last = (t == nt - 2);
            const char* a1 = cA + (size_t)(t + 1) * kstep;
            const char* a2 = last ? nA : cA + (size_t)(t + 2) * kstep; const char* b2 = last ? nB : cB + (size_t)(t + 2) * kstep;
            const char* a3 = a2 + kstep; const char* b3 = b2 + kstep;
            if (last && has_next) S.a_ready(nxt);
            PG8_LDB(B0, 0, 0); PG8_SCHED; PG8_LDA(At, 0, 0); PG8_STAGE(PG8_SA(1, 1), a1 + hstep, voffA);
            PG8_WAIT_L(8); PG8_BAR; PG8_WAIT_L(0); PG8_MMA(0, 0, At, B0); PG8_BAR; PG8_SCHED;
            PG8_LDB(B1, 0, 1); PG8_STAGE(PG8_SB(0, 0), b2, voffB);
            PG8_BAR; PG8_WAIT_L(0); PG8_MMA(0, 1, At, B1); PG8_BAR;
            PG8_LDA(At, 0, 1); PG8_STAGE(PG8_SA(0, 0), a2, voffA);
            PG8_BAR; PG8_WAIT_L(0); PG8_MMA(1, 0, At, B0); PG8_BAR; PG8_SCHED;
            PG8_STAGE(PG8_SB(0, 1), b2 + hstep, voffB);
            PG8_WAIT_V(6); PG8_BAR; PG8_MMA(1, 1, At, B1); PG8_BAR;
            PG8_LDB(B0, 1, 0); PG8_SCHED; PG8_LDA(At, 1, 0); PG8_STAGE(PG8_SA(0, 1), a2 + hstep, voffA);
            PG8_WAIT_L(8); PG8_BAR; PG8_WAIT_L(0); PG8_MMA(0, 0, At, B0); PG8_BAR; PG8_SCHED;
            PG8_LDB(B1, 1, 1); PG8_STAGE(PG8_SB(1, 0), b3, voffB);
            PG8_BAR; PG8_WAIT_L(0); PG8_MMA(0, 1, At, B1); PG8_BAR;
            PG8_LDA(At, 1, 1); PG8_STAGE(PG8_SA(1, 0), a3, voffA);
            PG8_BAR; PG8_WAIT_L(0); PG8_MMA(1, 0, At, B0); PG8_BAR; PG8_SCHED;
            PG8_STAGE(PG8_SB(1, 1), b3 + hstep, voffB);
            PG8_WAIT_V(6); PG8_BAR; PG8_MMA(1, 1, At, B1); PG8_BAR;
        }
        PG8_STAMP();
        if constexpr (!Epi::AFTER_DRAIN) { E(acc, cur, wr, wc, fr, fq); S.done(cur); }
        PG8_STAMP();
        if (!has_next) break;
        if (!(Epi::KEEP && cur.seg == 0))
#pragma unroll
        for (int a = 0; a < 2; ++a)
#pragma unroll
            for (int b = 0; b < 2; ++b)
#pragma unroll
                for (int m = 0; m < 4; ++m)
#pragma unroll
                    for (int n = 0; n < 2; ++n) acc[a][b][m][n] = (f32x4){0.f, 0.f, 0.f, 0.f};
        cur = nxt; cA = nA; cB = nB; ++ui;
    }
    PG8_WAIT_V(0);
    if (wr == 0) PG8_BAR;
    PG8_BAR;
    if constexpr (Epi::AFTER_DRAIN) { E.fused(acc, cur, wr, wc, fr, fq, lds, wid, lane); S.done(cur); }
    PG8_STAMP();
    if (STAMP && wid == 0) { stamps[lane] = lane < nts ? (((unsigned long long)(unsigned)ts_hi << 32) | (unsigned)ts_lo) : 0ull;
        if (lane == 62) stamps[62] = rt_entry; if (lane == 63) stamps[63] = (unsigned long long)wall_clock64(); }
#undef PG8_STAMP
#undef PG8_SA
#undef PG8_SB
#undef PG8_STAGE
#undef PG8_LDA
#undef PG8_LDB
#undef PG8_MMA
#undef PG8_WAIT_V
#undef PG8_WAIT_L
#undef PG8_BAR
#undef PG8_SCHED
}
}
template <int SEG> __device__ __forceinline__ void epi_proj_seg(const Params& p, const f32x4 (&acc)[2][2][4][2], int m0, int n0, int wr, int wc, int fr, int fq) {
  const bool is_ctx = (m0 < T_CTX);
  const bool do_rope = (SEG <= 1) && !is_ctx;
#pragma unroll
  for (int ai = 0; ai < 2; ++ai)
#pragma unroll
    for (int m = 0; m < 4; ++m) {
      const int t = m0 + ai * 128 + wr * 64 + m * 16 + fr;
      const int ts = t - T_CTX, bsm = ts >> 12, tl = ts & 4095;
      f32x4 rc[4];
      if (do_rope) {
        const int pos = (wc & 1) ? (tl & 63) : (tl >> 6);
        const f32x4* rp = reinterpret_cast<const f32x4*>(p.rope + (pos * 16 + 8 * (fq & 1)) * 2);
        rc[0] = rp[0]; rc[1] = rp[1]; rc[2] = rp[2]; rc[3] = rp[3];
      }
#pragma unroll
      for (int bj = 0; bj < 2; ++bj) {
        f32x4 v0 = acc[ai][bj][m][0], v1 = acc[ai][bj][m][1];
        const int n = n0 + bj * 128 + wc * 32 + 8 * fq;
        if (do_rope) {
          const float sgn = (fq < 2) ? -1.f : 1.f;
#pragma unroll
          for (int e = 0; e < 4; ++e) {
            float o0 = __shfl_xor(v0[e], 32), o1 = __shfl_xor(v1[e], 32);
            float c0 = rc[e >> 1][(e & 1) * 2], s0 = rc[e >> 1][(e & 1) * 2 + 1];
            float c1 = rc[2 + (e >> 1)][(e & 1) * 2], s1 = rc[2 + (e >> 1)][(e & 1) * 2 + 1];
            v0[e] = v0[e] * c0 + sgn * o0 * s0;
            v1[e] = v1[e] * c1 + sgn * o1 * s1;
          }
        }
        if (SEG == 3 || SEG == 4) {
#pragma unroll
          for (int e = 0; e < 4; ++e) { v0[e] = siluf(v0[e]); v1[e] = siluf(v1[e]); }
        }
        if (SEG == 6) {
          if (bj == 0 && wc == 0) {
            float* fo = p.dtb + (long)t * 32 + 8 * fq;
            *reinterpret_cast<f32x4*>(fo) = v0; *reinterpret_cast<f32x4*>(fo + 4) = v1;
          }
        } else {
          u32x4 w = {cvtpk(v0[0], v0[1]), cvtpk(v0[2], v0[3]), cvtpk(v1[0], v1[1]), cvtpk(v1[2], v1[3])};
          u16* dst;
          if (SEG == 0) dst = p.qb + (long)t * 1024 + n;
          else if (SEG == 1 || SEG == 2) {
            const int c = n - SEG * 1024;
            if (is_ctx) {
              dst = (SEG == 1 ? p.kC : p.vC) + (long)t * 1024 + c;
              float* fo = p.out + (SEG == 1 ? 20971520L : 25165824L) + (long)t * 1024 + c;
              *reinterpret_cast<f32x4*>(fo) = v0; *reinterpret_cast<f32x4*>(fo + 4) = v1;
            } else dst = (SEG == 1 ? p.kS : p.vS) + ((long)bsm * 4608 + tl) * 1024 + c;
          } else if (SEG == 3) dst = p.gb + (long)t * 1024 + (n - 3072);
          else if (SEG == 4) dst = p.zb + (long)t * 1024 + (n - 4096);
          else dst = p.xbc + (long)t * 1536 + (n - 5120);
          *reinterpret_cast<u32x4*>(dst) = w;
        }
      }
    }
}
struct EpiProj {
  static constexpr bool PERM = true, AFTER_DRAIN = false, KEEP = false;
  const Params& p;
  __device__ __forceinline__ void operator()(const f32x4 (&acc)[2][2][4][2], const pg8::Unit& u, int wr, int wc, int fr, int fq) const {
    const int m0 = u.pm * 256, n0 = u.pn * 256;
    const int seg = (n0 < 5120) ? (n0 >> 10) : (n0 < 6656 ? 5 : 6);
    switch (seg) {
      case 0: epi_proj_seg<0>(p, acc, m0, n0, wr, wc, fr, fq); break;
      case 1: epi_proj_seg<1>(p, acc, m0, n0, wr, wc, fr, fq); break;
      case 2: epi_proj_seg<2>(p, acc, m0, n0, wr, wc, fr, fq); break;
      case 3: epi_proj_seg<3>(p, acc, m0, n0, wr, wc, fr, fq); break;
      case 4: epi_proj_seg<4>(p, acc, m0, n0, wr, wc, fr, fq); break;
      case 5: epi_proj_seg<5>(p, acc, m0, n0, wr, wc, fr, fq); break;
      default: epi_proj_seg<6>(p, acc, m0, n0, wr, wc, fr, fq); break;
    }
  }
};

__device__ void phase2(const Params& p, char* smem) {
  pg8::StaticOrder S; S.init(T_ALL, NPADW, (int)gridDim.x, (int)blockIdx.x);
  pg8::Gemm g{p.hb, p.winT, T_ALL, NPADW, 1024, p.hb, p.winT};
  EpiProj E{p};
  pg8::gemm_phase<EpiProj, pg8::StaticOrder, false>((PG8_LAS unsigned char*)smem, g, S, E, nullptr);
  __syncthreads();
}

constexpr int SHM_V = 64 * 128 * 2, SHM_K = 64 * 128 * 2;
constexpr float ASCALE = 0.125f;
constexpr float ATHR = 8.f;
#define KSWZ(row, colB) ((row) * 256 + ((colB) ^ (((row) & 7) << 4)))
#define SBAR() __builtin_amdgcn_sched_barrier(0)
__device__ __forceinline__ int crow(int r, int hi) { return (r & 3) + 8 * (r >> 2) + 4 * hi; }

__device__ __forceinline__ void partialSM(f32x16& p0, f32x16& p1, float& m_reg, float& mn, float& alpha) {
  constexpr float C = ASCALE * 1.4426950408889634f;
  float pmax = p0[0];
#pragma unroll
  for (int r = 1; r < 16; ++r) pmax = fmaxf(pmax, p0[r]);
#pragma unroll
  for (int r = 0; r < 16; ++r) pmax = fmaxf(pmax, p1[r]);
  { auto rr = __builtin_amdgcn_permlane32_swap(__float_as_uint(pmax), __float_as_uint(pmax), false, false);
    pmax = fmaxf(__uint_as_float(rr[0]), __uint_as_float(rr[1])); }
  if (__builtin_expect(__all(pmax - m_reg <= ATHR / ASCALE), 1)) { mn = m_reg; alpha = 1.f; }
  else { mn = fmaxf(m_reg, pmax); alpha = __builtin_amdgcn_exp2f((m_reg - mn) * C); m_reg = mn; }
  float mnC = -mn * C;
#pragma unroll
  for (int r = 0; r < 16; ++r) p0[r] = fmaf(p0[r], C, mnC);
#pragma unroll
  for (int r = 0; r < 16; ++r) p1[r] = fmaf(p1[r], C, mnC);
#pragma unroll
  for (int r = 0; r < 16; ++r) p0[r] = __builtin_amdgcn_exp2f(p0[r]);
}
__device__ __forceinline__ void finishSM(f32x16& p0, f32x16& p1, float alpha, float& l_reg, bf16x8& pa0, bf16x8& pa1, bf16x8& pa2, bf16x8& pa3) {
#pragma unroll
  for (int r = 0; r < 16; ++r) p1[r] = __builtin_amdgcn_exp2f(p1[r]);
  float ps = 0;
#pragma unroll
  for (int r = 0; r < 16; ++r) ps += p0[r];
#pragma unroll
  for (int r = 0; r < 16; ++r) ps += p1[r];
  { auto rr = __builtin_amdgcn_permlane32_swap(__float_as_uint(ps), __float_as_uint(ps), false, false);
    ps = __uint_as_float(rr[0]) + __uint_as_float(rr[1]); }
  l_reg = l_reg * alpha + ps;
#define PK4(P, BASE, OUT) do { unsigned a0 = cvtpk(P[BASE + 0], P[BASE + 1]), a1 = cvtpk(P[BASE + 2], P[BASE + 3]);   \
    unsigned b0 = cvtpk(P[BASE + 4], P[BASE + 5]), b1 = cvtpk(P[BASE + 6], P[BASE + 7]);                              \
    auto r0 = __builtin_amdgcn_permlane32_swap(a0, b0, false, false); auto r1 = __builtin_amdgcn_permlane32_swap(a1, b1, false, false); \
    u32x4 w = {r0[0], r1[0], r0[1], r1[1]}; OUT = *reinterpret_cast<bf16x8*>(&w); } while (0)
  PK4(p0, 0, pa0); PK4(p0, 8, pa1); PK4(p1, 0, pa2); PK4(p1, 8, pa3);
#undef PK4
}
__device__ __forceinline__ void qkt(f32x16& p0, f32x16& p1, const u16* Ks, const bf16x8* qr, int r32, int hi, int comp) {
  p0 = f32x16{}; p1 = f32x16{};
#pragma unroll
  for (int d0 = 0; d0 < 4; ++d0) { int cb = (comp * 64 + d0 * 16 + hi * 8) * 2;
    bf16x8 b0 = *reinterpret_cast<const bf16x8*>((const char*)Ks + KSWZ(r32, cb));
    bf16x8 b1 = *reinterpret_cast<const bf16x8*>((const char*)Ks + KSWZ(32 + r32, cb));
    bf16x8 q = qr[d0];
    p0 = __builtin_amdgcn_mfma_f32_32x32x16_bf16(b0, q, p0, 0, 0, 0);
    p1 = __builtin_amdgcn_mfma_f32_32x32x16_bf16(b1, q, p1, 0, 0, 0); }
}
__device__ __forceinline__ int v_st(int k, int c) { const int kk = (k & ~0xC) | ((k & 4) << 1) | ((k & 8) >> 1); return ((kk >> 3) * 4 + (c >> 5)) * 512 + ((kk & 7) * 32 + (c & 31)) * 2; }
__device__ __forceinline__ int v_rd_base(int lane) { return ((lane & 3) << 3) | (((lane >> 2) & 3) << 6) | (((lane >> 4) & 1) << 5) | (((lane >> 5) & 1) << 8); }
constexpr int v_rd_off(int d0, int ks, int half) { return d0 * 512 + ks * 4096 + half * 2048; }
template <int OFF> __device__ __forceinline__ s16x4 tr_read(int vb) {
  s16x4 r; asm volatile("ds_read_b64_tr_b16 %0, %1 offset:%2" : "=&v"(r) : "v"(vb), "i"(OFF) : "memory"); return r;
}
template <int D0> __device__ __forceinline__ void pv_one(f32x16& od, int vb, bf16x8 pa0, bf16x8 pa1, bf16x8 pa2, bf16x8 pa3) {
  const s16x4 l0 = tr_read<v_rd_off(D0, 0, 0)>(vb), h0 = tr_read<v_rd_off(D0, 0, 1)>(vb), l1 = tr_read<v_rd_off(D0, 1, 0)>(vb), h1 = tr_read<v_rd_off(D0, 1, 1)>(vb);
  const s16x4 l2 = tr_read<v_rd_off(D0, 2, 0)>(vb), h2 = tr_read<v_rd_off(D0, 2, 1)>(vb), l3 = tr_read<v_rd_off(D0, 3, 0)>(vb), h3 = tr_read<v_rd_off(D0, 3, 1)>(vb);
  asm volatile("s_waitcnt lgkmcnt(0)" ::: "memory"); SBAR();
#define PK(L, H) (bf16x8){L[0], L[1], L[2], L[3], H[0], H[1], H[2], H[3]}
  od = __builtin_amdgcn_mfma_f32_32x32x16_bf16(pa0, PK(l0, h0), od, 0, 0, 0);
  od = __builtin_amdgcn_mfma_f32_32x32x16_bf16(pa1, PK(l1, h1), od, 0, 0, 0);
  od = __builtin_amdgcn_mfma_f32_32x32x16_bf16(pa2, PK(l2, h2), od, 0, 0, 0);
  od = __builtin_amdgcn_mfma_f32_32x32x16_bf16(pa3, PK(l3, h3), od, 0, 0, 0);
#undef PK
}
__device__ __forceinline__ void pv_d0(f32x16* o, int vb, bf16x8 pa0, bf16x8 pa1, bf16x8 pa2, bf16x8 pa3) {
  pv_one<0>(o[0], vb, pa0, pa1, pa2, pa3); pv_one<1>(o[1], vb, pa0, pa1, pa2, pa3); pv_one<2>(o[2], vb, pa0, pa1, pa2, pa3); pv_one<3>(o[3], vb, pa0, pa1, pa2, pa3);
}

__device__ __forceinline__ void attn_item(const Params& p, long tq0, int h, const u16* __restrict__ Kh, const u16* __restrict__ Vh, int seq, char* lds) {
  constexpr int LDK = 1024;
  const int tid = opaque_tid(), wid = __builtin_amdgcn_readfirstlane(tid >> 6), lane = tid & 63, r32 = lane & 31, hi = lane >> 5;
  const int comp = wid >> 2, qg = wid & 3;
  u16* V_lds = (u16*)lds; u16* K_lds = (u16*)(lds + 2 * SHM_V);
  float* wsl = (float*)(lds + 2 * SHM_V + 2 * SHM_K) + wid * 64; float* li_l = wsl; float* al_l = wsl + 32;
  float m_reg = -1e30f, l_reg = 0; f32x16 o[4] = {};
  char* Q_lds = lds + 2 * SHM_V + 2 * SHM_K + 2048;
  {
#pragma unroll
    for (int i = 0; i < 4; ++i) {
      int id = tid + i * NTHR; int row = id >> 4, ch = id & 15;
      bf16x8 v = *reinterpret_cast<const bf16x8*>(p.qb + (tq0 + row) * 1024 + h * 128 + ch * 8);
      *reinterpret_cast<bf16x8*>(Q_lds + KSWZ(row, ch * 16)) = v;
    }
  }
  __syncthreads();
  bf16x8 qr[4];
#pragma unroll
  for (int d0 = 0; d0 < 4; ++d0) qr[d0] = *reinterpret_cast<const bf16x8*>(Q_lds + (qg * 32) * 256 + KSWZ(r32, (comp * 64 + d0 * 16 + hi * 8) * 2));
  const int sr = tid >> 4, sc = (tid & 15) * 8, vst0 = v_st(sr, sc), vst1 = v_st(32 + sr, sc);
  const int vb0 = (int)(uintptr_t)V_lds + v_rd_base(lane);
  constexpr int SDEPTH = 1;
  struct { bf16x8 vs0, vs1, ks0, ks1; } sr_[SDEPTH];
#define SLOAD(i, k0) do { sr_[i].vs0 = *reinterpret_cast<const bf16x8*>(&Vh[(long)((k0) + sr) * LDK + sc]); sr_[i].vs1 = *reinterpret_cast<const bf16x8*>(&Vh[(long)((k0) + 32 + sr) * LDK + sc]); \
    sr_[i].ks0 = *reinterpret_cast<const bf16x8*>(&Kh[(long)((k0) + sr) * LDK + sc]); sr_[i].ks1 = *reinterpret_cast<const bf16x8*>(&Kh[(long)((k0) + 32 + sr) * LDK + sc]); } while (0)
#define SWRITE(b, i) do { *(bf16x8*)((char*)V_lds + (b) * SHM_V + vst0) = sr_[i].vs0;          \
    *(bf16x8*)((char*)V_lds + (b) * SHM_V + vst1) = sr_[i].vs1; int kc = sc * 2;               \
    *(bf16x8*)((char*)K_lds + (b) * SHM_K + KSWZ(sr, kc)) = sr_[i].ks0;                       \
    *(bf16x8*)((char*)K_lds + (b) * SHM_K + KSWZ(32 + sr, kc)) = sr_[i].ks1; } while (0)
#define SWAIT() do { if constexpr (SDEPTH == 2) asm volatile("s_waitcnt vmcnt(4)" ::: "memory"); else asm volatile("s_waitcnt vmcnt(0)" ::: "memory"); } while (0)
#define RESC(a) do { if (__any((a) < 1.f)) { if (hi == 0) al_l[r32] = (a); asm volatile("s_waitcnt lgkmcnt(0)" ::: "memory"); \
    _Pragma("unroll") for (int d = 0; d < 4; ++d) _Pragma("unroll") for (int r = 0; r < 16; ++r) o[d][r] *= al_l[crow(r, hi)]; } } while (0)
  f32x16 pA0, pA1, pB0, pB1; float mnA, mnB, alA, alB; bf16x8 pa0, pa1, pa2, pa3; const int NT = seq / 64;
  constexpr int SE = 0, SO = SDEPTH - 1;
  SLOAD(SE, 0); asm volatile("s_waitcnt vmcnt(0)" ::: "memory"); SWRITE(0, SE); __syncthreads();
  qkt(pA0, pA1, K_lds, qr, r32, hi, comp); partialSM(pA0, pA1, m_reg, mnA, alA);
  SLOAD(SO, 64); if constexpr (SDEPTH == 2) { if (2 < NT) SLOAD(SE, 2 * 64); }
  SWAIT(); SWRITE(1, SO); __syncthreads();
  for (int j = 1; j + 1 < NT; j += 2) {
    SBAR(); qkt(pB0, pB1, (u16*)((char*)K_lds + SHM_K), qr, r32, hi, comp);
    finishSM(pA0, pA1, alA, l_reg, pa0, pa1, pa2, pa3); SBAR();
    SLOAD(SO, (j + SDEPTH) * 64); SBAR();
    pv_d0(o, vb0, pa0, pa1, pa2, pa3); partialSM(pB0, pB1, m_reg, mnB, alB);
    __syncthreads(); SWAIT(); SWRITE(0, SE);
    RESC(alB); __syncthreads();
    SBAR(); qkt(pA0, pA1, K_lds, qr, r32, hi, comp);
    finishSM(pB0, pB1, alB, l_reg, pa0, pa1, pa2, pa3); SBAR();
    if (SDEPTH == 1 || j + 3 < NT) SLOAD(SE, (j + 1 + SDEPTH) * 64); SBAR();
    pv_d0(o, vb0 + (int)SHM_V, pa0, pa1, pa2, pa3); partialSM(pA0, pA1, m_reg, mnA, alA);
    __syncthreads(); SWAIT(); SWRITE(1, SO);
    RESC(alA); __syncthreads();
  }
  SBAR(); qkt(pB0, pB1, (u16*)((char*)K_lds + SHM_K), qr, r32, hi, comp);
  finishSM(pA0, pA1, alA, l_reg, pa0, pa1, pa2, pa3); SBAR();
  pv_d0(o, vb0, pa0, pa1, pa2, pa3); partialSM(pB0, pB1, m_reg, mnB, alB);
  __syncthreads(); RESC(alB);
  finishSM(pB0, pB1, alB, l_reg, pa0, pa1, pa2, pa3); SBAR();
  pv_d0(o, vb0 + (int)SHM_V, pa0, pa1, pa2, pa3);
  if (hi == 0) li_l[r32] = l_reg; asm volatile("s_waitcnt lgkmcnt(0)" ::: "memory");
  float rli[16];
#pragma unroll
  for (int r = 0; r < 16; ++r) rli[r] = 1.f / li_l[crow(r, hi)];
#undef SLOAD
#undef SWRITE
#undef SWAIT
#undef RESC
  __syncthreads();
  float* ex = (float*)lds;
  const float lam = p.misc[0];
  if (comp == 1) {
#pragma unroll
    for (int d0 = 0; d0 < 4; ++d0)
#pragma unroll
      for (int r = 0; r < 16; ++r) ex[((qg * 4 + d0) * 16 + r) * 64 + lane] = o[d0][r] * rli[r] * lam;
  }
  __syncthreads();
  if (comp == 0) {
    float ssq[16];
#pragma unroll
    for (int r = 0; r < 16; ++r) ssq[r] = 0.f;
#pragma unroll
    for (int d0 = 0; d0 < 4; ++d0)
#pragma unroll
      for (int r = 0; r < 16; ++r) {
        float v = o[d0][r] * rli[r] - ex[((qg * 4 + d0) * 16 + r) * 64 + lane];
        o[d0][r] = v; ssq[r] += v * v;
      }
#pragma unroll
    for (int r = 0; r < 16; ++r) {
      float s = ssq[r];
      s += __shfl_xor(s, 1); s += __shfl_xor(s, 2); s += __shfl_xor(s, 4); s += __shfl_xor(s, 8); s += __shfl_xor(s, 16);
      ssq[r] = rsqrtf(s * (1.f / 128.f) + EPSF) * (1.f - LAM_INIT);
    }
    float sg[4];
#pragma unroll
    for (int d0 = 0; d0 < 4; ++d0) sg[d0] = p.subln_g[d0 * 32 + r32];
    const long base = (tq0 + qg * 32 + 4 * hi) * 1024 + h * 128 + r32;
    const u16* gp = p.gb + base; u16* qp = p.qb + base;
#pragma unroll
    for (int r = 0; r < 16; ++r) {
      const int ro = ((r & 3) + 8 * (r >> 2)) * 1024;
      float g0 = bf2f(gp[ro]), g1 = bf2f(gp[ro + 32]), g2 = bf2f(gp[ro + 64]), g3 = bf2f(gp[ro + 96]);
      qp[ro] = f2bf(o[0][r] * ssq[r] * sg[0] * g0);
      qp[ro + 32] = f2bf(o[1][r] * ssq[r] * sg[1] * g1);
      qp[ro + 64] = f2bf(o[2][r] * ssq[r] * sg[2] * g2);
      qp[ro + 96] = f2bf(o[3][r] * ssq[r] * sg[3] * g3);
      SBAR();
    }
  }
  __syncthreads();
}


template <int D0> __device__ __forceinline__ void pv_two(f32x16& oa, f32x16& ob, int vb, bf16x8 a0, bf16x8 a1, bf16x8 a2, bf16x8 a3, bf16x8 b0, bf16x8 b1, bf16x8 b2, bf16x8 b3) {
  const s16x4 l0 = tr_read<v_rd_off(D0, 0, 0)>(vb), h0 = tr_read<v_rd_off(D0, 0, 1)>(vb), l1 = tr_read<v_rd_off(D0, 1, 0)>(vb), h1 = tr_read<v_rd_off(D0, 1, 1)>(vb);
  const s16x4 l2 = tr_read<v_rd_off(D0, 2, 0)>(vb), h2 = tr_read<v_rd_off(D0, 2, 1)>(vb), l3 = tr_read<v_rd_off(D0, 3, 0)>(vb), h3 = tr_read<v_rd_off(D0, 3, 1)>(vb);
#define PK(L, H) (bf16x8){L[0], L[1], L[2], L[3], H[0], H[1], H[2], H[3]}
  asm volatile("s_waitcnt lgkmcnt(6)" ::: "memory"); SBAR();
  { const bf16x8 v0 = PK(l0, h0);
    oa = __builtin_amdgcn_mfma_f32_32x32x16_bf16(a0, v0, oa, 0, 0, 0);
    ob = __builtin_amdgcn_mfma_f32_32x32x16_bf16(b0, v0, ob, 0, 0, 0); }
  SBAR(); asm volatile("s_waitcnt lgkmcnt(4)" ::: "memory"); SBAR();
  { const bf16x8 v1 = PK(l1, h1);
    oa = __builtin_amdgcn_mfma_f32_32x32x16_bf16(a1, v1, oa, 0, 0, 0);
    ob = __builtin_amdgcn_mfma_f32_32x32x16_bf16(b1, v1, ob, 0, 0, 0); }
  SBAR(); asm volatile("s_waitcnt lgkmcnt(2)" ::: "memory"); SBAR();
  { const bf16x8 v2 = PK(l2, h2);
    oa = __builtin_amdgcn_mfma_f32_32x32x16_bf16(a2, v2, oa, 0, 0, 0);
    ob = __builtin_amdgcn_mfma_f32_32x32x16_bf16(b2, v2, ob, 0, 0, 0); }
  SBAR(); asm volatile("s_waitcnt lgkmcnt(0)" ::: "memory"); SBAR();
  { const bf16x8 v3 = PK(l3, h3);
    oa = __builtin_amdgcn_mfma_f32_32x32x16_bf16(a3, v3, oa, 0, 0, 0);
    ob = __builtin_amdgcn_mfma_f32_32x32x16_bf16(b3, v3, ob, 0, 0, 0); }
#undef PK
}

__device__ __forceinline__ void attn_epi(const Params& p, f32x16 (&o)[4], const float (&rli)[16], int comp, int qg, int lane, int r32, int hi,
                                         long row0, int h, float* ex, float lam, bool dry) {
  const long gbase_i = (row0 + 4 * hi) * 1024 + h * 128 + r32;
  u16 gv0[8][4];
  if (comp == 0) {
    const u16* gp0 = p.gb + gbase_i;
#pragma unroll
    for (int r = 0; r < 8; ++r) {
      const int ro = ((r & 3) + 8 * (r >> 2)) * 1024;
      gv0[r][0] = gp0[ro]; gv0[r][1] = gp0[ro + 32]; gv0[r][2] = gp0[ro + 64]; gv0[r][3] = gp0[ro + 96];
    }
  }
  __syncthreads();
  if (comp == 1) {
#pragma unroll
    for (int d0 = 0; d0 < 4; ++d0)
#pragma unroll
      for (int r = 0; r < 16; ++r) ex[((qg * 4 + d0) * 16 + r) * 64 + lane] = o[d0][r] * rli[r] * lam;
  }
  __syncthreads();
  if (comp == 0) {
    float ssq[16];
#pragma unroll
    for (int r = 0; r < 16; ++r) ssq[r] = 0.f;
#pragma unroll
    for (int d0 = 0; d0 < 4; ++d0)
#pragma unroll
      for (int r = 0; r < 16; ++r) {
        float v = o[d0][r] * rli[r] - ex[((qg * 4 + d0) * 16 + r) * 64 + lane];
        o[d0][r] = v; ssq[r] += v * v;
      }
#pragma unroll
    for (int r = 0; r < 16; ++r) {
      float s = ssq[r];
      s += __shfl_xor(s, 1); s += __shfl_xor(s, 2); s += __shfl_xor(s, 4); s += __shfl_xor(s, 8); s += __shfl_xor(s, 16);
      ssq[r] = rsqrtf(s * (1.f / 128.f) + EPSF) * (1.f - LAM_INIT);
    }
    float sg[4];
#pragma unroll
    for (int d0 = 0; d0 < 4; ++d0) sg[d0] = p.subln_g[d0 * 32 + r32];
    const u16* gp = p.gb + gbase_i; u16* qp = p.qb + gbase_i;
#pragma unroll
    for (int r = 0; r < 8; ++r) {
      const int ro = ((r & 3) + 8 * (r >> 2)) * 1024;
      if (!dry) {
        qp[ro] = f2bf(o[0][r] * ssq[r] * sg[0] * bf2f(gv0[r][0]));
        qp[ro + 32] = f2bf(o[1][r] * ssq[r] * sg[1] * bf2f(gv0[r][1]));
        qp[ro + 64] = f2bf(o[2][r] * ssq[r] * sg[2] * bf2f(gv0[r][2]));
        qp[ro + 96] = f2bf(o[3][r] * ssq[r] * sg[3] * bf2f(gv0[r][3]));
      }
    }
    SBAR();
    u16 gv1[8][4];
#pragma unroll
    for (int rr = 0; rr < 8; ++rr) {
      const int r = 8 + rr, ro = ((r & 3) + 8 * (r >> 2)) * 1024;
      gv1[rr][0] = gp[ro]; gv1[rr][1] = gp[ro + 32]; gv1[rr][2] = gp[ro + 64]; gv1[rr][3] = gp[ro + 96];
    }
    SBAR();
#pragma unroll
    for (int rr = 0; rr < 8; ++rr) {
      const int r = 8 + rr, ro = ((r & 3) + 8 * (r >> 2)) * 1024;
      if (!dry) {
        qp[ro] = f2bf(o[0][r] * ssq[r] * sg[0] * bf2f(gv1[rr][0]));
        qp[ro + 32] = f2bf(o[1][r] * ssq[r] * sg[1] * bf2f(gv1[rr][1]));
        qp[ro + 64] = f2bf(o[2][r] * ssq[r] * sg[2] * bf2f(gv1[rr][2]));
        qp[ro + 96] = f2bf(o[3][r] * ssq[r] * sg[3] * bf2f(gv1[rr][3]));
      }
    }
  }
}

__device__ __forceinline__ void attn_item2(const Params& p, long tq0, int h, const u16* __restrict__ Kh, const u16* __restrict__ Vh, int seq, char* lds, bool dry) {
  constexpr int LDK = 1024;
  const int tid = opaque_tid(), wid = __builtin_amdgcn_readfirstlane(tid >> 6), lane = tid & 63, r32 = lane & 31, hi = lane >> 5;
  const int comp = wid >> 2, qg = wid & 3;
  u16* V_lds = (u16*)lds; u16* K_lds = (u16*)(lds + 2 * SHM_V);
  float* wsl = (float*)(lds + 2 * SHM_V + 2 * SHM_K) + wid * 128; float* li_a = wsl; float* al_a = wsl + 32; float* li_b = wsl + 64; float* al_b = wsl + 96;
  char* Q_lds = lds + 2 * SHM_V + 2 * SHM_K + 4096;
  float m_a = -1e30f, l_a = 0, m_b = -1e30f, l_b = 0; f32x16 oa[4] = {}, ob[4] = {};
#pragma unroll
  for (int i = 0; i < 8; ++i) {
    int id = tid + i * NTHR; int row = id >> 4, ch = id & 15;
    bf16x8 v = *reinterpret_cast<const bf16x8*>(p.qb + (tq0 + row) * 1024 + h * 128 + ch * 8);
    *reinterpret_cast<bf16x8*>(Q_lds + KSWZ(row, ch * 16)) = v;
  }
  const char* qa_p = Q_lds + (qg * 64) * 256; const char* qb_p = qa_p + 32 * 256;
  const int vb0 = (int)(uintptr_t)V_lds + v_rd_base(lane);
  typedef __attribute__((address_space(3))) unsigned char lds_u8;
  typedef __attribute__((address_space(3))) unsigned lds_u32;
  lds_u8* ldsl = (lds_u8*)lds;
  int koff[2], voff[2];
#pragma unroll
  for (int i = 0; i < 2; ++i) {
    const int offb = ((i * 8 + wid) * 64 + lane) * 16;
    { const int row = offb >> 8, wb = offb & 255, colB = wb ^ ((row & 7) << 4); koff[i] = row * LDK + (colB >> 1); }
    { const int sub = offb >> 9, within = offb & 511, kkh = sub >> 2, cblk = sub & 3, e = within >> 1, kkl = e >> 5, cl = e & 31;
      const int kk = kkh * 8 + kkl, k = (kk & ~0xC) | ((kk & 4) << 1) | ((kk & 8) >> 1); voff[i] = k * LDK + cblk * 32 + cl; }
  }
#define DMA(buf, k0) do { _Pragma("unroll") for (int _i = 0; _i < 2; ++_i) { \
    __builtin_amdgcn_global_load_lds((const unsigned*)(Kh + (long)(k0) * LDK + koff[_i]), (lds_u32*)(ldsl + 2 * SHM_V + (buf) * SHM_K + (_i * 8 + wid) * 1024), 16, 0, 0); \
    __builtin_amdgcn_global_load_lds((const unsigned*)(Vh + (long)(k0) * LDK + voff[_i]), (lds_u32*)(ldsl + (buf) * SHM_V + (_i * 8 + wid) * 1024), 16, 0, 0); } } while (0)
#define RESC2(a, O, AL) do { if (__any((a) < 1.f)) { if (hi == 0) AL[r32] = (a); asm volatile("s_waitcnt lgkmcnt(0)" ::: "memory"); \
    _Pragma("unroll") for (int d = 0; d < 4; ++d) _Pragma("unroll") for (int r = 0; r < 16; ++r) O[d][r] *= AL[crow(r, hi)]; } } while (0)
  const int NT = seq / 64;
  DMA(0, 0); asm volatile("s_waitcnt vmcnt(0)" ::: "memory"); __syncthreads();
  for (int j = 0; j < NT; ++j) {
    const int cur = j & 1;
    if (j + 1 < NT) { if (cur) DMA(0, (j + 1) * 64); else DMA(1, (j + 1) * 64); }
    f32x16 pA0 = {}, pA1 = {}, pB0 = {}, pB1 = {};
    {
      const char* Ks = (const char*)K_lds + cur * SHM_K;
#pragma unroll
      for (int d0 = 0; d0 < 4; ++d0) { const int cb = (comp * 64 + d0 * 16 + hi * 8) * 2;
        bf16x8 k0 = *reinterpret_cast<const bf16x8*>(Ks + KSWZ(r32, cb));
        bf16x8 k1 = *reinterpret_cast<const bf16x8*>(Ks + KSWZ(32 + r32, cb));
        bf16x8 qa = *reinterpret_cast<const bf16x8*>(qa_p + KSWZ(r32, cb));
        bf16x8 qb = *reinterpret_cast<const bf16x8*>(qb_p + KSWZ(r32, cb));
        pA0 = __builtin_amdgcn_mfma_f32_32x32x16_bf16(k0, qa, pA0, 0, 0, 0);
        pA1 = __builtin_amdgcn_mfma_f32_32x32x16_bf16(k1, qa, pA1, 0, 0, 0);
        pB0 = __builtin_amdgcn_mfma_f32_32x32x16_bf16(k0, qb, pB0, 0, 0, 0);
        pB1 = __builtin_amdgcn_mfma_f32_32x32x16_bf16(k1, qb, pB1, 0, 0, 0); SBAR(); }
    }
    float mn, al; bf16x8 a0, a1, a2, a3, b0, b1, b2, b3;
    partialSM(pA0, pA1, m_a, mn, al); RESC2(al, oa, al_a); finishSM(pA0, pA1, al, l_a, a0, a1, a2, a3);
    partialSM(pB0, pB1, m_b, mn, al); RESC2(al, ob, al_b); finishSM(pB0, pB1, al, l_b, b0, b1, b2, b3);
    SBAR();
    const int vb = vb0 + cur * (int)SHM_V;
    pv_two<0>(oa[0], ob[0], vb, a0, a1, a2, a3, b0, b1, b2, b3);
    pv_two<1>(oa[1], ob[1], vb, a0, a1, a2, a3, b0, b1, b2, b3);
    pv_two<2>(oa[2], ob[2], vb, a0, a1, a2, a3, b0, b1, b2, b3);
    pv_two<3>(oa[3], ob[3], vb, a0, a1, a2, a3, b0, b1, b2, b3);
    asm volatile("s_waitcnt vmcnt(0)" ::: "memory");
    __syncthreads();
  }
#undef DMA
#undef RESC2
  if (hi == 0) { li_a[r32] = l_a; li_b[r32] = l_b; } asm volatile("s_waitcnt lgkmcnt(0)" ::: "memory");
  const float lam = p.misc[0];
  float* ex = (float*)lds;
  {
    float rli[16];
#pragma unroll
    for (int r = 0; r < 16; ++r) rli[r] = __builtin_amdgcn_rcpf(li_a[crow(r, hi)]);
    attn_epi(p, oa, rli, comp, qg, lane, r32, hi, tq0 + qg * 64, h, ex, lam, dry);
  }
  {
    float rli[16];
#pragma unroll
    for (int r = 0; r < 16; ++r) rli[r] = __builtin_amdgcn_rcpf(li_b[crow(r, hi)]);
    attn_epi(p, ob, rli, comp, qg, lane, r32, hi, tq0 + qg * 64 + 32, h, ex, lam, dry);
  }
  __syncthreads();
}

__device__ __forceinline__ void conv8(const Params& p, long tok_s, int L, int tpos, int ch0, float (&o)[8]) {
  const u16* base = p.xbc + (tok_s + tpos) * 1536 + ch0;
  bf16x8 r1 = *reinterpret_cast<const bf16x8*>(base);
  bf16x8 r0 = {0, 0, 0, 0, 0, 0, 0, 0}, r2 = {0, 0, 0, 0, 0, 0, 0, 0};
  if (tpos > 0) r0 = *reinterpret_cast<const bf16x8*>(base - 1536);
  if (tpos < L - 1) r2 = *reinterpret_cast<const bf16x8*>(base + 1536);
  const f32x4* w0 = reinterpret_cast<const f32x4*>(p.conv_w + ch0);
  const f32x4* w1 = reinterpret_cast<const f32x4*>(p.conv_w + 1536 + ch0);
  const f32x4* w2 = reinterpret_cast<const f32x4*>(p.conv_w + 3072 + ch0);
  const f32x4* bb = reinterpret_cast<const f32x4*>(p.conv_b + ch0);
  const f32x4 wa0 = w0[0], wa1 = w0[1], wb0 = w1[0], wb1 = w1[1], wc0 = w2[0], wc1 = w2[1], b0 = bb[0], b1 = bb[1];
#pragma unroll
  for (int e = 0; e < 4; ++e) {
    float v = b0[e] + wa0[e] * bfs2f(r0[e]) + wb0[e] * bfs2f(r1[e]) + wc0[e] * bfs2f(r2[e]);
    o[e] = siluf(v);
    float u = b1[e] + wa1[e] * bfs2f(r0[4 + e]) + wb1[e] * bfs2f(r1[4 + e]) + wc1[e] * bfs2f(r2[4 + e]);
    o[4 + e] = siluf(u);
  }
}
__device__ __forceinline__ int rotc(int r, int c) { return (c + ((r >> 3) << 3)) & 127; }
__device__ __forceinline__ void chunk_geom(int cg, long& tok_s, int& L, int& tpos0) {
  if (cg < 32) { tok_s = (long)(cg >> 1) * 256; L = 256; tpos0 = (cg & 1) * 128; }
  else { int cs = cg - 32; tok_s = T_CTX + (long)(cs >> 5) * 4096; L = 4096; tpos0 = (cs & 31) * 128; }
}
__device__ __forceinline__ void ssd_dt_scan(const Params& p, long tok0, int head, float* dtv, float* cum, float* scn, float* tot) {
  const int tid = opaque_tid(), lane = tid & 63, wid = tid >> 6;
  if (tid < 256) {
    int d = tid >> 7, tl = tid & 127;
    float raw = p.dtb[(tok0 + tl) * 32 + d * 16 + head] + p.dt_bias[d * 16 + head];
    float dt = (raw > 20.f) ? raw : log1pf(expf(raw));
    float a = -expf(p.A_log[d * 16 + head]) * dt;
    dtv[d * 128 + tl] = dt;
    int li = d ? 127 - tl : tl;
    scn[d * 128 + li] = a;
  }
  __syncthreads();
  if (wid < 2) {
    int d = wid;
    float a0 = scn[d * 128 + 2 * lane], a1 = scn[d * 128 + 2 * lane + 1];
    float s = a0 + a1;
#pragma unroll
    for (int off = 1; off < 64; off <<= 1) { float t = __shfl_up(s, off); if (lane >= off) s += t; }
    float c0 = s - a1, c1 = s;
    int li0 = 2 * lane, li1 = 2 * lane + 1;
    cum[d * 128 + (d ? 127 - li0 : li0)] = c0;
    cum[d * 128 + (d ? 127 - li1 : li1)] = c1;
    if (lane == 63) tot[d] = c1;
  }
  __syncthreads();
}

__device__ void ssd_state_item(const Params& p, int cg, int head, char* smem, bool dry) {
  const int tid = opaque_tid(), lane = tid & 63, wid = tid >> 6, fr = lane & 15, fq = lane >> 4;
  float* dtv = (float*)smem; float* cum = dtv + 256; float* scn = cum + 256; float* tot = scn + 256;
  u16* XsT = (u16*)(smem + 4096);
  u16* BT = XsT + 64 * 136;
  long tok_s; int L, tpos0; chunk_geom(cg, tok_s, L, tpos0);
  const long tok0 = (long)cg * 128;
  const int g = head >> 2;
  ssd_dt_scan(p, tok0, head, dtv, cum, scn, tot);
  const float tot0 = tot[0], tot1 = tot[1];
#pragma unroll
  for (int rep = 0; rep < 2; ++rep) {
    int id = tid + rep * NTHR; int tl = id >> 3, p0 = (id & 7) * 8;
    float xo[8], bo[8];
    conv8(p, tok_s, L, tpos0 + tl, head * 64 + p0, xo);
    conv8(p, tok_s, L, tpos0 + tl, 1024 + g * 64 + p0, bo);
    float s0 = dtv[tl] * __expf(tot0 - cum[tl]);
    float s1 = dtv[128 + tl] * __expf(tot1 - cum[128 + tl]);
    const int tc = rotc(p0, tl);
#pragma unroll
    for (int e = 0; e < 8; ++e) {
      XsT[(p0 + e) * 136 + tc] = f2bf(xo[e]);
      BT[(p0 + e) * 136 + tc] = f2bf(bo[e] * s0);
      BT[(64 + p0 + e) * 136 + tc] = f2bf(bo[e] * s1);
    }
  }
  __syncthreads();
  {
    const int d = wid >> 2, pb = wid & 3;
    f32x4 acc[4];
#pragma unroll
    for (int ni = 0; ni < 4; ++ni) acc[ni] = f32x4{0.f, 0.f, 0.f, 0.f};
#pragma unroll
    for (int ks = 0; ks < 4; ++ks) {
      bf16x8 a = *reinterpret_cast<const bf16x8*>(XsT + (pb * 16 + fr) * 136 + rotc(pb * 16 + fr, ks * 32 + fq * 8));
#pragma unroll
      for (int ni = 0; ni < 4; ++ni) {
        bf16x8 b = *reinterpret_cast<const bf16x8*>(BT + (d * 64 + ni * 16 + fr) * 136 + rotc(ni * 16 + fr, ks * 32 + fq * 8));
        acc[ni] = mfma16(a, b, acc[ni]);
      }
    }
    u16* dst = p.st + ((long)(cg * 16 + head) * 2 + d) * 4096;
#pragma unroll
    for (int ni = 0; ni < 4; ++ni)
#pragma unroll
      for (int j = 0; j < 4; ++j) { if (!dry) dst[(pb * 16 + fq * 4 + j) * 64 + ni * 16 + fr] = f2bf(acc[ni][j]); }
  }
  if (tid < 2 && !dry) p.cd[(cg * 16 + head) * 2 + tid] = __expf(tot[tid]);
  __syncthreads();
}

__device__ void ssd_state_item2(const Params& p, int it0, char* smem, bool dry) {
  const int tid = opaque_tid(), lane = tid & 63, wid = tid >> 6, fr = lane & 15, fq = lane >> 4;
  constexpr int RSTRIDE = 57344;
  {
    const int u = tid >> 8, t2 = tid & 255, cg = (it0 + u) >> 4, head = (it0 + u) & 15;
    float* dtv = (float*)(smem + u * RSTRIDE); float* scn = dtv + 512;
    const int d = t2 >> 7, tl = t2 & 127;
    float raw = p.dtb[((long)cg * 128 + tl) * 32 + d * 16 + head] + p.dt_bias[d * 16 + head];
    float dt = (raw > 20.f) ? raw : log1pf(expf(raw));
    float a = -expf(p.A_log[d * 16 + head]) * dt;
    dtv[d * 128 + tl] = dt;
    scn[d * 128 + (d ? 127 - tl : tl)] = a;
  }
  __syncthreads();
  if (wid < 4) {
    const int u = wid >> 1, d = wid & 1;
    float* dtv = (float*)(smem + u * RSTRIDE); float* cum = dtv + 256; float* scn = cum + 256; float* tot = scn + 256;
    float a0 = scn[d * 128 + 2 * lane], a1 = scn[d * 128 + 2 * lane + 1];
    float sacc = a0 + a1;
#pragma unroll
    for (int off = 1; off < 64; off <<= 1) { float t = __shfl_up(sacc, off); if (lane >= off) sacc += t; }
    float c0 = sacc - a1, c1 = sacc;
    int li0 = 2 * lane, li1 = 2 * lane + 1;
    cum[d * 128 + (d ? 127 - li0 : li0)] = c0;
    cum[d * 128 + (d ? 127 - li1 : li1)] = c1;
    if (lane == 63) tot[d] = c1;
  }
  __syncthreads();
#pragma unroll
  for (int u = 0; u < 2; ++u) {
    const int cg = (it0 + u) >> 4, head = (it0 + u) & 15, g = head >> 2;
    float* dtv = (float*)(smem + u * RSTRIDE); float* cum = dtv + 256; float* tot = dtv + 768;
    u16* XsT = (u16*)(smem + u * RSTRIDE + 4096); u16* BT = XsT + 64 * 136;
    long tok_s; int L, tpos0; chunk_geom(cg, tok_s, L, tpos0);
    const float tot0 = tot[0], tot1 = tot[1];
#pragma unroll
    for (int rep = 0; rep < 2; ++rep) {
      int id = tid + rep * NTHR; int tl = id >> 3, p0 = (id & 7) * 8;
      float xo[8], bo[8];
      conv8(p, tok_s, L, tpos0 + tl, head * 64 + p0, xo);
      conv8(p, tok_s, L, tpos0 + tl, 1024 + g * 64 + p0, bo);
      float s0 = dtv[tl] * __expf(tot0 - cum[tl]);
      float s1 = dtv[128 + tl] * __expf(tot1 - cum[128 + tl]);
      const int tc = rotc(p0, tl);
#pragma unroll
      for (int e = 0; e < 8; ++e) {
        XsT[(p0 + e) * 136 + tc] = f2bf(xo[e]);
        BT[(p0 + e) * 136 + tc] = f2bf(bo[e] * s0);
        BT[(64 + p0 + e) * 136 + tc] = f2bf(bo[e] * s1);
      }
    }
  }
  __syncthreads();
#pragma unroll
  for (int u = 0; u < 2; ++u) {
    const int cg = (it0 + u) >> 4, head = (it0 + u) & 15;
    const u16* XsT = (const u16*)(smem + u * RSTRIDE + 4096); const u16* BT = XsT + 64 * 136;
    const float* tot = (const float*)(smem + u * RSTRIDE) + 768;
    const int d = wid >> 2, pb = wid & 3;
    f32x4 acc[4];
#pragma unroll
    for (int ni = 0; ni < 4; ++ni) acc[ni] = f32x4{0.f, 0.f, 0.f, 0.f};
#pragma unroll
    for (int ks = 0; ks < 4; ++ks) {
      bf16x8 a = *reinterpret_cast<const bf16x8*>(XsT + (pb * 16 + fr) * 136 + rotc(pb * 16 + fr, ks * 32 + fq * 8));
#pragma unroll
      for (int ni = 0; ni < 4; ++ni) {
        bf16x8 b = *reinterpret_cast<const bf16x8*>(BT + (d * 64 + ni * 16 + fr) * 136 + rotc(ni * 16 + fr, ks * 32 + fq * 8));
        acc[ni] = mfma16(a, b, acc[ni]);
      }
    }
    u16* dst = p.st + ((long)(cg * 16 + head) * 2 + d) * 4096;
#pragma unroll
    for (int ni = 0; ni < 4; ++ni)
#pragma unroll
      for (int j = 0; j < 4; ++j) { if (!dry) dst[(pb * 16 + fq * 4 + j) * 64 + ni * 16 + fr] = f2bf(acc[ni][j]); }
    if (tid < 2 && !dry) p.cd[(cg * 16 + head) * 2 + tid] = __expf(tot[tid]);
  }
  __syncthreads();
}

__device__ void phase3_attn(const Params& p, char* smem, bool dry) {
  constexpr int N_AS = 512, N_AC = 128;
  for (int it = blockIdx.x; it < N_AS + N_AC; it += gridDim.x) {
    long tq0; int h, seq; const u16 *kp, *vp;
    if (it < N_AS) {
      int qbi = it & 15, b = it >> 7; h = (it >> 4) & 7;
      if (gridDim.x == 256) {
        const int r = it >> 8, bid = it & 255, slot = bid >> 3;
        const int bh = r * 16 + (bid & 7) * 2 + (slot >> 4);
        qbi = slot & 15; b = bh >> 3; h = bh & 7;
      }
      tq0 = T_CTX + (long)b * 4096 + qbi * 256; seq = 4608;
      kp = p.kS + (long)b * 4608 * 1024 + h * 128; vp = p.vS + (long)b * 4608 * 1024 + h * 128;
    } else {
      int i = it - N_AS; int b = i >> 3; h = i & 7;
      tq0 = (long)b * 256; seq = 256;
      kp = p.kC + (long)b * 256 * 1024 + h * 128; vp = p.vC + (long)b * 256 * 1024 + h * 128;
    }
    attn_item2(p, tq0, h, kp, vp, seq, smem, dry);
  }
}
__device__ void phase3_state(const Params& p, char* smem, bool dry) {
  int start = blockIdx.x, stride = gridDim.x, cnt = (160 * 8 - (int)blockIdx.x + (int)gridDim.x - 1) / (int)gridDim.x;
  if (gridDim.x == 256) { stride = 128; if (blockIdx.x < 128) { start = blockIdx.x; cnt = 4; } else { start = 512 + (blockIdx.x - 128); cnt = 6; } }
#pragma unroll 1
  for (int k = 0; k < cnt; ++k) ssd_state_item2(p, (start + k * stride) * 2, smem, dry);
}
__device__ void phase3(const Params& p, char* smem) {
  if (p.probe & 8) phase3_attn(p, smem, true);
  if (p.probe & 16) phase3_state(p, smem, true);
  phase3_attn(p, smem, false);
  phase3_state(p, smem, false);
}

__device__ void phase4(const Params& p, char* smem) {
  const int tid = opaque_tid();
  for (int it = blockIdx.x; it < 256 + 1024; it += gridDim.x) {
    int seq, head, d, half, nc, c0; const float* h0p = nullptr; float* outp = nullptr;
    if (it < 256) { half = it & 1; d = (it >> 1) & 1; head = (it >> 2) & 15; int b = it >> 6; seq = 16 + b; nc = 32; c0 = 32 + b * 32;
      h0p = p.state_ssd + ((long)(b * 2 + d) * 16 + head) * 4096; }
    else { int i = it - 256; half = i & 1; d = (i >> 1) & 1; head = (i >> 2) & 15; int b = i >> 6; seq = b; nc = 2; c0 = b * 2;
      outp = p.out + 29360128L + ((long)(b * 2 + d) * 16 + head) * 4096; }
    (void)seq;
    const int e = half * 2048 + tid * 4;
    float h[4] = {0.f, 0.f, 0.f, 0.f};
    if (h0p) { float4 v = *reinterpret_cast<const float4*>(h0p + e); h[0] = v.x; h[1] = v.y; h[2] = v.z; h[3] = v.w; }
    const int cstart = d ? c0 + nc - 1 : c0, cstep = d ? -1 : 1;
    for (int i0 = 0; i0 < nc; i0 += 8) {
      u32x2 sv[8]; float dc[8];
#pragma unroll
      for (int k = 0; k < 8; ++k) if (i0 + k < nc) {
        int cgi = cstart + (i0 + k) * cstep;
        sv[k] = *reinterpret_cast<const u32x2*>(p.st + ((long)(cgi * 16 + head) * 2 + d) * 4096 + e);
        dc[k] = p.cd[(cgi * 16 + head) * 2 + d];
      }
#pragma unroll
      for (int k = 0; k < 8; ++k) if (i0 + k < nc) {
        int cgi = cstart + (i0 + k) * cstep;
        u32x2 hw = {cvtpk(h[0], h[1]), cvtpk(h[2], h[3])};
        *reinterpret_cast<u32x2*>(p.st + ((long)(cgi * 16 + head) * 2 + d) * 4096 + e) = hw;
        float s0 = __uint_as_float(sv[k][0] << 16), s1 = __uint_as_float(sv[k][0] & 0xffff0000u);
        float s2 = __uint_as_float(sv[k][1] << 16), s3 = __uint_as_float(sv[k][1] & 0xffff0000u);
        h[0] = h[0] * dc[k] + s0; h[1] = h[1] * dc[k] + s1; h[2] = h[2] * dc[k] + s2; h[3] = h[3] * dc[k] + s3;
      }
    }
    if (outp) { float4 v = {h[0], h[1], h[2], h[3]}; *reinterpret_cast<float4*>(outp + e) = v; }
  }
}

__device__ void ssd_y_item(const Params& p, int cg, int head, char* smem, bool dry) {
  const int tid = opaque_tid(), lane = tid & 63, wid = tid >> 6, fr = lane & 15, fq = lane >> 4;
  float* dtv = (float*)smem; float* cum = dtv + 256; float* scn = cum + 256; float* tot = scn + 256;
  u16* XT = (u16*)(smem + 4096);
  u16* Cs = XT + 64 * 136;
  u16* Bs = Cs + 128 * 72;
  u16* Ms = Bs + 128 * 72;
  u16* Hs = Ms + 128 * 136;
  long tok_s; int L, tpos0; chunk_geom(cg, tok_s, L, tpos0);
  const long tok0 = (long)cg * 128;
  const int g = head >> 2;
  bf16x8 hpre[2];
  {
    const int pp = tid >> 3, ch = (tid & 7) * 8;
    hpre[0] = *reinterpret_cast<const bf16x8*>(p.st + ((long)(cg * 16 + head) * 2 + 0) * 4096 + pp * 64 + ch);
    hpre[1] = *reinterpret_cast<const bf16x8*>(p.st + ((long)(cg * 16 + head) * 2 + 1) * 4096 + pp * 64 + ch);
  }
  ssd_dt_scan(p, tok0, head, dtv, cum, scn, tot);
#pragma unroll
  for (int rep = 0; rep < 2; ++rep) {
    int id = tid + rep * NTHR; int tl = id >> 3, p0 = (id & 7) * 8;
    float xo[8], bo[8], co[8];
    conv8(p, tok_s, L, tpos0 + tl, head * 64 + p0, xo);
    conv8(p, tok_s, L, tpos0 + tl, 1024 + g * 64 + p0, bo);
    conv8(p, tok_s, L, tpos0 + tl, 1280 + g * 64 + p0, co);
#pragma unroll
    for (int e = 0; e < 8; ++e) XT[(p0 + e) * 136 + rotc(p0, tl)] = f2bf(xo[e]);
    *reinterpret_cast<bf16x8*>(Bs + tl * 72 + p0) = pack8(bo);
    *reinterpret_cast<bf16x8*>(Cs + tl * 72 + p0) = pack8(co);
  }
  __syncthreads();
  f32x4 cb[8];
#pragma unroll
  for (int si = 0; si < 8; ++si) cb[si] = f32x4{0.f, 0.f, 0.f, 0.f};
#pragma unroll
  for (int ks = 0; ks < 2; ++ks) {
    bf16x8 a = *reinterpret_cast<const bf16x8*>(Cs + (wid * 16 + fr) * 72 + ks * 32 + fq * 8);
#pragma unroll
    for (int si = 0; si < 8; ++si) {
      bf16x8 b = *reinterpret_cast<const bf16x8*>(Bs + (si * 16 + fr) * 72 + ks * 32 + fq * 8);
      cb[si] = mfma16(a, b, cb[si]);
    }
  }
  f32x4 yacc[4];
#pragma unroll
  for (int pi = 0; pi < 4; ++pi) yacc[pi] = f32x4{0.f, 0.f, 0.f, 0.f};
  u16 zpre[4][4];
#pragma unroll
  for (int j = 0; j < 4; ++j)
#pragma unroll
    for (int pi = 0; pi < 4; ++pi) zpre[j][pi] = p.zb[(tok0 + wid * 16 + fq * 4 + j) * 1024 + head * 64 + pi * 16 + fr];
  {
    {
      int pp = tid >> 3, ch = (tid & 7) * 8;
      *reinterpret_cast<bf16x8*>(Hs + pp * 72 + ch) = hpre[0];
      *reinterpret_cast<bf16x8*>(Hs + 64 * 72 + pp * 72 + ch) = hpre[1];
    }
    float cq0[4], cq1[4];
#pragma unroll
    for (int j = 0; j < 4; ++j) { cq0[j] = cum[wid * 16 + fq * 4 + j]; cq1[j] = cum[128 + wid * 16 + fq * 4 + j]; }
#pragma unroll
    for (int si = 0; si < 8; ++si) {
      const int s = si * 16 + fr;
      const float cs0 = cum[s], cs1 = cum[128 + s], dt0 = dtv[s], dt1 = dtv[128 + s];
#pragma unroll
      for (int j = 0; j < 4; ++j) {
        const int q = wid * 16 + fq * 4 + j;
        const float arg = (s < q) ? (cq0[j] - cs0) : (cq1[j] - cs1);
        const float w = (s < q) ? dt0 : ((s > q) ? dt1 : dt0 + dt1);
        const float v = cb[si][j] * __expf((s == q) ? 0.f : arg) * w;
        Ms[q * 136 + s] = f2bf(v);
      }
    }
    __syncthreads();
    f32x4 tmp0[4], tmp1[4];
#pragma unroll
    for (int pi = 0; pi < 4; ++pi) { tmp0[pi] = f32x4{0.f, 0.f, 0.f, 0.f}; tmp1[pi] = f32x4{0.f, 0.f, 0.f, 0.f}; }
#pragma unroll
    for (int ks = 0; ks < 4; ++ks) {
      bf16x8 a = *reinterpret_cast<const bf16x8*>(Ms + (wid * 16 + fr) * 136 + ks * 32 + fq * 8);
#pragma unroll
      for (int pi = 0; pi < 4; ++pi) {
        bf16x8 b = *reinterpret_cast<const bf16x8*>(XT + (pi * 16 + fr) * 136 + rotc(pi * 16 + fr, ks * 32 + fq * 8));
        yacc[pi] = mfma16(a, b, yacc[pi]);
      }
    }
#pragma unroll
    for (int ks = 0; ks < 2; ++ks) {
      bf16x8 a = *reinterpret_cast<const bf16x8*>(Cs + (wid * 16 + fr) * 72 + ks * 32 + fq * 8);
#pragma unroll
      for (int pi = 0; pi < 4; ++pi) {
        bf16x8 b0 = *reinterpret_cast<const bf16x8*>(Hs + (pi * 16 + fr) * 72 + ks * 32 + fq * 8);
        bf16x8 b1 = *reinterpret_cast<const bf16x8*>(Hs + 64 * 72 + (pi * 16 + fr) * 72 + ks * 32 + fq * 8);
        tmp0[pi] = mfma16(a, b0, tmp0[pi]);
        tmp1[pi] = mfma16(a, b1, tmp1[pi]);
      }
    }
#pragma unroll
    for (int j = 0; j < 4; ++j) {
      const float e0 = __expf(cq0[j]), e1 = __expf(cq1[j]);
#pragma unroll
      for (int pi = 0; pi < 4; ++pi) yacc[pi][j] += e0 * tmp0[pi][j] + e1 * tmp1[pi][j];
    }
  }
  const float dsk = p.D_skip[head];
#pragma unroll
  for (int j = 0; j < 4; ++j) {
    int q = wid * 16 + fq * 4 + j;
    float ss = 0.f;
#pragma unroll
    for (int pi = 0; pi < 4; ++pi) {
      int pp = pi * 16 + fr;
      long idx = (tok0 + q) * 1024 + head * 64 + pp;
      float y = yacc[pi][j] + dsk * bf2f(XT[pp * 136 + rotc(pp, q)]);
      float yg = y * bf2f(zpre[j][pi]);
      if (!dry) p.zb[idx] = f2bf(yg);
      ss += yg * yg;
    }
    ss += __shfl_xor(ss, 1); ss += __shfl_xor(ss, 2); ss += __shfl_xor(ss, 4); ss += __shfl_xor(ss, 8);
    if (fr == 0 && !dry) p.ssqp[(tok0 + q) * 16 + head] = ss;
  }
  __syncthreads();
}
__device__ void phase5(const Params& p, char* smem) {
  if (p.probe & 32) { for (int it = blockIdx.x; it < 160 * 16; it += gridDim.x) ssd_y_item(p, it >> 4, it & 15, smem, true); }
  for (int it = blockIdx.x; it < 160 * 16; it += gridDim.x) ssd_y_item(p, it >> 4, it & 15, smem, false);
}

struct SegOrder : pg8::StaticOrder {
  __device__ bool next(int i, pg8::Unit& u) const {
    if (G != 256 || nwg != 320) { if (!tile_at((long)(i >> 1) * G + c, u)) return false; u.seg = i & 1; return true; }
    if (i < 2) { tile_at(c, u); u.seg = i; return true; }
    if (i > 2 || c >= 128) return false;
    const int t2 = c & 63;
    tile_at(256 + t2, u); u.seg = c >> 6; u.split = 1 + t2; return true;
  }
};
struct EpiOut {
  static constexpr bool PERM = true, AFTER_DRAIN = false, KEEP = true;
  const Params& p;
  __device__ __forceinline__ void operator()(f32x4 (&acc)[2][2][4][2], const pg8::Unit& u, int wr, int wc, int fr, int fq) const {
    const int m0 = u.pm * 256, n0 = u.pn * 256;
    if (u.seg == 0) {
#pragma unroll
      for (int ai = 0; ai < 2; ++ai) {
        f32x4 sv[4][4];
#pragma unroll
        for (int m = 0; m < 4; ++m) {
          const int t = m0 + ai * 128 + wr * 64 + m * 16 + fr;
          const f32x4* sp = reinterpret_cast<const f32x4*>(p.ssqp + (long)t * 16);
          sv[m][0] = sp[0]; sv[m][1] = sp[1]; sv[m][2] = sp[2]; sv[m][3] = sp[3];
        }
        SBAR();
#pragma unroll
        for (int m = 0; m < 4; ++m) {
          const f32x4 sa = sv[m][0] + sv[m][1] + sv[m][2] + sv[m][3];
          const float r = rsqrtf((sa[0] + sa[1] + sa[2] + sa[3]) * (1.f / 1024.f) + EPSF);
#pragma unroll
          for (int bj = 0; bj < 2; ++bj)
#pragma unroll
            for (int n = 0; n < 2; ++n) acc[ai][bj][m][n] *= r;
        }
        SBAR();
      }
      if (u.split) {
        const int wid = wr * 4 + wc, lane = fq * 16 + fr;
        float* sc = reinterpret_cast<float*>(p.st) + (size_t)(u.split - 1) * 65536 + (wid * 64 + lane) * 4;
#pragma unroll
        for (int ai = 0; ai < 2; ++ai)
#pragma unroll
          for (int bj = 0; bj < 2; ++bj)
#pragma unroll
            for (int m = 0; m < 4; ++m)
              { *reinterpret_cast<f32x4*>(sc + ((((ai * 2 + bj) * 4 + m) * 2 + 0) * 2048)) = acc[ai][bj][m][0]; *reinterpret_cast<f32x4*>(sc + ((((ai * 2 + bj) * 4 + m) * 2 + 1) * 2048)) = acc[ai][bj][m][1]; }
        __builtin_amdgcn_fence(__ATOMIC_RELEASE, "agent");
        asm volatile("s_waitcnt vmcnt(0)" ::: "memory");
        if (lane == 0) __hip_atomic_fetch_add(p.bar + SPLIT_FLAG0 + (u.split - 1), 1u, __ATOMIC_RELAXED, __HIP_MEMORY_SCOPE_AGENT);
      }
      return;
    }
    if (u.split) {
      const int wid = wr * 4 + wc, lane = fq * 16 + fr;
      unsigned* fl = p.bar + SPLIT_FLAG0 + (u.split - 1);
      unsigned sp = 0;
      while (__hip_atomic_load(fl, __ATOMIC_RELAXED, __HIP_MEMORY_SCOPE_AGENT) < 8u) { __builtin_amdgcn_s_sleep(2); if (++sp > (1u << 22)) break; }
      __builtin_amdgcn_fence(__ATOMIC_ACQUIRE, "agent");
      asm volatile("s_waitcnt vmcnt(0)" ::: "memory");
    }
    const int mr = (m0 < T_CTX) ? 0 : 1 + ((m0 - T_CTX) >> 12);
    const float* xb = (m0 < T_CTX) ? p.x_prompt + (long)m0 * 1024 : p.x_sample + (long)(m0 - T_CTX) * 1024;
    const int c0 = n0 + wc * 32 + 8 * fq;
    const float* gbase = p.modv + mr * 3072 + 2048 + c0;
    const bool spl = (u.split != 0);
    const int pstr = spl ? 2048 : 0;
    const float* pbase = spl ? reinterpret_cast<const float*>(p.st) + (size_t)(u.split - 1) * 65536 + ((wr * 4 + wc) * 64 + fq * 16 + fr) * 4
                             : reinterpret_cast<const float*>(p.bar + SPLIT_FLAG0 + 64);
#pragma unroll
    for (int ai = 0; ai < 2; ++ai)
#pragma unroll
      for (int mp = 0; mp < 2; ++mp) {
        f32x4 xv[2][2][2];
#pragma unroll
        for (int mm = 0; mm < 2; ++mm) {
          const int m = mp * 2 + mm, rl = ai * 128 + wr * 64 + m * 16 + fr;
          const float* xr = xb + rl * 1024 + c0;
#pragma unroll
          for (int bj = 0; bj < 2; ++bj) {
            xv[mm][bj][0] = *reinterpret_cast<const f32x4*>(xr + bj * 128); xv[mm][bj][1] = *reinterpret_cast<const f32x4*>(xr + bj * 128 + 4);
          }
        }
        SBAR();
#pragma unroll
        for (int mm = 0; mm < 2; ++mm) {
          const int m = mp * 2 + mm, rl = ai * 128 + wr * 64 + m * 16 + fr;
          u16* orow = p.kC + (long)(m0 + rl) * 1024 + c0;
          const float* gp = gbase; asm volatile("" : "+v"(gp));
          float ss = 0.f;
#pragma unroll
          for (int bj = 0; bj < 2; ++bj) {
            const f32x4 g0 = *reinterpret_cast<const f32x4*>(gp + bj * 128), g1 = *reinterpret_cast<const f32x4*>(gp + bj * 128 + 4);
            const f32x4 q0 = *reinterpret_cast<const f32x4*>(pbase + ((((ai * 2 + bj) * 4 + m) * 2 + 0) * pstr));
            const f32x4 q1 = *reinterpret_cast<const f32x4*>(pbase + ((((ai * 2 + bj) * 4 + m) * 2 + 1) * pstr));
            f32x4 v0 = xv[mm][bj][0] + g0 * (acc[ai][bj][m][0] + q0);
            f32x4 v1 = xv[mm][bj][1] + g1 * (acc[ai][bj][m][1] + q1);
            u32x4 w = {cvtpk(v0[0], v0[1]), cvtpk(v0[2], v0[3]), cvtpk(v1[0], v1[1]), cvtpk(v1[2], v1[3])};
            *reinterpret_cast<u32x4*>(orow + bj * 128) = w;
#pragma unroll
            for (int e = 0; e < 4; ++e) {
              float lo = __uint_as_float(w[e] << 16), hi = __uint_as_float(w[e] & 0xffff0000u);
              ss += lo * lo + hi * hi;
            }
          }
          ss += __shfl_xor(ss, 16); ss += __shfl_xor(ss, 32);
          if (fq == 0) p.ssq2p[(long)(m0 + rl) * 16 + u.pn * 4 + wc] = ss;
        }
        SBAR();
      }
  }
};
__device__ void phase6(const Params& p, char* smem) {
  SegOrder S; S.init(T_ALL, 1024, (int)gridDim.x, (int)blockIdx.x);
  pg8::Gemm g{p.zb, p.woutT + 1024 * 1024, T_ALL, 1024, 1024, p.qb, p.woutT};
  EpiOut E{p};
  pg8::gemm_phase<EpiOut, SegOrder, false>((PG8_LAS unsigned char*)smem, g, S, E, nullptr);
  __syncthreads();
}

__device__ void phase7(const Params& p, char* smem) {
  const int tid = opaque_tid(), lane = tid & 63, wid = tid >> 6;
  for (int it = blockIdx.x; it < T_ALL / 32; it += gridDim.x) {
    u32x2 w[4][4]; float sq[4];
#pragma unroll
    for (int rr = 0; rr < 4; ++rr) {
      const int t = it * 32 + rr * 8 + wid;
      const u16* xr = p.kC + (long)t * 1024;
#pragma unroll
      for (int i = 0; i < 4; ++i) w[rr][i] = *reinterpret_cast<const u32x2*>(xr + i * 256 + lane * 4);
      sq[rr] = (lane < 16) ? p.ssq2p[(long)t * 16 + lane] : 0.f;
    }
#pragma unroll
    for (int rr = 0; rr < 4; ++rr) {
      const int t = it * 32 + rr * 8 + wid;
      float s = sq[rr];
      s += __shfl_xor(s, 1); s += __shfl_xor(s, 2); s += __shfl_xor(s, 4); s += __shfl_xor(s, 8);
      s = __shfl(s, 0);
      const float rs = rsqrtf(s * (1.f / 1024.f) + EPSF);
      float* yr = p.out + (long)t * 1024;
#pragma unroll
      for (int i = 0; i < 4; ++i) {
        int col = i * 256 + lane * 4;
        float4 g = *reinterpret_cast<const float4*>(p.final_g + col);
        float4 v;
        v.x = __uint_as_float(w[rr][i][0] << 16) * rs * g.x; v.y = __uint_as_float(w[rr][i][0] & 0xffff0000u) * rs * g.y;
        v.z = __uint_as_float(w[rr][i][1] << 16) * rs * g.z; v.w = __uint_as_float(w[rr][i][1] & 0xffff0000u) * rs * g.w;
        __builtin_nontemporal_store(v.x, yr + col); __builtin_nontemporal_store(v.y, yr + col + 1);
        __builtin_nontemporal_store(v.z, yr + col + 2); __builtin_nontemporal_store(v.w, yr + col + 3);
      }
    }
  }
}

#define XB_TMO      128
#define XB_XCNT(j)  (256  + 64 * (j))
#define XB_XSUB(j)  (1280 + 64 * (j))
#define XB_XGEN(j)  (2304 + 64 * (j))
#define XB_TOP      3328
#define XB_TOPGEN   3392
#define XCD_BAR_WORDS 3456
#define XB_SPIN_CAP (1u << 18)
#define XLAS __attribute__((address_space(3)))

__device__ __forceinline__ unsigned xb_ld(unsigned* p)              { return __hip_atomic_load(p, __ATOMIC_RELAXED, __HIP_MEMORY_SCOPE_AGENT); }
__device__ __forceinline__ unsigned xb_add(unsigned* p, unsigned v) { return __hip_atomic_fetch_add(p, v, __ATOMIC_RELAXED, __HIP_MEMORY_SCOPE_AGENT); }
__device__ __forceinline__ unsigned xb_xcc_id() { return (unsigned)__builtin_amdgcn_s_getreg((3 << 11) | 20) & 0xFu; }
#define XB_SPIN(cond, bar) do { unsigned _sp = 0; while (cond) { __builtin_amdgcn_s_sleep(1); \
    if ((++_sp & 255u) == 0u) { if (xb_ld(&(bar)[XB_TMO])) break; if (_sp > XB_SPIN_CAP) { atomicAdd(&(bar)[XB_TMO], 1u); break; } } } } while (0)

struct XcdBarrier {
    unsigned* bar; unsigned x;
    volatile XLAS unsigned* st;
};

__device__ __forceinline__ XcdBarrier xcd_barrier_post(unsigned* bar, volatile XLAS unsigned* st) {
    XcdBarrier b; b.bar = bar; b.x = xb_xcc_id(); b.st = st;
    if (threadIdx.x == 0) (void)xb_add(&bar[XB_XCNT(b.x)], 1u);
    return b;
}
__device__ __forceinline__ void xcd_barrier_complete(unsigned* bar, unsigned x, unsigned& nloc, unsigned& nx) {
    const unsigned G = gridDim.x * gridDim.y * gridDim.z;
    unsigned sum, cnt, mine, sp = 0u;
    for (;;) {
        sum = 0u; cnt = 0u; mine = 0u;
#pragma unroll
        for (unsigned j = 0; j < 16; ++j) { const unsigned c = xb_ld(&bar[XB_XCNT(j)]); sum += c; cnt += (c > 0u) ? 1u : 0u; mine = (j == x) ? c : mine; }
        if (sum == G) break;
        __builtin_amdgcn_s_sleep(1);
        if ((++sp & 255u) == 0u) { if (xb_ld(&bar[XB_TMO])) break; if (sp > XB_SPIN_CAP) { atomicAdd(&bar[XB_TMO], 1u); break; } }
    }
    nloc = mine > 0u ? mine : 1u; nx = cnt > 0u ? cnt : 1u;
}

__device__ __forceinline__ void xcd_barrier(const XcdBarrier& b) {
    asm volatile("s_waitcnt vmcnt(0)" ::: "memory");
    __syncthreads();
    if (threadIdx.x == 0) {
        unsigned* bar = b.bar;
        __builtin_amdgcn_s_waitcnt(0);
        unsigned nloc = b.st[0], nx = b.st[1];
        if (nloc == 0u) { xcd_barrier_complete(bar, b.x, nloc, nx); b.st[0] = nloc; b.st[1] = nx; }
        const unsigned old = xb_add(&bar[XB_XSUB(b.x)], 1u);
        const unsigned gen = old / nloc;
        if (old + 1u == (gen + 1u) * nloc) {
            __builtin_amdgcn_fence(__ATOMIC_RELEASE, "agent");
            asm volatile("s_waitcnt vmcnt(0)" ::: "memory");
            const unsigned og = xb_add(&bar[XB_TOP], 1u);
            const unsigned tg = og / nx;
            if (og + 1u == (tg + 1u) * nx) xb_add(&bar[XB_TOPGEN], 1u);
            else XB_SPIN(xb_ld(&bar[XB_TOPGEN]) == tg, bar);
            __builtin_amdgcn_fence(__ATOMIC_ACQUIRE, "agent");
            xb_add(&bar[XB_XGEN(b.x)], 1u);
            asm volatile("s_waitcnt vmcnt(0)" ::: "memory");
        } else {
            XB_SPIN(xb_ld(&bar[XB_XGEN(b.x)]) == gen, bar);
            __builtin_amdgcn_fence(__ATOMIC_ACQUIRE, "agent");
            asm volatile("s_waitcnt vmcnt(0)" ::: "memory");
        }
    }
    __syncthreads();
}

template <int PH> __device__ __forceinline__ void run_phase(const Params& p, char* smem) {
  if constexpr (PH == 0) phase0(p, smem);
  if constexpr (PH == 1) phase1(p, smem);
  if constexpr (PH == 2) phase2(p, smem);
  if constexpr (PH == 3) phase3(p, smem);
  if constexpr (PH == 4) phase4(p, smem);
  if constexpr (PH == 5) phase5(p, smem);
  if constexpr (PH == 6) phase6(p, smem);
  if constexpr (PH == 7) phase7(p, smem);
}

#if MK_COOP
__global__ void __launch_bounds__(NTHR) fwd_megakernel(Params p) {
  extern __shared__ __attribute__((aligned(16))) char smem[];
  cg::grid_group grid = cg::this_grid();
  __shared__ unsigned xb_st[4];
  if (threadIdx.x < 4) xb_st[threadIdx.x] = 0u;
  __syncthreads();
  if (p.probe == 0x7fffffff) grid.sync();
  const XcdBarrier xb = xcd_barrier_post(p.bar, (volatile XLAS unsigned*)xb_st);
  for (int r = 0; r < REP0; ++r) { phase0(p, smem); xcd_barrier(xb); }
  for (int r = 0; r < REP1; ++r) { phase1(p, smem); xcd_barrier(xb); }
  for (int r = 0; r < REP2; ++r) { phase2(p, smem); xcd_barrier(xb); }
  phase3(p, smem); xcd_barrier(xb);
  phase4(p, smem); xcd_barrier(xb);
  phase5(p, smem); xcd_barrier(xb);
  for (int r = 0; r < REP6; ++r) { phase6(p, smem); xcd_barrier(xb); }
  phase7(p, smem);
}
#else
template <int PH> __global__ void __launch_bounds__(NTHR) phase_kernel(Params p) {
  extern __shared__ __attribute__((aligned(16))) char smem[];
  run_phase<PH>(p, smem);
}
#endif

#ifndef XLAST
#define XLAST
#endif
#ifndef LAST_PHASE
#define LAST_PHASE 7
#endif
__global__ void dbg_copy(const uint4* __restrict__ src, uint4* __restrict__ dst, long n16) {
  for (long i = blockIdx.x * 256L + threadIdx.x; i < n16; i += gridDim.x * 256L) dst[i] = src[i];
}
extern "C" void kernel_launch(void* const* d_in, const int* in_sizes, int n_in, void* d_out, int out_size, void* d_ws, size_t ws_size,
                              hipStream_t stream) {
  Params p;
  memset(&p, 0, sizeof(p));
  const float* const* in = (const float* const*)d_in;
  p.x_prompt = in[0]; p.x_sample = in[1]; p.cache_k = in[2]; p.cache_v = in[3]; p.state_ssd = in[4]; p.c = in[5]; p.c_ctx = in[6];
  p.w_mod = in[7]; p.b_mod = in[8]; p.norm_g = in[9]; p.w_in = in[10]; p.lq1 = in[11]; p.lk1 = in[12]; p.lq2 = in[13]; p.lk2 = in[14];
  p.subln_g = in[15]; p.conv_w = in[16]; p.conv_b = in[17]; p.dt_bias = in[18]; p.A_log = in[19]; p.D_skip = in[20];
  p.ssd_norm_g = in[21]; p.w_out = in[22]; p.final_g = in[23];
  p.out = (float*)d_out;
  p.probe = PROBE_MASK;
  char* w = (char*)d_ws; size_t off = 0;
  auto take = [&](size_t bytes) { char* r = w + off; off += (bytes + 255) & ~(size_t)255; return r; };
  p.winT = (u16*)take((size_t)NPADW * 1024 * 2);
  p.woutT = (u16*)take((size_t)1024 * 2048 * 2);
  p.qb = (u16*)take((size_t)T_ALL * 1024 * 2);
  p.kC = (u16*)take((size_t)T_CTX * 1024 * 2);
  p.kS = (u16*)take((size_t)4 * 4608 * 1024 * 2);
  p.vC = (u16*)take((size_t)T_CTX * 1024 * 2);
  p.vS = (u16*)take((size_t)4 * 4608 * 1024 * 2);
  p.zb = (u16*)take((size_t)T_ALL * 1024 * 2);
  p.xbc = (u16*)take((size_t)T_ALL * 1536 * 2);
  p.dtb = (float*)take((size_t)T_ALL * 32 * 4);
  p.modv = (float*)take((size_t)5 * 3072 * 4);
  p.rope = (float*)take((size_t)64 * 16 * 2 * 4);
  p.misc = (float*)take(256);
  p.cd = (float*)take((size_t)160 * 16 * 2 * 4);
  p.ssqp = (float*)take((size_t)T_ALL * 16 * 4);
  p.ssq2p = (float*)take((size_t)T_ALL * 16 * 4);
  p.bar = (unsigned*)take((size_t)(XCD_BAR_WORDS + 64 + 65536) * 4);
  if (off > ws_size) { fprintf(stderr, "kernel_launch: workspace too small: need %zu have %zu\n", off, ws_size); return; }
  p.hb = (u16*)d_out;
  p.st = (u16*)d_out;
  p.gb = (u16*)d_out + (size_t)T_ALL * 1024;

#if MK_COOP
  static int grid_blocks = 0;
  if (!grid_blocks) {
    int dev = 0, cus = 0, per_cu = 0;
    hipGetDevice(&dev);
    hipDeviceGetAttribute(&cus, hipDeviceAttributeMultiprocessorCount, dev);
    hipFuncSetAttribute((const void*)fwd_megakernel, hipFuncAttributeMaxDynamicSharedMemorySize, LDS_BYTES);
    hipOccupancyMaxActiveBlocksPerMultiprocessor(&per_cu, (const void*)fwd_megakernel, NTHR, LDS_BYTES);
    if (per_cu < 1) per_cu = 1;
    grid_blocks = cus * per_cu;
  }
  (void)hipMemsetAsync(p.bar, 0, (size_t)(XCD_BAR_WORDS + 64 + 65536) * 4, stream);
  void* args[] = {&p};
  hipError_t e = hipLaunchCooperativeKernel((const void*)fwd_megakernel, dim3(grid_blocks), dim3(NTHR), args, LDS_BYTES, stream);
  if (e != hipSuccess) fprintf(stderr, "cooperative launch failed: %s (grid %d)\n", hipGetErrorString(e), grid_blocks);
#else
  static int attr_done = 0;
  if (!attr_done) {
    hipFuncSetAttribute((const void*)phase_kernel<0>, hipFuncAttributeMaxDynamicSharedMemorySize, LDS_BYTES);
    hipFuncSetAttribute((const void*)phase_kernel<1>, hipFuncAttributeMaxDynamicSharedMemorySize, LDS_BYTES);
    hipFuncSetAttribute((const void*)phase_kernel<2>, hipFuncAttributeMaxDynamicSharedMemorySize, LDS_BYTES);
    hipFuncSetAttribute((const void*)phase_kernel<3>, hipFuncAttributeMaxDynamicSharedMemorySize, LDS_BYTES);
    hipFuncSetAttribute((const void*)phase_kernel<4>, hipFuncAttributeMaxDynamicSharedMemorySize, LDS_BYTES);
    hipFuncSetAttribute((const void*)phase_kernel<5>, hipFuncAttributeMaxDynamicSharedMemorySize, LDS_BYTES);
    hipFuncSetAttribute((const void*)phase_kernel<6>, hipFuncAttributeMaxDynamicSharedMemorySize, LDS_BYTES);
    hipFuncSetAttribute((const void*)phase_kernel<7>, hipFuncAttributeMaxDynamicSharedMemorySize, LDS_BYTES);
    attr_done = 1;
  }
  const int G = 256;
  if (LAST_PHASE >= 0) hipLaunchKernelGGL(phase_kernel<0>, dim3(G), dim3(NTHR), LDS_BYTES, stream, p);
  if (LAST_PHASE >= 1) hipLaunchKernelGGL(phase_kernel<1>, dim3(G), dim3(NTHR), LDS_BYTES, stream, p);
  if (LAST_PHASE >= 2) hipLaunchKernelGGL(phase_kernel<2>, dim3(G), dim3(NTHR), LDS_BYTES, stream, p);
  if (LAST_PHASE >= 3) hipLaunchKernelGGL(phase_kernel<3>, dim3(G), dim3(NTHR), LDS_BYTES, stream, p);
  if (LAST_PHASE >= 4) hipLaunchKernelGGL(phase_kernel<4>, dim3(G), dim3(NTHR), LDS_BYTES, stream, p);
  if (LAST_PHASE >= 5) hipLaunchKernelGGL(phase_kernel<5>, dim3(G), dim3(NTHR), LDS_BYTES, stream, p);
  if (LAST_PHASE >= 6) hipLaunchKernelGGL(phase_kernel<6>, dim3(G), dim3(NTHR), LDS_BYTES, stream, p);
  if (LAST_PHASE >= 7) hipLaunchKernelGGL(phase_kernel<7>, dim3(G), dim3(NTHR), LDS_BYTES, stream, p);
#if LAST_PHASE == 3
  hipLaunchKernelGGL(dbg_copy, dim3(1024), dim3(256), 0, stream, (const uint4*)p.qb, (uint4*)p.gb, (long)T_ALL * 1024 * 2 / 16);
#endif
#endif
}
```

```cpp
#include <hip/hip_runtime.h>
#include <hip/hip_cooperative_groups.h>
#include <cstdio>
#include <cstring>
#include <cstdint>
namespace cg = cooperative_groups;

#ifndef REP0
#define REP0 1
#endif
#ifndef REP1
#define REP1 1
#endif
#ifndef REP2
#define REP2 1
#endif
#ifndef REP6
#define REP6 1
#endif
__device__ __forceinline__ int opaque_tid() { int t = threadIdx.x; asm volatile("" : "+v"(t)); return t; }
#ifndef PROBE_MASK
#define PROBE_MASK 0
#endif
constexpr int SPLIT_FLAG0 = 3456;
#ifndef MK_COOP
#define MK_COOP 1
#endif

typedef unsigned short u16;
using bf16x8 = __attribute__((ext_vector_type(8))) short;
using s16x4  = __attribute__((ext_vector_type(4))) short;
using f32x4  = __attribute__((ext_vector_type(4))) float;
using f32x16 = __attribute__((ext_vector_type(16))) float;
using u32x4  = __attribute__((ext_vector_type(4))) unsigned;
using u32x2  = __attribute__((ext_vector_type(2))) unsigned;

constexpr int NTHR = 512;
constexpr int T_CTX = 4096, T_ALL = 20480;
constexpr int NPROJ = 6688, NPADW = 6912;
constexpr int LDS_BYTES = 135168;
constexpr float EPSF = 1e-6f;
constexpr float LAM_INIT = 0.2f;
#ifndef DBG_ST
#define DBG_ST 1
#endif

struct Params {
  const float *x_prompt, *x_sample, *cache_k, *cache_v, *state_ssd, *c, *c_ctx, *w_mod, *b_mod, *norm_g, *w_in,
      *lq1, *lk1, *lq2, *lk2, *subln_g, *conv_w, *conv_b, *dt_bias, *A_log, *D_skip, *ssd_norm_g, *w_out, *final_g;
  float* out;
  u16 *winT, *woutT, *qb, *kC, *kS, *vC, *vS, *zb, *xbc, *hb, *gb, *st;
  float *dtb, *modv, *rope, *misc, *cd, *ssqp, *ssq2p;
  unsigned* bar;
  int probe, pad_;
};

typedef __bf16 bf16v2 __attribute__((ext_vector_type(2)));
typedef float f32v2 __attribute__((ext_vector_type(2)));
__device__ __forceinline__ unsigned cvtpk(float lo, float hi) {
  f32v2 v = {lo, hi}; bf16v2 b = __builtin_convertvector(v, bf16v2); return __builtin_bit_cast(unsigned, b);
}
__device__ __forceinline__ u16 f2bf(float x) { __bf16 b = (__bf16)x; return __builtin_bit_cast(u16, b); }
__device__ __forceinline__ float bf2f(u16 x) { return __uint_as_float(((unsigned)x) << 16); }
__device__ __forceinline__ float bfs2f(short x) { return __uint_as_float(((unsigned)(u16)x) << 16); }
__device__ __forceinline__ float siluf(float v) { return v * __builtin_amdgcn_rcpf(1.f + __expf(-v)); }
__device__ __forceinline__ bf16x8 pack8(const float* v) {
  u32x4 w = {cvtpk(v[0], v[1]), cvtpk(v[2], v[3]), cvtpk(v[4], v[5]), cvtpk(v[6], v[7])};
  return *reinterpret_cast<bf16x8*>(&w);
}
__device__ __forceinline__ f32x4 mfma16(bf16x8 a, bf16x8 b, f32x4 c) {
  return __builtin_amdgcn_mfma_f32_16x16x32_bf16(a, b, c, 0, 0, 0);
}

__device__ void p0_mod_item(const Params& p, int i, char* smem) {
  const int tid = opaque_tid();
  float* sc = (float*)smem;
  float* red = sc + 5 * 1024;
  for (int idx = tid; idx < 5120; idx += NTHR) {
    int r = idx >> 10, k = idx & 1023;
    float v = (r == 0) ? p.c_ctx[k] : p.c[(r - 1) * 1024 + k];
    sc[idx] = v / (1.f + expf(-v));
  }
  __syncthreads();
  const int kg = tid >> 4, cq = tid & 15, c0 = i * 64;
  f32x4 a0 = {0, 0, 0, 0}, a1 = a0, a2 = a0, a3 = a0, a4 = a0;
  const float* w = p.w_mod + (long)(kg * 32) * 3072 + c0 + cq * 4;
#pragma unroll 8
  for (int k = 0; k < 32; ++k) {
    f32x4 wv = __builtin_nontemporal_load(reinterpret_cast<const f32x4*>(w + (long)k * 3072));
    int kk = kg * 32 + k;
    a0 += sc[kk] * wv; a1 += sc[1024 + kk] * wv; a2 += sc[2048 + kk] * wv; a3 += sc[3072 + kk] * wv; a4 += sc[4096 + kk] * wv;
  }
  *reinterpret_cast<f32x4*>(red + (kg * 5 + 0) * 64 + cq * 4) = a0; *reinterpret_cast<f32x4*>(red + (kg * 5 + 1) * 64 + cq * 4) = a1;
  *reinterpret_cast<f32x4*>(red + (kg * 5 + 2) * 64 + cq * 4) = a2; *reinterpret_cast<f32x4*>(red + (kg * 5 + 3) * 64 + cq * 4) = a3;
  *reinterpret_cast<f32x4*>(red + (kg * 5 + 4) * 64 + cq * 4) = a4;
  __syncthreads();
  if (tid < 320) {
    int r = tid >> 6, cc = tid & 63;
    float sum = p.b_mod[c0 + cc];
    for (int q = 0; q < 32; ++q) sum += red[(q * 5 + r) * 64 + cc];
    p.modv[r * 3072 + c0 + cc] = sum;
  }
  if (i == 0 && tid == 511) {
    float s1 = 0, s2 = 0;
    for (int k = 0; k < 64; ++k) { s1 += p.lq1[k] * p.lk1[k]; s2 += p.lq2[k] * p.lk2[k]; }
    p.misc[0] = expf(s1) - expf(s2) + LAM_INIT;
  }
}

__device__ void p0_transpose_item(const float* __restrict__ src, int ldsrc, int nvalid, u16* __restrict__ dst, int lddst,
                                  int n0, int k0, int kd0, const float* __restrict__ kscale, char* smem) {
  float* tile = (float*)smem;
  const int tid = opaque_tid();
  {
    int r = tid >> 3, cc = (tid & 7) * 8;
    float sc = 1.f;
    if (kscale != nullptr && (k0 + r) >= 1024) sc = kscale[k0 + r - 1024];
    float4 x0 = {0.f, 0.f, 0.f, 0.f}, x1 = {0.f, 0.f, 0.f, 0.f};
    if (n0 + cc < nvalid) {
      const float* sp = src + (long)(k0 + r) * ldsrc + n0 + cc;
      x0 = *reinterpret_cast<const float4*>(sp); x1 = *reinterpret_cast<const float4*>(sp + 4);
    }
    float* tp = tile + r * 65 + cc;
    tp[0] = x0.x * sc; tp[1] = x0.y * sc; tp[2] = x0.z * sc; tp[3] = x0.w * sc;
    tp[4] = x1.x * sc; tp[5] = x1.y * sc; tp[6] = x1.z * sc; tp[7] = x1.w * sc;
  }
  __syncthreads();
  {
    int n = tid >> 3, kk = (tid & 7) * 8;
    float v[8];
#pragma unroll
    for (int e = 0; e < 8; ++e) v[e] = tile[(kk + e) * 65 + n];
    *reinterpret_cast<bf16x8*>(dst + (long)(n0 + n) * lddst + kd0 + kk) = pack8(v);
  }
}

__device__ void p0_transpose4(const float* __restrict__ src, int ldsrc, int nvalid, u16* __restrict__ dst, int lddst,
                              int n0, int k0, int kd0, const float* __restrict__ kscale, char* smem) {
  float* tile = (float*)smem;
  const int tid = opaque_tid();
  const int r = tid >> 3, cc = (tid & 7) * 8;
  float4 x0[4], x1[4]; float sc[4];
#pragma unroll
  for (int j = 0; j < 4; ++j) {
    const int kr = k0 + j * 64 + r;
    sc[j] = (kscale != nullptr && kr >= 1024) ? kscale[kr - 1024] : 1.f;
    x0[j] = float4{0.f, 0.f, 0.f, 0.f}; x1[j] = x0[j];
    if (n0 + cc < nvalid) {
      const float* sp = src + (long)kr * ldsrc + n0 + cc;
      const f32x4 y0 = __builtin_nontemporal_load(reinterpret_cast<const f32x4*>(sp)), y1 = __builtin_nontemporal_load(reinterpret_cast<const f32x4*>(sp + 4));
      x0[j] = float4{y0[0], y0[1], y0[2], y0[3]}; x1[j] = float4{y1[0], y1[1], y1[2], y1[3]};
    }
  }
#pragma unroll
  for (int j = 0; j < 4; ++j) {
    float* tp = tile + j * 4160 + r * 65 + cc;
    tp[0] = x0[j].x * sc[j]; tp[1] = x0[j].y * sc[j]; tp[2] = x0[j].z * sc[j]; tp[3] = x0[j].w * sc[j];
    tp[4] = x1[j].x * sc[j]; tp[5] = x1[j].y * sc[j]; tp[6] = x1[j].z * sc[j]; tp[7] = x1[j].w * sc[j];
  }
  __syncthreads();
  const int n = tid >> 3, kk = (tid & 7) * 8;
#pragma unroll
  for (int j = 0; j < 4; ++j) {
    float v[8];
#pragma unroll
    for (int e = 0; e < 8; ++e) v[e] = tile[j * 4160 + (kk + e) * 65 + n];
    *reinterpret_cast<bf16x8*>(dst + (long)(n0 + n) * lddst + kd0 + j * 64 + kk) = pack8(v);
  }
}

__device__ void p0_rope_item(const Params& p) {
  const int tid = opaque_tid();
  for (int idx = tid; idx < 1024; idx += NTHR) {
    int pos = idx >> 4, i = idx & 15;
    double inv = 1.0;
    for (int q = 0; q < i; ++q) inv *= 0.56234132519034908;
    double ang = (double)pos * inv;
    double kq = rint(ang * 0.63661977236758134);
    double r = ang - kq * 1.5707963267948966 - kq * 6.123233995736766e-17;
    double r2 = r * r;
    double s = r * (1.0 + r2 * (-1.0 / 6 + r2 * (1.0 / 120 + r2 * (-1.0 / 5040 + r2 * (1.0 / 362880 + r2 * (-1.0 / 39916800 + r2 * (1.0 / 6227020800.0 + r2 * (-1.0 / 1307674368000.0))))))));
    double cs = 1.0 + r2 * (-0.5 + r2 * (1.0 / 24 + r2 * (-1.0 / 720 + r2 * (1.0 / 40320 + r2 * (-1.0 / 3628800 + r2 * (1.0 / 479001600 + r2 * (-1.0 / 87178291200.0 + r2 * (1.0 / 20922789888000.0))))))));
    long kk = (long)kq; int qd = (int)(kk & 3);
    double so, co;
    if (qd == 0) { so = s; co = cs; } else if (qd == 1) { so = cs; co = -s; } else if (qd == 2) { so = -s; co = -cs; } else { so = -cs; co = s; }
    p.rope[idx * 2 + 0] = (float)co;
    p.rope[idx * 2 + 1] = (float)so;
  }
}

__device__ void phase0_pre_item(const Params& p, int i, char* smem) {
  const int tid = opaque_tid();
  constexpr int N_WIN = 108 * 4, N_WOUT = 16 * 8, N_CACHE = 256, N_ROPE = 1;
    if (i < N_WIN) {
      int nt = i >> 2, kq = i & 3;
      p0_transpose4(p.w_in, NPROJ, NPROJ, p.winT, 1024, nt * 64, kq * 256, kq * 256, nullptr, smem);
      __syncthreads();
    } else if ((i -= N_WIN) < N_WOUT) {
      int nt = i >> 3, kq = i & 7;
      p0_transpose4(p.w_out, 1024, 1024, p.woutT + (kq >= 4 ? 1024 * 1024 : 0), 1024, nt * 64, kq * 256, (kq & 3) * 256, p.ssd_norm_g, smem);
      __syncthreads();
    } else if ((i -= N_WOUT) < N_CACHE) {
      float4 xa[4], xb[4];
#pragma unroll
      for (int j = 0; j < 4; ++j) {
        const int piece = i * 4 + j, tens = piece >> 9, blk = piece & 511;
        const float* src = (tens ? p.cache_v : p.cache_k) + (long)blk * 4096 + tid * 8;
        { const f32x4 y0 = __builtin_nontemporal_load(reinterpret_cast<const f32x4*>(src)), y1 = __builtin_nontemporal_load(reinterpret_cast<const f32x4*>(src + 4));
          xa[j] = float4{y0[0], y0[1], y0[2], y0[3]}; xb[j] = float4{y1[0], y1[1], y1[2], y1[3]}; }
      }
#pragma unroll
      for (int j = 0; j < 4; ++j) {
        const int piece = i * 4 + j, tens = piece >> 9, blk = piece & 511;
        const long e0 = (long)blk * 4096 + tid * 8;
        const int b = (int)(e0 >> 19); const long rem = e0 & ((1 << 19) - 1);
        u16* dst = (tens ? p.vS : p.kS) + ((long)b * 4608 + 4096) * 1024 + rem;
        float v[8] = {xa[j].x, xa[j].y, xa[j].z, xa[j].w, xb[j].x, xb[j].y, xb[j].z, xb[j].w};
        *reinterpret_cast<bf16x8*>(dst) = pack8(v);
      }
    } else if ((i -= N_CACHE) < N_ROPE) {
      p0_rope_item(p);
    }
}
__device__ void phase0(const Params& p, char* smem) {
  constexpr int N_PRE = 108 * 4 + 16 * 8 + 256 + 1;
  if (gridDim.x == 256) {
    if (blockIdx.x < 48) { p0_mod_item(p, blockIdx.x, smem); __syncthreads(); }
    else { for (int i = blockIdx.x - 48; i < N_PRE; i += 208) phase0_pre_item(p, i, smem); }
  } else {
    for (int it = blockIdx.x; it < 48 + N_PRE; it += gridDim.x) {
      if (it < 48) { p0_mod_item(p, it, smem); __syncthreads(); } else phase0_pre_item(p, it - 48, smem);
    }
  }
}

__device__ void phase1(const Params& p, char* smem) {
  const int tid = opaque_tid(), lane = tid & 63, wid = tid >> 6;
  (void)tid;
  for (int i = blockIdx.x; i < T_ALL / 32; i += gridDim.x) {
      float4 v[4][4]; float ss[4];
#pragma unroll
      for (int rr = 0; rr < 4; ++rr) {
        const int t = i * 32 + rr * 8 + wid;
        const float* xr = (t < T_CTX) ? p.x_prompt + (long)t * 1024 : p.x_sample + (long)(t - T_CTX) * 1024;
#pragma unroll
        for (int q = 0; q < 4; ++q) v[rr][q] = *reinterpret_cast<const float4*>(xr + q * 256 + lane * 4);
      }
#pragma unroll
      for (int rr = 0; rr < 4; ++rr) {
        float a = 0.f;
#pragma unroll
        for (int q = 0; q < 4; ++q) a += v[rr][q].x * v[rr][q].x + v[rr][q].y * v[rr][q].y + v[rr][q].z * v[rr][q].z + v[rr][q].w * v[rr][q].w;
#pragma unroll
        for (int o = 32; o >= 1; o >>= 1) a += __shfl_xor(a, o);
        ss[rr] = rsqrtf(a * (1.f / 1024.f) + EPSF);
      }
#pragma unroll
      for (int rr = 0; rr < 4; ++rr) {
        const int t = i * 32 + rr * 8 + wid;
        const int mr = (t < T_CTX) ? 0 : 1 + ((t - T_CTX) >> 12);
        const float rs = ss[rr];
#pragma unroll
        for (int q = 0; q < 4; ++q) {
          int col = q * 256 + lane * 4;
          float4 g = *reinterpret_cast<const float4*>(p.norm_g + col);
          float4 sh = *reinterpret_cast<const float4*>(p.modv + mr * 3072 + col);
          float4 sc = *reinterpret_cast<const float4*>(p.modv + mr * 3072 + 1024 + col);
          float h0 = v[rr][q].x * rs * g.x * (1.f + sc.x) + sh.x;
          float h1 = v[rr][q].y * rs * g.y * (1.f + sc.y) + sh.y;
          float h2 = v[rr][q].z * rs * g.z * (1.f + sc.z) + sh.z;
          float h3 = v[rr][q].w * rs * g.w * (1.f + sc.w) + sh.w;
          u32x2 w = {cvtpk(h0, h1), cvtpk(h2, h3)};
          *reinterpret_cast<u32x2*>(p.hb + (long)t * 1024 + col) = w;
        }
      }
  }
}

constexpr int G_LD = 72;
constexpr int G_ABYTES = 256 * G_LD * 2, G_BBYTES = 128 * G_LD * 2, G_STAGE = G_ABYTES + G_BBYTES;

__device__ __forceinline__ void gemm_kloop(f32x4 (&acc)[4][4], const u16* __restrict__ A, int lda,
                                           const u16* __restrict__ B, int ldb, int nk, char* smem) {
  const int tid = opaque_tid(), lane = tid & 63, wid = __builtin_amdgcn_readfirstlane(tid >> 6), wm = wid >> 1, wn = wid & 1, fr = lane & 15, fq = lane >> 4;
  bf16x8 ra[4], rb[2];
  const int lr = tid >> 3, lc = (tid & 7) * 8;
  __syncthreads();
#pragma unroll
  for (int i = 0; i < 4; ++i) ra[i] = *reinterpret_cast<const bf16x8*>(A + (long)(lr + i * 64) * lda + lc);
#pragma unroll
  for (int i = 0; i < 2; ++i) rb[i] = *reinterpret_cast<const bf16x8*>(B + (long)(lr + i * 64) * ldb + lc);
  {
    u16* As = (u16*)smem; u16* Bs = (u16*)(smem + G_ABYTES);
#pragma unroll
    for (int i = 0; i < 4; ++i) *reinterpret_cast<bf16x8*>(As + (lr + i * 64) * G_LD + lc) = ra[i];
#pragma unroll
    for (int i = 0; i < 2; ++i) *reinterpret_cast<bf16x8*>(Bs + (lr + i * 64) * G_LD + lc) = rb[i];
  }
  __syncthreads();
  for (int kt = 0; kt < nk; ++kt) {
    if (kt + 1 < nk) {
#pragma unroll
      for (int i = 0; i < 4; ++i) ra[i] = *reinterpret_cast<const bf16x8*>(A + (long)(lr + i * 64) * lda + (kt + 1) * 64 + lc);
#pragma unroll
      for (int i = 0; i < 2; ++i) rb[i] = *reinterpret_cast<const bf16x8*>(B + (long)(lr + i * 64) * ldb + (kt + 1) * 64 + lc);
    }
    const u16* As = (const u16*)(smem + (kt & 1) * G_STAGE);
    const u16* Bs = (const u16*)(smem + (kt & 1) * G_STAGE + G_ABYTES);
#pragma unroll
    for (int ks = 0; ks < 2; ++ks) {
      bf16x8 a[4], b[4];
#pragma unroll
      for (int mi = 0; mi < 4; ++mi) a[mi] = *reinterpret_cast<const bf16x8*>(As + (wm * 64 + mi * 16 + fr) * G_LD + ks * 32 + fq * 8);
#pragma unroll
      for (int ni = 0; ni < 4; ++ni) b[ni] = *reinterpret_cast<const bf16x8*>(Bs + (wn * 64 + ni * 16 + fr) * G_LD + ks * 32 + fq * 8);
#pragma unroll
      for (int mi = 0; mi < 4; ++mi)
#pragma unroll
        for (int ni = 0; ni < 4; ++ni) acc[mi][ni] = mfma16(a[mi], b[ni], acc[mi][ni]);
    }
    if (kt + 1 < nk) {
      u16* As2 = (u16*)(smem + ((kt + 1) & 1) * G_STAGE); u16* Bs2 = (u16*)(smem + ((kt + 1) & 1) * G_STAGE + G_ABYTES);
#pragma unroll
      for (int i = 0; i < 4; ++i) *reinterpret_cast<bf16x8*>(As2 + (lr + i * 64) * G_LD + lc) = ra[i];
#pragma unroll
      for (int i = 0; i < 2; ++i) *reinterpret_cast<bf16x8*>(Bs2 + (lr + i * 64) * G_LD + lc) = rb[i];
    }
    __syncthreads();
  }
}

namespace pg8 {
#define PG8_LAS __attribute__((address_space(3)))
typedef unsigned short bf16_t;
typedef short bf16x8 __attribute__((ext_vector_type(8)));
typedef float f32x4 __attribute__((ext_vector_type(4)));
typedef unsigned u32x4 __attribute__((ext_vector_type(4)));
constexpr int BM = 256, BK = 64, HALF = 128, HTB = HALF * BK * 2  , STAGE_BYTES = 8 * HTB, NXCD = 8, WGM = 4;

__host__ __device__ __forceinline__ int lds_byte(int r, int c) { const int st = (r >> 4) * 2 + (c >> 5), rr = r & 15, cc = c & 31, ob = rr * 64 + cc * 2; return st * 1024 + (ob ^ (((ob >> 9) & 1) << 5)); }
__host__ __device__ __forceinline__ void stage_rc(int b, int& R, int& C) { const int st = b / 1024, sb = b % 1024, swz = sb ^ (((sb >> 9) & 1) << 5); R = (st >> 1) * 16 + swz / 64; C = (st & 1) * 32 + (swz % 64) / 2; }
__host__ __device__ __forceinline__ int perm32(int rho) { const int n = rho >> 4, i = rho & 15; return 8 * (i >> 2) + 4 * n + (i & 3); }

struct Unit { int pm, pn, seg, split; };
struct Gemm { const bf16_t* A; const bf16_t* Bt; int M, N, K; const bf16_t* A2; const bf16_t* Bt2; };

struct StaticOrder {
    int nM, nN, nwg, G, c;
    __host__ __device__ void init(int M, int N, int G_, int c_) { nM = M / BM; nN = N / BM; nwg = nM * nN; G = G_; c = c_; }
    __host__ __device__ bool tile_at(long L, Unit& u) const {
        if (L >= nwg) return false;
        int wgid = (int)L; { const int q = nwg / NXCD, r = nwg % NXCD, xcd = wgid % NXCD, off = wgid / NXCD; wgid = (xcd < r ? xcd * (q + 1) : r * (q + 1) + (xcd - r) * q) + off; }
        const int nig = WGM * nN, gid = wgid / nig, fm = gid * WGM, gsz = (nM - fm) < WGM ? (nM - fm) : WGM;
        u.pm = fm + ((wgid % nig) % gsz); u.pn = (wgid % nig) / gsz; u.seg = 0; u.split = 0; return true;
    }
    __host__ __device__ bool next(int i, Unit& u) const { return tile_at((long)i * G + c, u); }
    __device__ __forceinline__ void a_ready(const Unit&) const {}
    __device__ __forceinline__ void done(const Unit&) const {}
};
template <class Epi, class Sched, bool STAMP = false>
__device__ __forceinline__ void gemm_phase(PG8_LAS unsigned char* lds, const Gemm g, const Sched& S, const Epi& E, unsigned long long* stamps) {
    const int tid = opaque_tid(), wid = __builtin_amdgcn_readfirstlane(tid >> 6), lane = tid & 63, wr = wid >> 2, wc = wid & 3, fr = lane & 15, fq = lane >> 4;
    const int K = g.K, nt = K / BK;
    int ts_lo = 0, ts_hi = 0, nts = 0; const unsigned long long rt_entry = STAMP ? (unsigned long long)wall_clock64() : 0ull;
#define PG8_STAMP() do { if (STAMP && wid == 0 && nts < 64) { const unsigned long long _c = (unsigned long long)clock64(); \
        ts_lo = (lane == nts) ? (int)(unsigned)_c : ts_lo; ts_hi = (lane == nts) ? (int)(unsigned)(_c >> 32) : ts_hi; ++nts; } } while (0)
    PG8_STAMP();
    unsigned voffA[2], voffB[2];
#pragma unroll
    for (int i = 0; i < 2; ++i) { int R, C; stage_rc(tid * 16 + i * 8192, R, C); const int Rb = Epi::PERM ? ((R & ~31) + perm32(R & 31)) : R;
        voffA[i] = (unsigned)(R * K + C) * 2u; voffB[i] = (unsigned)(Rb * K + C) * 2u; }
    const size_t kstep = (size_t)(BK * 2);
    const size_t hstep = (size_t)HALF * K * 2;
    const size_t tstep = 2 * hstep;
    const unsigned ldsw = (unsigned)wid * 1024u;
    const int aoff = lds_byte(wr * 64 + fr, fq * 8), boff = lds_byte(wc * 32 + fr, fq * 8);
#define PG8_SA(b, h) (((b) * 2 + (h)) * HTB)
#define PG8_SB(b, h) ((4 + (b) * 2 + (h)) * HTB)
#define PG8_STAGE(bufoff, gbase, voff) do { _Pragma("unroll") for (int _i = 0; _i < 2; ++_i) \
        __builtin_amdgcn_global_load_lds((const unsigned*)((const char*)(gbase) + (voff)[_i]), (PG8_LAS unsigned*)(lds + (bufoff) + ldsw + _i * 8192), 16, 0, 0); } while (0)
#define PG8_LDA(dst, b, h) do { _Pragma("unroll") for (int m = 0; m < 4; ++m) _Pragma("unroll") for (int k = 0; k < 2; ++k) dst[m][k] = *(const PG8_LAS bf16x8*)(lds + PG8_SA(b, h) + aoff + m * 2048 + k * 1024); } while (0)
#define PG8_LDB(dst, b, h) do { _Pragma("unroll") for (int n = 0; n < 2; ++n) _Pragma("unroll") for (int k = 0; k < 2; ++k) dst[n][k] = *(const PG8_LAS bf16x8*)(lds + PG8_SB(b, h) + boff + n * 2048 + k * 1024); } while (0)
#define PG8_MMA(ai, bj, At, Bt) do { __builtin_amdgcn_s_setprio(1); _Pragma("unroll") for (int m = 0; m < 4; ++m) _Pragma("unroll") for (int n = 0; n < 2; ++n) _Pragma("unroll") for (int k = 0; k < 2; ++k) \
        acc[ai][bj][m][n] = __builtin_amdgcn_mfma_f32_16x16x32_bf16(Bt[n][k], At[m][k], acc[ai][bj][m][n], 0, 0, 0); __builtin_amdgcn_s_setprio(0); } while (0)
#define PG8_WAIT_V(n) asm volatile("s_waitcnt vmcnt(" #n ")" ::: "memory")
#define PG8_WAIT_L(n) asm volatile("s_waitcnt lgkmcnt(" #n ")" ::: "memory")
#define PG8_BAR __builtin_amdgcn_s_barrier()
#define PG8_SCHED __builtin_amdgcn_sched_barrier(0)
    Unit cur, nxt; int ui = 0;
    if (!S.next(0, cur)) return;
    f32x4 acc[2][2][4][2];
#pragma unroll
    for (int a = 0; a < 2; ++a)
#pragma unroll
        for (int b = 0; b < 2; ++b)
#pragma unroll
            for (int m = 0; m < 4; ++m)
#pragma unroll
                for (int n = 0; n < 2; ++n) acc[a][b][m][n] = (f32x4){0.f, 0.f, 0.f, 0.f};
    bf16x8 At[4][2], B0[2][2], B1[2][2];
    const char* cA = (const char*)(cur.seg ? g.A2 : g.A) + (size_t)cur.pm * tstep; const char* cB = (const char*)(cur.seg ? g.Bt2 : g.Bt) + (size_t)cur.pn * tstep;
    S.a_ready(cur);
    PG8_STAGE(PG8_SB(0, 0), cB, voffB); PG8_STAGE(PG8_SA(0, 0), cA, voffA); PG8_STAGE(PG8_SB(0, 1), cB + hstep, voffB); PG8_STAGE(PG8_SA(0, 1), cA + hstep, voffA);
    if (wr == 1) PG8_BAR;
    PG8_WAIT_V(4); PG8_BAR;
    PG8_STAGE(PG8_SB(1, 0), cB + kstep, voffB); PG8_STAGE(PG8_SA(1, 0), cA + kstep, voffA); PG8_STAGE(PG8_SB(1, 1), cB + hstep + kstep, voffB);
    PG8_WAIT_V(6); PG8_BAR;
    PG8_STAMP();
    for (;;) {
        const bool has_next = S.next(ui + 1, nxt);
        const char* nA = has_next ? (const char*)(nxt.seg ? g.A2 : g.A) + (size_t)nxt.pm * tstep : cA; const char* nB = has_next ? (const char*)(nxt.seg ? g.Bt2 : g.Bt) + (size_t)nxt.pn * tstep : cB;
        for (int t = 0; t < nt; t += 2) {
            const bool last = (t == nt - 2);
            const char* a1 = cA + (size_t)(t + 1) * kstep;
            const char* a2 = last ? nA : cA + (size_t)(t + 2) * kstep; const char* b2 = last ? nB : cB + (size_t)(t + 2) * kstep;
            const char* a3 = a2 + kstep; const char* b3 = b2 + kstep;
            if (last && has_next) S.a_ready(nxt);
            PG8_LDB(B0, 0, 0); PG8_SCHED; PG8_LDA(At, 0, 0); PG8_STAGE(PG8_SA(1, 1), a1 + hstep, voffA);
            PG8_WAIT_L(8); PG8_BAR; PG8_WAIT_L(0); PG8_MMA(0, 0, At, B0); PG8_BAR; PG8_SCHED;
            PG8_LDB(B1, 0, 1); PG8_STAGE(PG8_SB(0, 0), b2, voffB);
            PG8_BAR; PG8_WAIT_L(0); PG8_MMA(0, 1, At, B1); PG8_BAR;
            PG8_LDA(At, 0, 1); PG8_STAGE(PG8_SA(0, 0), a2, voffA);
            PG8_BAR; PG8_WAIT_L(0); PG8_MMA(1, 0, At, B0); PG8_BAR; PG8_SCHED;
            PG8_STAGE(PG8_SB(0, 1), b2 + hstep, voffB);
            PG8_WAIT_V(6); PG8_BAR; PG8_MMA(1, 1, At, B1); PG8_BAR;
            PG8_LDB(B0, 1, 0); PG8_SCHED; PG8_LDA(At, 1, 0); PG8_STAGE(PG8_SA(0, 1), a2 + hstep, voffA);
            PG8_WAIT_L(8); PG8_BAR; PG8_WAIT_L(0); PG8_MMA(0, 0, At, B0); PG8_BAR; PG8_SCHED;
            PG8_LDB(B1, 1, 1); PG8_STAGE(PG8_SB(1, 0), b3, voffB);
            PG8_BAR; PG8_WAIT_L(0); PG8_MMA(0, 1, At, B1); PG8_BAR;
            PG8_LDA(At, 1, 1); PG8_STAGE(PG8_SA(1, 0), a3, voffA);
            PG8_BAR; PG8_WAIT_L(0); PG8_MMA(1, 0, At, B0); PG8_BAR; PG8_SCHED;
            PG8_STAGE(PG8_SB(1, 1), b3 + hstep, voffB);
            PG8_WAIT_V(6); PG8_BAR; PG8_MMA(1, 1, At, B1); PG8_BAR;
        }
        PG8_STAMP();
        if constexpr (!Epi::AFTER_DRAIN) { E(acc, cur, wr, wc, fr, fq); S.done(cur); }
        PG8_STAMP();
        if (!has_next) break;
        if (!(Epi::KEEP && cur.seg == 0))
#pragma unroll
        for (int a = 0; a < 2; ++a)
#pragma unroll
            for (int b = 0; b < 2; ++b)
#pragma unroll
                for (int m = 0; m < 4; ++m)
#pragma unroll
                    for (int n = 0; n < 2; ++n) acc[a][b][m][n] = (f32x4){0.f, 0.f, 0.f, 0.f};
        cur = nxt; cA = nA; cB = nB; ++ui;
    }
    PG8_WAIT_V(0);
    if (wr == 0) PG8_BAR;
    PG8_BAR;
    if constexpr (Epi::AFTER_DRAIN) { E.fused(acc, cur, wr, wc, fr, fq, lds, wid, lane); S.done(cur); }
    PG8_STAMP();
    if (STAMP && wid == 0) { stamps[lane] = lane < nts ? (((unsigned long long)(unsigned)ts_hi << 32) | (unsigned)ts_lo) : 0ull;
        if (lane == 62) stamps[62] = rt_entry; if (lane == 63) stamps[63] = (unsigned long long)wall_clock64(); }
#undef PG8_STAMP
#undef PG8_SA
#undef PG8_SB
#undef PG8_STAGE
#undef PG8_LDA
#undef PG8_LDB
#undef PG8_MMA
#undef PG8_WAIT_V
#undef PG8_WAIT_L
#undef PG8_BAR
#undef PG8_SCHED
}
}
template <int SEG> __device__ __forceinline__ void epi_proj_seg(const Params& p, const f32x4 (&acc)[2][2][4][2], int m0, int n0, int wr, int wc, int fr, int fq) {
  const bool is_ctx = (m0 < T_CTX);
  const bool do_rope = (SEG <= 1) && !is_ctx;
#pragma unroll
  for (int ai = 0; ai < 2; ++ai)
#pragma unroll
    for (int m = 0; m < 4; ++m) {
      const int t = m0 + ai * 128 + wr * 64 + m * 16 + fr;
      const int ts = t - T_CTX, bsm = ts >> 12, tl = ts & 4095;
      f32x4 rc[4];
      if (do_rope) {
        const int pos = (wc & 1) ? (tl & 63) : (tl >> 6);
        const f32x4* rp = reinterpret_cast<const f32x4*>(p.rope + (pos * 16 + 8 * (fq & 1)) * 2);
        rc[0] = rp[0]; rc[1] = rp[1]; rc[2] = rp[2]; rc[3] = rp[3];
      }
#pragma unroll
      for (int bj = 0; bj < 2; ++bj) {
        f32x4 v0 = acc[ai][bj][m][0], v1 = acc[ai][bj][m][1];
        const int n = n0 + bj * 128 + wc * 32 + 8 * fq;
        if (do_rope) {
          const float sgn = (fq < 2) ? -1.f : 1.f;
#pragma unroll
          for (int e = 0; e < 4; ++e) {
            float o0 = __shfl_xor(v0[e], 32), o1 = __shfl_xor(v1[e], 32);
            float c0 = rc[e >> 1][(e & 1) * 2], s0 = rc[e >> 1][(e & 1) * 2 + 1];
            float c1 = rc[2 + (e >> 1)][(e & 1) * 2], s1 = rc[2 + (e >> 1)][(e & 1) * 2 + 1];
            v0[e] = v0[e] * c0 + sgn * o0 * s0;
            v1[e] = v1[e] * c1 + sgn * o1 * s1;
          }
        }
        if (SEG == 3 || SEG == 4) {
#pragma unroll
          for (int e = 0; e < 4; ++e) { v0[e] = siluf(v0[e]); v1[e] = siluf(v1[e]); }
        }
        if (SEG == 6) {
          if (bj == 0 && wc == 0) {
            float* fo = p.dtb + (long)t * 32 + 8 * fq;
            *reinterpret_cast<f32x4*>(fo) = v0; *reinterpret_cast<f32x4*>(fo + 4) = v1;
          }
        } else {
          u32x4 w = {cvtpk(v0[0], v0[1]), cvtpk(v0[2], v0[3]), cvtpk(v1[0], v1[1]), cvtpk(v1[2], v1[3])};
          u16* dst;
          if (SEG == 0) dst = p.qb + (long)t * 1024 + n;
          else if (SEG == 1 || SEG == 2) {
            const int c = n - SEG * 1024;
            if (is_ctx) {
              dst = (SEG == 1 ? p.kC : p.vC) + (long)t * 1024 + c;
              float* fo = p.out + (SEG == 1 ? 20971520L : 25165824L) + (long)t * 1024 + c;
              *reinterpret_cast<f32x4*>(fo) = v0; *reinterpret_cast<f32x4*>(fo + 4) = v1;
            } else dst = (SEG == 1 ? p.kS : p.vS) + ((long)bsm * 4608 + tl) * 1024 + c;
          } else if (SEG == 3) dst = p.gb + (long)t * 1024 + (n - 3072);
          else if (SEG == 4) dst = p.zb + (long)t * 1024 + (n - 4096);
          else dst = p.xbc + (long)t * 1536 + (n - 5120);
          *reinterpret_cast<u32x4*>(dst) = w;
        }
      }
    }
}
struct EpiProj {
  static constexpr bool PERM = true, AFTER_DRAIN = false, KEEP = false;
  const Params& p;
  __device__ __forceinline__ void operator()(const f32x4 (&acc)[2][2][4][2], const pg8::Unit& u, int wr, int wc, int fr, int fq) const {
    const int m0 = u.pm * 256, n0 = u.pn * 256;
    const int seg = (n0 < 5120) ? (n0 >> 10) : (n0 < 6656 ? 5 : 6);
    switch (seg) {
      case 0: epi_proj_seg<0>(p, acc, m0, n0, wr, wc, fr, fq); break;
      case 1: epi_proj_seg<1>(p, acc, m0, n0, wr, wc, fr, fq); break;
      case 2: epi_proj_seg<2>(p, acc, m0, n0, wr, wc, fr, fq); break;
      case 3: epi_proj_seg<3>(p, acc, m0, n0, wr, wc, fr, fq); break;
      case 4: epi_proj_seg<4>(p, acc, m0, n0, wr, wc, fr, fq); break;
      case 5: epi_proj_seg<5>(p, acc, m0, n0, wr, wc, fr, fq); break;
      default: epi_proj_seg<6>(p, acc, m0, n0, wr, wc, fr, fq); break;
    }
  }
};

__device__ void phase2(const Params& p, char* smem) {
  pg8::StaticOrder S; S.init(T_ALL, NPADW, (int)gridDim.x, (int)blockIdx.x);
  pg8::Gemm g{p.hb, p.winT, T_ALL, NPADW, 1024, p.hb, p.winT};
  EpiProj E{p};
  pg8::gemm_phase<EpiProj, pg8::StaticOrder, false>((PG8_LAS unsigned char*)smem, g, S, E, nullptr);
  __syncthreads();
}

constexpr int SHM_V = 64 * 128 * 2, SHM_K = 64 * 128 * 2;
constexpr float ASCALE = 0.125f;
constexpr float ATHR = 8.f;
#define KSWZ(row, colB) ((row) * 256 + ((colB) ^ (((row) & 7) << 4)))
#define SBAR() __builtin_amdgcn_sched_barrier(0)
__device__ __forceinline__ int crow(int r, int hi) { return (r & 3) + 8 * (r >> 2) + 4 * hi; }

__device__ __forceinline__ void partialSM(f32x16& p0, f32x16& p1, float& m_reg, float& mn, float& alpha) {
  constexpr float C = ASCALE * 1.4426950408889634f;
  float pmax = p0[0];
#pragma unroll
  for (int r = 1; r < 16; ++r) pmax = fmaxf(pmax, p0[r]);
#pragma unroll
  for (int r = 0; r < 16; ++r) pmax = fmaxf(pmax, p1[r]);
  { auto rr = __builtin_amdgcn_permlane32_swap(__float_as_uint(pmax), __float_as_uint(pmax), false, false);
    pmax = fmaxf(__uint_as_float(rr[0]), __uint_as_float(rr[1])); }
  if (__builtin_expect(__all(pmax - m_reg <= ATHR / ASCALE), 1)) { mn = m_reg; alpha = 1.f; }
  else { mn = fmaxf(m_reg, pmax); alpha = __builtin_amdgcn_exp2f((m_reg - mn) * C); m_reg = mn; }
  float mnC = -mn * C;
#pragma unroll
  for (int r = 0; r < 16; ++r) p0[r] = fmaf(p0[r], C, mnC);
#pragma unroll
  for (int r = 0; r < 16; ++r) p1[r] = fmaf(p1[r], C, mnC);
#pragma unroll
  for (int r = 0; r < 16; ++r) p0[r] = __builtin_amdgcn_exp2f(p0[r]);
}
__device__ __forceinline__ void finishSM(f32x16& p0, f32x16& p1, float alpha, float& l_reg, bf16x8& pa0, bf16x8& pa1, bf16x8& pa2, bf16x8& pa3) {
#pragma unroll
  for (int r = 0; r < 16; ++r) p1[r] = __builtin_amdgcn_exp2f(p1[r]);
  float ps = 0;
#pragma unroll
  for (int r = 0; r < 16; ++r) ps += p0[r];
#pragma unroll
  for (int r = 0; r < 16; ++r) ps += p1[r];
  { auto rr = __builtin_amdgcn_permlane32_swap(__float_as_uint(ps), __float_as_uint(ps), false, false);
    ps = __uint_as_float(rr[0]) + __uint_as_float(rr[1]); }
  l_reg = l_reg * alpha + ps;
#define PK4(P, BASE, OUT) do { unsigned a0 = cvtpk(P[BASE + 0], P[BASE + 1]), a1 = cvtpk(P[BASE + 2], P[BASE + 3]);   \
    unsigned b0 = cvtpk(P[BASE + 4], P[BASE + 5]), b1 = cvtpk(P[BASE + 6], P[BASE + 7]);                              \
    auto r0 = __builtin_amdgcn_permlane32_swap(a0, b0, false, false); auto r1 = __builtin_amdgcn_permlane32_swap(a1, b1, false, false); \
    u32x4 w = {r0[0], r1[0], r0[1], r1[1]}; OUT = *reinterpret_cast<bf16x8*>(&w); } while (0)
  PK4(p0, 0, pa0); PK4(p0, 8, pa1); PK4(p1, 0, pa2); PK4(p1, 8, pa3);
#undef PK4
}
__device__ __forceinline__ void qkt(f32x16& p0, f32x16& p1, const u16* Ks, const bf16x8* qr, int r32, int hi, int comp) {
  p0 = f32x16{}; p1 = f32x16{};
#pragma unroll
  for (int d0 = 0; d0 < 4; ++d0) { int cb = (comp * 64 + d0 * 16 + hi * 8) * 2;
    bf16x8 b0 = *reinterpret_cast<const bf16x8*>((const char*)Ks + KSWZ(r32, cb));
    bf16x8 b1 = *reinterpret_cast<const bf16x8*>((const char*)Ks + KSWZ(32 + r32, cb));
    bf16x8 q = qr[d0];
    p0 = __builtin_amdgcn_mfma_f32_32x32x16_bf16(b0, q, p0, 0, 0, 0);
    p1 = __builtin_amdgcn_mfma_f32_32x32x16_bf16(b1, q, p1, 0, 0, 0); }
}
__device__ __forceinline__ int v_st(int k, int c) { const int kk = (k & ~0xC) | ((k & 4) << 1) | ((k & 8) >> 1); return ((kk >> 3) * 4 + (c >> 5)) * 512 + ((kk & 7) * 32 + (c & 31)) * 2; }
__device__ __forceinline__ int v_rd_base(int lane) { return ((lane & 3) << 3) | (((lane >> 2) & 3) << 6) | (((lane >> 4) & 1) << 5) | (((lane >> 5) & 1) << 8); }
constexpr int v_rd_off(int d0, int ks, int half) { return d0 * 512 + ks * 4096 + half * 2048; }
template <int OFF> __device__ __forceinline__ s16x4 tr_read(int vb) {
  s16x4 r; asm volatile("ds_read_b64_tr_b16 %0, %1 offset:%2" : "=&v"(r) : "v"(vb), "i"(OFF) : "memory"); return r;
}
template <int D0> __device__ __forceinline__ void pv_one(f32x16& od, int vb, bf16x8 pa0, bf16x8 pa1, bf16x8 pa2, bf16x8 pa3) {
  const s16x4 l0 = tr_read<v_rd_off(D0, 0, 0)>(vb), h0 = tr_read<v_rd_off(D0, 0, 1)>(vb), l1 = tr_read<v_rd_off(D0, 1, 0)>(vb), h1 = tr_read<v_rd_off(D0, 1, 1)>(vb);
  const s16x4 l2 = tr_read<v_rd_off(D0, 2, 0)>(vb), h2 = tr_read<v_rd_off(D0, 2, 1)>(vb), l3 = tr_read<v_rd_off(D0, 3, 0)>(vb), h3 = tr_read<v_rd_off(D0, 3, 1)>(vb);
  asm volatile("s_waitcnt lgkmcnt(0)" ::: "memory"); SBAR();
#define PK(L, H) (bf16x8){L[0], L[1], L[2], L[3], H[0], H[1], H[2], H[3]}
  od = __builtin_amdgcn_mfma_f32_32x32x16_bf16(pa0, PK(l0, h0), od, 0, 0, 0);
  od = __builtin_amdgcn_mfma_f32_32x32x16_bf16(pa1, PK(l1, h1), od, 0, 0, 0);
  od = __builtin_amdgcn_mfma_f32_32x32x16_bf16(pa2, PK(l2, h2), od, 0, 0, 0);
  od = __builtin_amdgcn_mfma_f32_32x32x16_bf16(pa3, PK(l3, h3), od, 0, 0, 0);
#undef PK
}
__device__ __forceinline__ void pv_d0(f32x16* o, int vb, bf16x8 pa0, bf16x8 pa1, bf16x8 pa2, bf16x8 pa3) {
  pv_one<0>(o[0], vb, pa0, pa1, pa2, pa3); pv_one<1>(o[1], vb, pa0, pa1, pa2, pa3); pv_one<2>(o[2], vb, pa0, pa1, pa2, pa3); pv_one<3>(o[3], vb, pa0, pa1, pa2, pa3);
}

__device__ __forceinline__ void attn_item(const Params& p, long tq0, int h, const u16* __restrict__ Kh, const u16* __restrict__ Vh, int seq, char* lds) {
  constexpr int LDK = 1024;
  const int tid = opaque_tid(), wid = __builtin_amdgcn_readfirstlane(tid >> 6), lane = tid & 63, r32 = lane & 31, hi = lane >> 5;
  const int comp = wid >> 2, qg = wid & 3;
  u16* V_lds = (u16*)lds; u16* K_lds = (u16*)(lds + 2 * SHM_V);
  float* wsl = (float*)(lds + 2 * SHM_V + 2 * SHM_K) + wid * 64; float* li_l = wsl; float* al_l = wsl + 32;
  float m_reg = -1e30f, l_reg = 0; f32x16 o[4] = {};
  char* Q_lds = lds + 2 * SHM_V + 2 * SHM_K + 2048;
  {
#pragma unroll
    for (int i = 0; i < 4; ++i) {
      int id = tid + i * NTHR; int row = id >> 4, ch = id & 15;
      bf16x8 v = *reinterpret_cast<const bf16x8*>(p.qb + (tq0 + row) * 1024 + h * 128 + ch * 8);
      *reinterpret_cast<bf16x8*>(Q_lds + KSWZ(row, ch * 16)) = v;
    }
  }
  __syncthreads();
  bf16x8 qr[4];
#pragma unroll
  for (int d0 = 0; d0 < 4; ++d0) qr[d0] = *reinterpret_cast<const bf16x8*>(Q_lds + (qg * 32) * 256 + KSWZ(r32, (comp * 64 + d0 * 16 + hi * 8) * 2));
  const int sr = tid >> 4, sc = (tid & 15) * 8, vst0 = v_st(sr, sc), vst1 = v_st(32 + sr, sc);
  const int vb0 = (int)(uintptr_t)V_lds + v_rd_base(lane);
  constexpr int SDEPTH = 1;
  struct { bf16x8 vs0, vs1, ks0, ks1; } sr_[SDEPTH];
#define SLOAD(i, k0) do { sr_[i].vs0 = *reinterpret_cast<const bf16x8*>(&Vh[(long)((k0) + sr) * LDK + sc]); sr_[i].vs1 = *reinterpret_cast<const bf16x8*>(&Vh[(long)((k0) + 32 + sr) * LDK + sc]); \
    sr_[i].ks0 = *reinterpret_cast<const bf16x8*>(&Kh[(long)((k0) + sr) * LDK + sc]); sr_[i].ks1 = *reinterpret_cast<const bf16x8*>(&Kh[(long)((k0) + 32 + sr) * LDK + sc]); } while (0)
#define SWRITE(b, i) do { *(bf16x8*)((char*)V_lds + (b) * SHM_V + vst0) = sr_[i].vs0;          \
    *(bf16x8*)((char*)V_lds + (b) * SHM_V + vst1) = sr_[i].vs1; int kc = sc * 2;               \
    *(bf16x8*)((char*)K_lds + (b) * SHM_K + KSWZ(sr, kc)) = sr_[i].ks0;                       \
    *(bf16x8*)((char*)K_lds + (b) * SHM_K + KSWZ(32 + sr, kc)) = sr_[i].ks1; } while (0)
#define SWAIT() do { if constexpr (SDEPTH == 2) asm volatile("s_waitcnt vmcnt(4)" ::: "memory"); else asm volatile("s_waitcnt vmcnt(0)" ::: "memory"); } while (0)
#define RESC(a) do { if (__any((a) < 1.f)) { if (hi == 0) al_l[r32] = (a); asm volatile("s_waitcnt lgkmcnt(0)" ::: "memory"); \
    _Pragma("unroll") for (int d = 0; d < 4; ++d) _Pragma("unroll") for (int r = 0; r < 16; ++r) o[d][r] *= al_l[crow(r, hi)]; } } while (0)
  f32x16 pA0, pA1, pB0, pB1; float mnA, mnB, alA, alB; bf16x8 pa0, pa1, pa2, pa3; const int NT = seq / 64;
  constexpr int SE = 0, SO = SDEPTH - 1;
  SLOAD(SE, 0); asm volatile("s_waitcnt vmcnt(0)" ::: "memory"); SWRITE(0, SE); __syncthreads();
  qkt(pA0, pA1, K_lds, qr, r32, hi, comp); partialSM(pA0, pA1, m_reg, mnA, alA);
  SLOAD(SO, 64); if constexpr (SDEPTH == 2) { if (2 < NT) SLOAD(SE, 2 * 64); }
  SWAIT(); SWRITE(1, SO); __syncthreads();
  for (int j = 1; j + 1 < NT; j += 2) {
    SBAR(); qkt(pB0, pB1, (u16*)((char*)K_lds + SHM_K), qr, r32, hi, comp);
    finishSM(pA0, pA1, alA, l_reg, pa0, pa1, pa2, pa3); SBAR();
    SLOAD(SO, (j + SDEPTH) * 64); SBAR();
    pv_d0(o, vb0, pa0, pa1, pa2, pa3); partialSM(pB0, pB1, m_reg, mnB, alB);
    __syncthreads(); SWAIT(); SWRITE(0, SE);
    RESC(alB); __syncthreads();
    SBAR(); qkt(pA0, pA1, K_lds, qr, r32, hi, comp);
    finishSM(pB0, pB1, alB, l_reg, pa0, pa1, pa2, pa3); SBAR();
    if (SDEPTH == 1 || j + 3 < NT) SLOAD(SE, (j + 1 + SDEPTH) * 64); SBAR();
    pv_d0(o, vb0 + (int)SHM_V, pa0, pa1, pa2, pa3); partialSM(pA0, pA1, m_reg, mnA, alA);
    __syncthreads(); SWAIT(); SWRITE(1, SO);
    RESC(alA); __syncthreads();
  }
  SBAR(); qkt(pB0, pB1, (u16*)((char*)K_lds + SHM_K), qr, r32, hi, comp);
  finishSM(pA0, pA1, alA, l_reg, pa0, pa1, pa2, pa3); SBAR();
  pv_d0(o, vb0, pa0, pa1, pa2, pa3); partialSM(pB0, pB1, m_reg, mnB, alB);
  __syncthreads(); RESC(alB);
  finishSM(pB0, pB1, alB, l_reg, pa0, pa1, pa2, pa3); SBAR();
  pv_d0(o, vb0 + (int)SHM_V, pa0, pa1, pa2, pa3);
  if (hi == 0) li_l[r32] = l_reg; asm volatile("s_waitcnt lgkmcnt(0)" ::: "memory");
  float rli[16];
#pragma unroll
  for (int r = 0; r < 16; ++r) rli[r] = 1.f / li_l[crow(r, hi)];
#undef SLOAD
#undef SWRITE
#undef SWAIT
#undef RESC
  __syncthreads();
  float* ex = (float*)lds;
  const float lam = p.misc[0];
  if (comp == 1) {
#pragma unroll
    for (int d0 = 0; d0 < 4; ++d0)
#pragma unroll
      for (int r = 0; r < 16; ++r) ex[((qg * 4 + d0) * 16 + r) * 64 + lane] = o[d0][r] * rli[r] * lam;
  }
  __syncthreads();
  if (comp == 0) {
    float ssq[16];
#pragma unroll
    for (int r = 0; r < 16; ++r) ssq[r] = 0.f;
#pragma unroll
    for (int d0 = 0; d0 < 4; ++d0)
#pragma unroll
      for (int r = 0; r < 16; ++r) {
        float v = o[d0][r] * rli[r] - ex[((qg * 4 + d0) * 16 + r) * 64 + lane];
        o[d0][r] = v; ssq[r] += v * v;
      }
#pragma unroll
    for (int r = 0; r < 16; ++r) {
      float s = ssq[r];
      s += __shfl_xor(s, 1); s += __shfl_xor(s, 2); s += __shfl_xor(s, 4); s += __shfl_xor(s, 8); s += __shfl_xor(s, 16);
      ssq[r] = rsqrtf(s * (1.f / 128.f) + EPSF) * (1.f - LAM_INIT);
    }
    float sg[4];
#pragma unroll
    for (int d0 = 0; d0 < 4; ++d0) sg[d0] = p.subln_g[d0 * 32 + r32];
    const long base = (tq0 + qg * 32 + 4 * hi) * 1024 + h * 128 + r32;
    const u16* gp = p.gb + base; u16* qp = p.qb + base;
#pragma unroll
    for (int r = 0; r < 16; ++r) {
      const int ro = ((r & 3) + 8 * (r >> 2)) * 1024;
      float g0 = bf2f(gp[ro]), g1 = bf2f(gp[ro + 32]), g2 = bf2f(gp[ro + 64]), g3 = bf2f(gp[ro + 96]);
      qp[ro] = f2bf(o[0][r] * ssq[r] * sg[0] * g0);
      qp[ro + 32] = f2bf(o[1][r] * ssq[r] * sg[1] * g1);
      qp[ro + 64] = f2bf(o[2][r] * ssq[r] * sg[2] * g2);
      qp[ro + 96] = f2bf(o[3][r] * ssq[r] * sg[3] * g3);
      SBAR();
    }
  }
  __syncthreads();
}


template <int D0> __device__ __forceinline__ void pv_two(f32x16& oa, f32x16& ob, int vb, bf16x8 a0, bf16x8 a1, bf16x8 a2, bf16x8 a3, bf16x8 b0, bf16x8 b1, bf16x8 b2, bf16x8 b3) {
  const s16x4 l0 = tr_read<v_rd_off(D0, 0, 0)>(vb), h0 = tr_read<v_rd_off(D0, 0, 1)>(vb), l1 = tr_read<v_rd_off(D0, 1, 0)>(vb), h1 = tr_read<v_rd_off(D0, 1, 1)>(vb);
  const s16x4 l2 = tr_read<v_rd_off(D0, 2, 0)>(vb), h2 = tr_read<v_rd_off(D0, 2, 1)>(vb), l3 = tr_read<v_rd_off(D0, 3, 0)>(vb), h3 = tr_read<v_rd_off(D0, 3, 1)>(vb);
#define PK(L, H) (bf16x8){L[0], L[1], L[2], L[3], H[0], H[1], H[2], H[3]}
  asm volatile("s_waitcnt lgkmcnt(6)" ::: "memory"); SBAR();
  { const bf16x8 v0 = PK(l0, h0);
    oa = __builtin_amdgcn_mfma_f32_32x32x16_bf16(a0, v0, oa, 0, 0, 0);
    ob = __builtin_amdgcn_mfma_f32_32x32x16_bf16(b0, v0, ob, 0, 0, 0); }
  SBAR(); asm volatile("s_waitcnt lgkmcnt(4)" ::: "memory"); SBAR();
  { const bf16x8 v1 = PK(l1, h1);
    oa = __builtin_amdgcn_mfma_f32_32x32x16_bf16(a1, v1, oa, 0, 0, 0);
    ob = __builtin_amdgcn_mfma_f32_32x32x16_bf16(b1, v1, ob, 0, 0, 0); }
  SBAR(); asm volatile("s_waitcnt lgkmcnt(2)" ::: "memory"); SBAR();
  { const bf16x8 v2 = PK(l2, h2);
    oa = __builtin_amdgcn_mfma_f32_32x32x16_bf16(a2, v2, oa, 0, 0, 0);
    ob = __builtin_amdgcn_mfma_f32_32x32x16_bf16(b2, v2, ob, 0, 0, 0); }
  SBAR(); asm volatile("s_waitcnt lgkmcnt(0)" ::: "memory"); SBAR();
  { const bf16x8 v3 = PK(l3, h3);
    oa = __builtin_amdgcn_mfma_f32_32x32x16_bf16(a3, v3, oa, 0, 0, 0);
    ob = __builtin_amdgcn_mfma_f32_32x32x16_bf16(b3, v3, ob, 0, 0, 0); }
#undef PK
}

__device__ __forceinline__ void attn_epi(const Params& p, f32x16 (&o)[4], const float (&rli)[16], int comp, int qg, int lane, int r32, int hi,
                                         long row0, int h, float* ex, float lam, bool dry) {
  const long gbase_i = (row0 + 4 * hi) * 1024 + h * 128 + r32;
  u16 gv0[8][4];
  if (comp == 0) {
    const u16* gp0 = p.gb + gbase_i;
#pragma unroll
    for (int r = 0; r < 8; ++r) {
      const int ro = ((r & 3) + 8 * (r >> 2)) * 1024;
      gv0[r][0] = gp0[ro]; gv0[r][1] = gp0[ro + 32]; gv0[r][2] = gp0[ro + 64]; gv0[r][3] = gp0[ro + 96];
    }
  }
  __syncthreads();
  if (comp == 1) {
#pragma unroll
    for (int d0 = 0; d0 < 4; ++d0)
#pragma unroll
      for (int r = 0; r < 16; ++r) ex[((qg * 4 + d0) * 16 + r) * 64 + lane] = o[d0][r] * rli[r] * lam;
  }
  __syncthreads();
  if (comp == 0) {
    float ssq[16];
#pragma unroll
    for (int r = 0; r < 16; ++r) ssq[r] = 0.f;
#pragma unroll
    for (int d0 = 0; d0 < 4; ++d0)
#pragma unroll
      for (int r = 0; r < 16; ++r) {
        float v = o[d0][r] * rli[r] - ex[((qg * 4 + d0) * 16 + r) * 64 + lane];
        o[d0][r] = v; ssq[r] += v * v;
      }
#pragma unroll
    for (int r = 0; r < 16; ++r) {
      float s = ssq[r];
      s += __shfl_xor(s, 1); s += __shfl_xor(s, 2); s += __shfl_xor(s, 4); s += __shfl_xor(s, 8); s += __shfl_xor(s, 16);
      ssq[r] = rsqrtf(s * (1.f / 128.f) + EPSF) * (1.f - LAM_INIT);
    }
    float sg[4];
#pragma unroll
    for (int d0 = 0; d0 < 4; ++d0) sg[d0] = p.subln_g[d0 * 32 + r32];
    const u16* gp = p.gb + gbase_i; u16* qp = p.qb + gbase_i;
#pragma unroll
    for (int r = 0; r < 8; ++r) {
      const int ro = ((r & 3) + 8 * (r >> 2)) * 1024;
      if (!dry) {
        qp[ro] = f2bf(o[0][r] * ssq[r] * sg[0] * bf2f(gv0[r][0]));
        qp[ro + 32] = f2bf(o[1][r] * ssq[r] * sg[1] * bf2f(gv0[r][1]));
        qp[ro + 64] = f2bf(o[2][r] * ssq[r] * sg[2] * bf2f(gv0[r][2]));
        qp[ro + 96] = f2bf(o[3][r] * ssq[r] * sg[3] * bf2f(gv0[r][3]));
      }
    }
    SBAR();
    u16 gv1[8][4];
#pragma unroll
    for (int rr = 0; rr < 8; ++rr) {
      const int r = 8 + rr, ro = ((r & 3) + 8 * (r >> 2)) * 1024;
      gv1[rr][0] = gp[ro]; gv1[rr][1] = gp[ro + 32]; gv1[rr][2] = gp[ro + 64]; gv1[rr][3] = gp[ro + 96];
    }
    SBAR();
#pragma unroll
    for (int rr = 0; rr < 8; ++rr) {
      const int r = 8 + rr, ro = ((r & 3) + 8 * (r >> 2)) * 1024;
      if (!dry) {
        qp[ro] = f2bf(o[0][r] * ssq[r] * sg[0] * bf2f(gv1[rr][0]));
        qp[ro + 32] = f2bf(o[1][r] * ssq[r] * sg[1] * bf2f(gv1[rr][1]));
        qp[ro + 64] = f2bf(o[2][r] * ssq[r] * sg[2] * bf2f(gv1[rr][2]));
        qp[ro + 96] = f2bf(o[3][r] * ssq[r] * sg[3] * bf2f(gv1[rr][3]));
      }
    }
  }
}

__device__ __forceinline__ void attn_item2(const Params& p, long tq0, int h, const u16* __restrict__ Kh, const u16* __restrict__ Vh, int seq, char* lds, bool dry) {
  constexpr int LDK = 1024;
  const int tid = opaque_tid(), wid = __builtin_amdgcn_readfirstlane(tid >> 6), lane = tid & 63, r32 = lane & 31, hi = lane >> 5;
  const int comp = wid >> 2, qg = wid & 3;
  u16* V_lds = (u16*)lds; u16* K_lds = (u16*)(lds + 2 * SHM_V);
  float* wsl = (float*)(lds + 2 * SHM_V + 2 * SHM_K) + wid * 128; float* li_a = wsl; float* al_a = wsl + 32; float* li_b = wsl + 64; float* al_b = wsl + 96;
  char* Q_lds = lds + 2 * SHM_V + 2 * SHM_K + 4096;
  float m_a = -1e30f, l_a = 0, m_b = -1e30f, l_b = 0; f32x16 oa[4] = {}, ob[4] = {};
#pragma unroll
  for (int i = 0; i < 8; ++i) {
    int id = tid + i * NTHR; int row = id >> 4, ch = id & 15;
    bf16x8 v = *reinterpret_cast<const bf16x8*>(p.qb + (tq0 + row) * 1024 + h * 128 + ch * 8);
    *reinterpret_cast<bf16x8*>(Q_lds + KSWZ(row, ch * 16)) = v;
  }
  const char* qa_p = Q_lds + (qg * 64) * 256; const char* qb_p = qa_p + 32 * 256;
  const int vb0 = (int)(uintptr_t)V_lds + v_rd_base(lane);
  typedef __attribute__((address_space(3))) unsigned char lds_u8;
  typedef __attribute__((address_space(3))) unsigned lds_u32;
  lds_u8* ldsl = (lds_u8*)lds;
  int koff[2], voff[2];
#pragma unroll
  for (int i = 0; i < 2; ++i) {
    const int offb = ((i * 8 + wid) * 64 + lane) * 16;
    { const int row = offb >> 8, wb = offb & 255, colB = wb ^ ((row & 7) << 4); koff[i] = row * LDK + (colB >> 1); }
    { const int sub = offb >> 9, within = offb & 511, kkh = sub >> 2, cblk = sub & 3, e = within >> 1, kkl = e >> 5, cl = e & 31;
      const int kk = kkh * 8 + kkl, k = (kk & ~0xC) | ((kk & 4) << 1) | ((kk & 8) >> 1); voff[i] = k * LDK + cblk * 32 + cl; }
  }
#define DMA(buf, k0) do { _Pragma("unroll") for (int _i = 0; _i < 2; ++_i) { \
    __builtin_amdgcn_global_load_lds((const unsigned*)(Kh + (long)(k0) * LDK + koff[_i]), (lds_u32*)(ldsl + 2 * SHM_V + (buf) * SHM_K + (_i * 8 + wid) * 1024), 16, 0, 0); \
    __builtin_amdgcn_global_load_lds((const unsigned*)(Vh + (long)(k0) * LDK + voff[_i]), (lds_u32*)(ldsl + (buf) * SHM_V + (_i * 8 + wid) * 1024), 16, 0, 0); } } while (0)
#define RESC2(a, O, AL) do { if (__any((a) < 1.f)) { if (hi == 0) AL[r32] = (a); asm volatile("s_waitcnt lgkmcnt(0)" ::: "memory"); \
    _Pragma("unroll") for (int d = 0; d < 4; ++d) _Pragma("unroll") for (int r = 0; r < 16; ++r) O[d][r] *= AL[crow(r, hi)]; } } while (0)
  const int NT = seq / 64;
  DMA(0, 0); asm volatile("s_waitcnt vmcnt(0)" ::: "memory"); __syncthreads();
  for (int j = 0; j < NT; ++j) {
    const int cur = j & 1;
    if (j + 1 < NT) { if (cur) DMA(0, (j + 1) * 64); else DMA(1, (j + 1) * 64); }
    f32x16 pA0 = {}, pA1 = {}, pB0 = {}, pB1 = {};
    {
      const char* Ks = (const char*)K_lds + cur * SHM_K;
#pragma unroll
      for (int d0 = 0; d0 < 4; ++d0) { const int cb = (comp * 64 + d0 * 16 + hi * 8) * 2;
        bf16x8 k0 = *reinterpret_cast<const bf16x8*>(Ks + KSWZ(r32, cb));
        bf16x8 k1 = *reinterpret_cast<const bf16x8*>(Ks + KSWZ(32 + r32, cb));
        bf16x8 qa = *reinterpret_cast<const bf16x8*>(qa_p + KSWZ(r32, cb));
        bf16x8 qb = *reinterpret_cast<const bf16x8*>(qb_p + KSWZ(r32, cb));
        pA0 = __builtin_amdgcn_mfma_f32_32x32x16_bf16(k0, qa, pA0, 0, 0, 0);
        pA1 = __builtin_amdgcn_mfma_f32_32x32x16_bf16(k1, qa, pA1, 0, 0, 0);
        pB0 = __builtin_amdgcn_mfma_f32_32x32x16_bf16(k0, qb, pB0, 0, 0, 0);
        pB1 = __builtin_amdgcn_mfma_f32_32x32x16_bf16(k1, qb, pB1, 0, 0, 0); SBAR(); }
    }
    float mn, al; bf16x8 a0, a1, a2, a3, b0, b1, b2, b3;
    partialSM(pA0, pA1, m_a, mn, al); RESC2(al, oa, al_a); finishSM(pA0, pA1, al, l_a, a0, a1, a2, a3);
    partialSM(pB0, pB1, m_b, mn, al); RESC2(al, ob, al_b); finishSM(pB0, pB1, al, l_b, b0, b1, b2, b3);
    SBAR();
    const int vb = vb0 + cur * (int)SHM_V;
    pv_two<0>(oa[0], ob[0], vb, a0, a1, a2, a3, b0, b1, b2, b3);
    pv_two<1>(oa[1], ob[1], vb, a0, a1, a2, a3, b0, b1, b2, b3);
    pv_two<2>(oa[2], ob[2], vb, a0, a1, a2, a3, b0, b1, b2, b3);
    pv_two<3>(oa[3], ob[3], vb, a0, a1, a2, a3, b0, b1, b2, b3);
    asm volatile("s_waitcnt vmcnt(0)" ::: "memory");
    __syncthreads();
  }
#undef DMA
#undef RESC2
  if (hi == 0) { li_a[r32] = l_a; li_b[r32] = l_b; } asm volatile("s_waitcnt lgkmcnt(0)" ::: "memory");
  const float lam = p.misc[0];
  float* ex = (float*)lds;
  {
    float rli[16];
#pragma unroll
    for (int r = 0; r < 16; ++r) rli[r] = __builtin_amdgcn_rcpf(li_a[crow(r, hi)]);
    attn_epi(p, oa, rli, comp, qg, lane, r32, hi, tq0 + qg * 64, h, ex, lam, dry);
  }
  {
    float rli[16];
#pragma unroll
    for (int r = 0; r < 16; ++r) rli[r] = __builtin_amdgcn_rcpf(li_b[crow(r, hi)]);
    attn_epi(p, ob, rli, comp, qg, lane, r32, hi, tq0 + qg * 64 + 32, h, ex, lam, dry);
  }
  __syncthreads();
}

__device__ __forceinline__ void conv8(const Params& p, long tok_s, int L, int tpos, int ch0, float (&o)[8]) {
  const u16* base = p.xbc + (tok_s + tpos) * 1536 + ch0;
  bf16x8 r1 = *reinterpret_cast<const bf16x8*>(base);
  bf16x8 r0 = {0, 0, 0, 0, 0, 0, 0, 0}, r2 = {0, 0, 0, 0, 0, 0, 0, 0};
  if (tpos > 0) r0 = *reinterpret_cast<const bf16x8*>(base - 1536);
  if (tpos < L - 1) r2 = *reinterpret_cast<const bf16x8*>(base + 1536);
  const f32x4* w0 = reinterpret_cast<const f32x4*>(p.conv_w + ch0);
  const f32x4* w1 = reinterpret_cast<const f32x4*>(p.conv_w + 1536 + ch0);
  const f32x4* w2 = reinterpret_cast<const f32x4*>(p.conv_w + 3072 + ch0);
  const f32x4* bb = reinterpret_cast<const f32x4*>(p.conv_b + ch0);
  const f32x4 wa0 = w0[0], wa1 = w0[1], wb0 = w1[0], wb1 = w1[1], wc0 = w2[0], wc1 = w2[1], b0 = bb[0], b1 = bb[1];
#pragma unroll
  for (int e = 0; e < 4; ++e) {
    float v = b0[e] + wa0[e] * bfs2f(r0[e]) + wb0[e] * bfs2f(r1[e]) + wc0[e] * bfs2f(r2[e]);
    o[e] = siluf(v);
    float u = b1[e] + wa1[e] * bfs2f(r0[4 + e]) + wb1[e] * bfs2f(r1[4 + e]) + wc1[e] * bfs2f(r2[4 + e]);
    o[4 + e] = siluf(u);
  }
}
__device__ __forceinline__ int rotc(int r, int c) { return (c + ((r >> 3) << 3)) & 127; }
__device__ __forceinline__ void chunk_geom(int cg, long& tok_s, int& L, int& tpos0) {
  if (cg < 32) { tok_s = (long)(cg >> 1) * 256; L = 256; tpos0 = (cg & 1) * 128; }
  else { int cs = cg - 32; tok_s = T_CTX + (long)(cs >> 5) * 4096; L = 4096; tpos0 = (cs & 31) * 128; }
}
__device__ __forceinline__ void ssd_dt_scan(const Params& p, long tok0, int head, float* dtv, float* cum, float* scn, float* tot) {
  const int tid = opaque_tid(), lane = tid & 63, wid = tid >> 6;
  if (tid < 256) {
    int d = tid >> 7, tl = tid & 127;
    float raw = p.dtb[(tok0 + tl) * 32 + d * 16 + head] + p.dt_bias[d * 16 + head];
    float dt = (raw > 20.f) ? raw : log1pf(expf(raw));
    float a = -expf(p.A_log[d * 16 + head]) * dt;
    dtv[d * 128 + tl] = dt;
    int li = d ? 127 - tl : tl;
    scn[d * 128 + li] = a;
  }
  __syncthreads();
  if (wid < 2) {
    int d = wid;
    float a0 = scn[d * 128 + 2 * lane], a1 = scn[d * 128 + 2 * lane + 1];
    float s = a0 + a1;
#pragma unroll
    for (int off = 1; off < 64; off <<= 1) { float t = __shfl_up(s, off); if (lane >= off) s += t; }
    float c0 = s - a1, c1 = s;
    int li0 = 2 * lane, li1 = 2 * lane + 1;
    cum[d * 128 + (d ? 127 - li0 : li0)] = c0;
    cum[d * 128 + (d ? 127 - li1 : li1)] = c1;
    if (lane == 63) tot[d] = c1;
  }
  __syncthreads();
}

__device__ void ssd_state_item(const Params& p, int cg, int head, char* smem, bool dry) {
  const int tid = opaque_tid(), lane = tid & 63, wid = tid >> 6, fr = lane & 15, fq = lane >> 4;
  float* dtv = (float*)smem; float* cum = dtv + 256; float* scn = cum + 256; float* tot = scn + 256;
  u16* XsT = (u16*)(smem + 4096);
  u16* BT = XsT + 64 * 136;
  long tok_s; int L, tpos0; chunk_geom(cg, tok_s, L, tpos0);
  const long tok0 = (long)cg * 128;
  const int g = head >> 2;
  ssd_dt_scan(p, tok0, head, dtv, cum, scn, tot);
  const float tot0 = tot[0], tot1 = tot[1];
#pragma unroll
  for (int rep = 0; rep < 2; ++rep) {
    int id = tid + rep * NTHR; int tl = id >> 3, p0 = (id & 7) * 8;
    float xo[8], bo[8];
    conv8(p, tok_s, L, tpos0 + tl, head * 64 + p0, xo);
    conv8(p, tok_s, L, tpos0 + tl, 1024 + g * 64 + p0, bo);
    float s0 = dtv[tl] * __expf(tot0 - cum[tl]);
    float s1 = dtv[128 + tl] * __expf(tot1 - cum[128 + tl]);
    const int tc = rotc(p0, tl);
#pragma unroll
    for (int e = 0; e < 8; ++e) {
      XsT[(p0 + e) * 136 + tc] = f2bf(xo[e]);
      BT[(p0 + e) * 136 + tc] = f2bf(bo[e] * s0);
      BT[(64 + p0 + e) * 136 + tc] = f2bf(bo[e] * s1);
    }
  }
  __syncthreads();
  {
    const int d = wid >> 2, pb = wid & 3;
    f32x4 acc[4];
#pragma unroll
    for (int ni = 0; ni < 4; ++ni) acc[ni] = f32x4{0.f, 0.f, 0.f, 0.f};
#pragma unroll
    for (int ks = 0; ks < 4; ++ks) {
      bf16x8 a = *reinterpret_cast<const bf16x8*>(XsT + (pb * 16 + fr) * 136 + rotc(pb * 16 + fr, ks * 32 + fq * 8));
#pragma unroll
      for (int ni = 0; ni < 4; ++ni) {
        bf16x8 b = *reinterpret_cast<const bf16x8*>(BT + (d * 64 + ni * 16 + fr) * 136 + rotc(ni * 16 + fr, ks * 32 + fq * 8));
        acc[ni] = mfma16(a, b, acc[ni]);
      }
    }
    u16* dst = p.st + ((long)(cg * 16 + head) * 2 + d) * 4096;
#pragma unroll
    for (int ni = 0; ni < 4; ++ni)
#pragma unroll
      for (int j = 0; j < 4; ++j) { if (!dry) dst[(pb * 16 + fq * 4 + j) * 64 + ni * 16 + fr] = f2bf(acc[ni][j]); }
  }
  if (tid < 2 && !dry) p.cd[(cg * 16 + head) * 2 + tid] = __expf(tot[tid]);
  __syncthreads();
}

__device__ void ssd_state_item2(const Params& p, int it0, char* smem, bool dry) {
  const int tid = opaque_tid(), lane = tid & 63, wid = tid >> 6, fr = lane & 15, fq = lane >> 4;
  constexpr int RSTRIDE = 57344;
  {
    const int u = tid >> 8, t2 = tid & 255, cg = (it0 + u) >> 4, head = (it0 + u) & 15;
    float* dtv = (float*)(smem + u * RSTRIDE); float* scn = dtv + 512;
    const int d = t2 >> 7, tl = t2 & 127;
    float raw = p.dtb[((long)cg * 128 + tl) * 32 + d * 16 + head] + p.dt_bias[d * 16 + head];
    float dt = (raw > 20.f) ? raw : log1pf(expf(raw));
    float a = -expf(p.A_log[d * 16 + head]) * dt;
    dtv[d * 128 + tl] = dt;
    scn[d * 128 + (d ? 127 - tl : tl)] = a;
  }
  __syncthreads();
  if (wid < 4) {
    const int u = wid >> 1, d = wid & 1;
    float* dtv = (float*)(smem + u * RSTRIDE); float* cum = dtv + 256; float* scn = cum + 256; float* tot = scn + 256;
    float a0 = scn[d * 128 + 2 * lane], a1 = scn[d * 128 + 2 * lane + 1];
    float sacc = a0 + a1;
#pragma unroll
    for (int off = 1; off < 64; off <<= 1) { float t = __shfl_up(sacc, off); if (lane >= off) sacc += t; }
    float c0 = sacc - a1, c1 = sacc;
    int li0 = 2 * lane, li1 = 2 * lane + 1;
    cum[d * 128 + (d ? 127 - li0 : li0)] = c0;
    cum[d * 128 + (d ? 127 - li1 : li1)] = c1;
    if (lane == 63) tot[d] = c1;
  }
  __syncthreads();
#pragma unroll
  for (int u = 0; u < 2; ++u) {
    const int cg = (it0 + u) >> 4, head = (it0 + u) & 15, g = head >> 2;
    float* dtv = (float*)(smem + u * RSTRIDE); float* cum = dtv + 256; float* tot = dtv + 768;
    u16* XsT = (u16*)(smem + u * RSTRIDE + 4096); u16* BT = XsT + 64 * 136;
    long tok_s; int L, tpos0; chunk_geom(cg, tok_s, L, tpos0);
    const float tot0 = tot[0], tot1 = tot[1];
#pragma unroll
    for (int rep = 0; rep < 2; ++rep) {
      int id = tid + rep * NTHR; int tl = id >> 3, p0 = (id & 7) * 8;
      float xo[8], bo[8];
      conv8(p, tok_s, L, tpos0 + tl, head * 64 + p0, xo);
      conv8(p, tok_s, L, tpos0 + tl, 1024 + g * 64 + p0, bo);
      float s0 = dtv[tl] * __expf(tot0 - cum[tl]);
      float s1 = dtv[128 + tl] * __expf(tot1 - cum[128 + tl]);
      const int tc = rotc(p0, tl);
#pragma unroll
      for (int e = 0; e < 8; ++e) {
        XsT[(p0 + e) * 136 + tc] = f2bf(xo[e]);
        BT[(p0 + e) * 136 + tc] = f2bf(bo[e] * s0);
        BT[(64 + p0 + e) * 136 + tc] = f2bf(bo[e] * s1);
      }
    }
  }
  __syncthreads();
#pragma unroll
  for (int u = 0; u < 2; ++u) {
    const int cg = (it0 + u) >> 4, head = (it0 + u) & 15;
    const u16* XsT = (const u16*)(smem + u * RSTRIDE + 4096); const u16* BT = XsT + 64 * 136;
    const float* tot = (const float*)(smem + u * RSTRIDE) + 768;
    const int d = wid >> 2, pb = wid & 3;
    f32x4 acc[4];
#pragma unroll
    for (int ni = 0; ni < 4; ++ni) acc[ni] = f32x4{0.f, 0.f, 0.f, 0.f};
#pragma unroll
    for (int ks = 0; ks < 4; ++ks) {
      bf16x8 a = *reinterpret_cast<const bf16x8*>(XsT + (pb * 16 + fr) * 136 + rotc(pb * 16 + fr, ks * 32 + fq * 8));
#pragma unroll
      for (int ni = 0; ni < 4; ++ni) {
        bf16x8 b = *reinterpret_cast<const bf16x8*>(BT + (d * 64 + ni * 16 + fr) * 136 + rotc(ni * 16 + fr, ks * 32 + fq * 8));
        acc[ni] = mfma16(a, b, acc[ni]);
      }
    }
    u16* dst = p.st + ((long)(cg * 16 + head) * 2 + d) * 4096;
#pragma unroll
    for (int ni = 0; ni < 4; ++ni)
#pragma unroll
      for (int j = 0; j < 4; ++j) { if (!dry) dst[(pb * 16 + fq * 4 + j) * 64 + ni * 16 + fr] = f2bf(acc[ni][j]); }
    if (tid < 2 && !dry) p.cd[(cg * 16 + head) * 2 + tid] = __expf(tot[tid]);
  }
  __syncthreads();
}

__device__ void phase3_attn(const Params& p, char* smem, bool dry) {
  constexpr int N_AS = 512, N_AC = 128;
  for (int it = blockIdx.x; it < N_AS + N_AC; it += gridDim.x) {
    long tq0; int h, seq; const u16 *kp, *vp;
    if (it < N_AS) {
      int qbi = it & 15, b = it >> 7; h = (it >> 4) & 7;
      if (gridDim.x == 256) {
        const int r = it >> 8, bid = it & 255, slot = bid >> 3;
        const int bh = r * 16 + (bid & 7) * 2 + (slot >> 4);
        qbi = slot & 15; b = bh >> 3; h = bh & 7;
      }
      tq0 = T_CTX + (long)b * 4096 + qbi * 256; seq = 4608;
      kp = p.kS + (long)b * 4608 * 1024 + h * 128; vp = p.vS + (long)b * 4608 * 1024 + h * 128;
    } else {
      int i = it - N_AS; int b = i >> 3; h = i & 7;
      tq0 = (long)b * 256; seq = 256;
      kp = p.kC + (long)b * 256 * 1024 + h * 128; vp = p.vC + (long)b * 256 * 1024 + h * 128;
    }
    attn_item2(p, tq0, h, kp, vp, seq, smem, dry);
  }
}
__device__ void phase3_state(const Params& p, char* smem, bool dry) {
  int start = blockIdx.x, stride = gridDim.x, cnt = (160 * 8 - (int)blockIdx.x + (int)gridDim.x - 1) / (int)gridDim.x;
  if (gridDim.x == 256) { stride = 128; if (blockIdx.x < 128) { start = blockIdx.x; cnt = 4; } else { start = 512 + (blockIdx.x - 128); cnt = 6; } }
#pragma unroll 1
  for (int k = 0; k < cnt; ++k) ssd_state_item2(p, (start + k * stride) * 2, smem, dry);
}
__device__ void phase3(const Params& p, char* smem) {
  if (p.probe & 8) phase3_attn(p, smem, true);
  if (p.probe & 16) phase3_state(p, smem, true);
  phase3_attn(p, smem, false);
  phase3_state(p, smem, false);
}

__device__ void phase4(const Params& p, char* smem) {
  const int tid = opaque_tid();
  for (int it = blockIdx.x; it < 256 + 1024; it += gridDim.x) {
    int seq, head, d, half, nc, c0; const float* h0p = nullptr; float* outp = nullptr;
    if (it < 256) { half = it & 1; d = (it >> 1) & 1; head = (it >> 2) & 15; int b = it >> 6; seq = 16 + b; nc = 32; c0 = 32 + b * 32;
      h0p = p.state_ssd + ((long)(b * 2 + d) * 16 + head) * 4096; }
    else { int i = it - 256; half = i & 1; d = (i >> 1) & 1; head = (i >> 2) & 15; int b = i >> 6; seq = b; nc = 2; c0 = b * 2;
      outp = p.out + 29360128L + ((long)(b * 2 + d) * 16 + head) * 4096; }
    (void)seq;
    const int e = half * 2048 + tid * 4;
    float h[4] = {0.f, 0.f, 0.f, 0.f};
    if (h0p) { float4 v = *reinterpret_cast<const float4*>(h0p + e); h[0] = v.x; h[1] = v.y; h[2] = v.z; h[3] = v.w; }
    const int cstart = d ? c0 + nc - 1 : c0, cstep = d ? -1 : 1;
    for (int i0 = 0; i0 < nc; i0 += 8) {
      u32x2 sv[8]; float dc[8];
#pragma unroll
      for (int k = 0; k < 8; ++k) if (i0 + k < nc) {
        int cgi = cstart + (i0 + k) * cstep;
        sv[k] = *reinterpret_cast<const u32x2*>(p.st + ((long)(cgi * 16 + head) * 2 + d) * 4096 + e);
        dc[k] = p.cd[(cgi * 16 + head) * 2 + d];
      }
#pragma unroll
      for (int k = 0; k < 8; ++k) if (i0 + k < nc) {
        int cgi = cstart + (i0 + k) * cstep;
        u32x2 hw = {cvtpk(h[0], h[1]), cvtpk(h[2], h[3])};
        *reinterpret_cast<u32x2*>(p.st + ((long)(cgi * 16 + head) * 2 + d) * 4096 + e) = hw;
        float s0 = __uint_as_float(sv[k][0] << 16), s1 = __uint_as_float(sv[k][0] & 0xffff0000u);
        float s2 = __uint_as_float(sv[k][1] << 16), s3 = __uint_as_float(sv[k][1] & 0xffff0000u);
        h[0] = h[0] * dc[k] + s0; h[1] = h[1] * dc[k] + s1; h[2] = h[2] * dc[k] + s2; h[3] = h[3] * dc[k] + s3;
      }
    }
    if (outp) { float4 v = {h[0], h[1], h[2], h[3]}; *reinterpret_cast<float4*>(outp + e) = v; }
  }
}

__device__ void ssd_y_item(const Params& p, int cg, int head, char* smem, bool dry) {
  const int tid = opaque_tid(), lane = tid & 63, wid = tid >> 6, fr = lane & 15, fq = lane >> 4;
  float* dtv = (float*)smem; float* cum = dtv + 256; float* scn = cum + 256; float* tot = scn + 256;
  u16* XT = (u16*)(smem + 4096);
  u16* Cs = XT + 64 * 136;
  u16* Bs = Cs + 128 * 72;
  u16* Ms = Bs + 128 * 72;
  u16* Hs = Ms + 128 * 136;
  long tok_s; int L, tpos0; chunk_geom(cg, tok_s, L, tpos0);
  const long tok0 = (long)cg * 128;
  const int g = head >> 2;
  bf16x8 hpre[2];
  {
    const int pp = tid >> 3, ch = (tid & 7) * 8;
    hpre[0] = *reinterpret_cast<const bf16x8*>(p.st + ((long)(cg * 16 + head) * 2 + 0) * 4096 + pp * 64 + ch);
    hpre[1] = *reinterpret_cast<const bf16x8*>(p.st + ((long)(cg * 16 + head) * 2 + 1) * 4096 + pp * 64 + ch);
  }
  ssd_dt_scan(p, tok0, head, dtv, cum, scn, tot);
#pragma unroll
  for (int rep = 0; rep < 2; ++rep) {
    int id = tid + rep * NTHR; int tl = id >> 3, p0 = (id & 7) * 8;
    float xo[8], bo[8], co[8];
    conv8(p, tok_s, L, tpos0 + tl, head * 64 + p0, xo);
    conv8(p, tok_s, L, tpos0 + tl, 1024 + g * 64 + p0, bo);
    conv8(p, tok_s, L, tpos0 + tl, 1280 + g * 64 + p0, co);
#pragma unroll
    for (int e = 0; e < 8; ++e) XT[(p0 + e) * 136 + rotc(p0, tl)] = f2bf(xo[e]);
    *reinterpret_cast<bf16x8*>(Bs + tl * 72 + p0) = pack8(bo);
    *reinterpret_cast<bf16x8*>(Cs + tl * 72 + p0) = pack8(co);
  }
  __syncthreads();
  f32x4 cb[8];
#pragma unroll
  for (int si = 0; si < 8; ++si) cb[si] = f32x4{0.f, 0.f, 0.f, 0.f};
#pragma unroll
  for (int ks = 0; ks < 2; ++ks) {
    bf16x8 a = *reinterpret_cast<const bf16x8*>(Cs + (wid * 16 + fr) * 72 + ks * 32 + fq * 8);
#pragma unroll
    for (int si = 0; si < 8; ++si) {
      bf16x8 b = *reinterpret_cast<const bf16x8*>(Bs + (si * 16 + fr) * 72 + ks * 32 + fq * 8);
      cb[si] = mfma16(a, b, cb[si]);
    }
  }
  f32x4 yacc[4];
#pragma unroll
  for (int pi = 0; pi < 4; ++pi) yacc[pi] = f32x4{0.f, 0.f, 0.f, 0.f};
  u16 zpre[4][4];
#pragma unroll
  for (int j = 0; j < 4; ++j)
#pragma unroll
    for (int pi = 0; pi < 4; ++pi) zpre[j][pi] = p.zb[(tok0 + wid * 16 + fq * 4 + j) * 1024 + head * 64 + pi * 16 + fr];
  {
    {
      int pp = tid >> 3, ch = (tid & 7) * 8;
      *reinterpret_cast<bf16x8*>(Hs + pp * 72 + ch) = hpre[0];
      *reinterpret_cast<bf16x8*>(Hs + 64 * 72 + pp * 72 + ch) = hpre[1];
    }
    float cq0[4], cq1[4];
#pragma unroll
    for (int j = 0; j < 4; ++j) { cq0[j] = cum[wid * 16 + fq * 4 + j]; cq1[j] = cum[128 + wid * 16 + fq * 4 + j]; }
#pragma unroll
    for (int si = 0; si < 8; ++si) {
      const int s = si * 16 + fr;
      const float cs0 = cum[s], cs1 = cum[128 + s], dt0 = dtv[s], dt1 = dtv[128 + s];
#pragma unroll
      for (int j = 0; j < 4; ++j) {
        const int q = wid * 16 + fq * 4 + j;
        const float arg = (s < q) ? (cq0[j] - cs0) : (cq1[j] - cs1);
        const float w = (s < q) ? dt0 : ((s > q) ? dt1 : dt0 + dt1);
        const float v = cb[si][j] * __expf((s == q) ? 0.f : arg) * w;
        Ms[q * 136 + s] = f2bf(v);
      }
    }
    __syncthreads();
    f32x4 tmp0[4], tmp1[4];
#pragma unroll
    for (int pi = 0; pi < 4; ++pi) { tmp0[pi] = f32x4{0.f, 0.f, 0.f, 0.f}; tmp1[pi] = f32x4{0.f, 0.f, 0.f, 0.f}; }
#pragma unroll
    for (int ks = 0; ks < 4; ++ks) {
      bf16x8 a = *reinterpret_cast<const bf16x8*>(Ms + (wid * 16 + fr) * 136 + ks * 32 + fq * 8);
#pragma unroll
      for (int pi = 0; pi < 4; ++pi) {
        bf16x8 b = *reinterpret_cast<const bf16x8*>(XT + (pi * 16 + fr) * 136 + rotc(pi * 16 + fr, ks * 32 + fq * 8));
        yacc[pi] = mfma16(a, b, yacc[pi]);
      }
    }
#pragma unroll
    for (int ks = 0; ks < 2; ++ks) {
      bf16x8 a = *reinterpret_cast<const bf16x8*>(Cs + (wid * 16 + fr) * 72 + ks * 32 + fq * 8);
#pragma unroll
      for (int pi = 0; pi < 4; ++pi) {
        bf16x8 b0 = *reinterpret_cast<const bf16x8*>(Hs + (pi * 16 + fr) * 72 + ks * 32 + fq * 8);
        bf16x8 b1 = *reinterpret_cast<const bf16x8*>(Hs + 64 * 72 + (pi * 16 + fr) * 72 + ks * 32 + fq * 8);
        tmp0[pi] = mfma16(a, b0, tmp0[pi]);
        tmp1[pi] = mfma16(a, b1, tmp1[pi]);
      }
    }
#pragma unroll
    for (int j = 0; j < 4; ++j) {
      const float e0 = __expf(cq0[j]), e1 = __expf(cq1[j]);
#pragma unroll
      for (int pi = 0; pi < 4; ++pi) yacc[pi][j] += e0 * tmp0[pi][j] + e1 * tmp1[pi][j];
    }
  }
  const float dsk = p.D_skip[head];
#pragma unroll
  for (int j = 0; j < 4; ++j) {
    int q = wid * 16 + fq * 4 + j;
    float ss = 0.f;
#pragma unroll
    for (int pi = 0; pi < 4; ++pi) {
      int pp = pi * 16 + fr;
      long idx = (tok0 + q) * 1024 + head * 64 + pp;
      float y = yacc[pi][j] + dsk * bf2f(XT[pp * 136 + rotc(pp, q)]);
      float yg = y * bf2f(zpre[j][pi]);
      if (!dry) p.zb[idx] = f2bf(yg);
      ss += yg * yg;
    }
    ss += __shfl_xor(ss, 1); ss += __shfl_xor(ss, 2); ss += __shfl_xor(ss, 4); ss += __shfl_xor(ss, 8);
    if (fr == 0 && !dry) p.ssqp[(tok0 + q) * 16 + head] = ss;
  }
  __syncthreads();
}
__device__ void phase5(const Params& p, char* smem) {
  if (p.probe & 32) { for (int it = blockIdx.x; it < 160 * 16; it += gridDim.x) ssd_y_item(p, it >> 4, it & 15, smem, true); }
  for (int it = blockIdx.x; it < 160 * 16; it += gridDim.x) ssd_y_item(p, it >> 4, it & 15, smem, false);
}

struct SegOrder : pg8::StaticOrder {
  __device__ bool next(int i, pg8::Unit& u) const {
    if (G != 256 || nwg != 320) { if (!tile_at((long)(i >> 1) * G + c, u)) return false; u.seg = i & 1; return true; }
    if (i < 2) { tile_at(c, u); u.seg = i; return true; }
    if (i > 2 || c >= 128) return false;
    const int t2 = c & 63;
    tile_at(256 + t2, u); u.seg = c >> 6; u.split = 1 + t2; return true;
  }
};
struct EpiOut {
  static constexpr bool PERM = true, AFTER_DRAIN = false, KEEP = true;
  const Params& p;
  __device__ __forceinline__ void operator()(f32x4 (&acc)[2][2][4][2], const pg8::Unit& u, int wr, int wc, int fr, int fq) const {
    const int m0 = u.pm * 256, n0 = u.pn * 256;
    if (u.seg == 0) {
#pragma unroll
      for (int ai = 0; ai < 2; ++ai) {
        f32x4 sv[4][4];
#pragma unroll
        for (int m = 0; m < 4; ++m) {
          const int t = m0 + ai * 128 + wr * 64 + m * 16 + fr;
          const f32x4* sp = reinterpret_cast<const f32x4*>(p.ssqp + (long)t * 16);
          sv[m][0] = sp[0]; sv[m][1] = sp[1]; sv[m][2] = sp[2]; sv[m][3] = sp[3];
        }
        SBAR();
#pragma unroll
        for (int m = 0; m < 4; ++m) {
          const f32x4 sa = sv[m][0] + sv[m][1] + sv[m][2] + sv[m][3];
          const float r = rsqrtf((sa[0] + sa[1] + sa[2] + sa[3]) * (1.f / 1024.f) + EPSF);
#pragma unroll
          for (int bj = 0; bj < 2; ++bj)
#pragma unroll
            for (int n = 0; n < 2; ++n) acc[ai][bj][m][n] *= r;
        }
        SBAR();
      }
      if (u.split) {
        const int wid = wr * 4 + wc, lane = fq * 16 + fr;
        float* sc = reinterpret_cast<float*>(p.st) + (size_t)(u.split - 1) * 65536 + (wid * 64 + lane) * 4;
#pragma unroll
        for (int ai = 0; ai < 2; ++ai)
#pragma unroll
          for (int bj = 0; bj < 2; ++bj)
#pragma unroll
            for (int m = 0; m < 4; ++m)
              { *reinterpret_cast<f32x4*>(sc + ((((ai * 2 + bj) * 4 + m) * 2 + 0) * 2048)) = acc[ai][bj][m][0]; *reinterpret_cast<f32x4*>(sc + ((((ai * 2 + bj) * 4 + m) * 2 + 1) * 2048)) = acc[ai][bj][m][1]; }
        __builtin_amdgcn_fence(__ATOMIC_RELEASE, "agent");
        asm volatile("s_waitcnt vmcnt(0)" ::: "memory");
        if (lane == 0) __hip_atomic_fetch_add(p.bar + SPLIT_FLAG0 + (u.split - 1), 1u, __ATOMIC_RELAXED, __HIP_MEMORY_SCOPE_AGENT);
      }
      return;
    }
    if (u.split) {
      const int wid = wr * 4 + wc, lane = fq * 16 + fr;
      unsigned* fl = p.bar + SPLIT_FLAG0 + (u.split - 1);
      unsigned sp = 0;
      while (__hip_atomic_load(fl, __ATOMIC_RELAXED, __HIP_MEMORY_SCOPE_AGENT) < 8u) { __builtin_amdgcn_s_sleep(2); if (++sp > (1u << 22)) break; }
      __builtin_amdgcn_fence(__ATOMIC_ACQUIRE, "agent");
      asm volatile("s_waitcnt vmcnt(0)" ::: "memory");
    }
    const int mr = (m0 < T_CTX) ? 0 : 1 + ((m0 - T_CTX) >> 12);
    const float* xb = (m0 < T_CTX) ? p.x_prompt + (long)m0 * 1024 : p.x_sample + (long)(m0 - T_CTX) * 1024;
    const int c0 = n0 + wc * 32 + 8 * fq;
    const float* gbase = p.modv + mr * 3072 + 2048 + c0;
    const bool spl = (u.split != 0);
    const int pstr = spl ? 2048 : 0;
    const float* pbase = spl ? reinterpret_cast<const float*>(p.st) + (size_t)(u.split - 1) * 65536 + ((wr * 4 + wc) * 64 + fq * 16 + fr) * 4
                             : reinterpret_cast<const float*>(p.bar + SPLIT_FLAG0 + 64);
#pragma unroll
    for (int ai = 0; ai < 2; ++ai)
#pragma unroll
      for (int mp = 0; mp < 2; ++mp) {
        f32x4 xv[2][2][2];
#pragma unroll
        for (int mm = 0; mm < 2; ++mm) {
          const int m = mp * 2 + mm, rl = ai * 128 + wr * 64 + m * 16 + fr;
          const float* xr = xb + rl * 1024 + c0;
#pragma unroll
          for (int bj = 0; bj < 2; ++bj) {
            xv[mm][bj][0] = *reinterpret_cast<const f32x4*>(xr + bj * 128); xv[mm][bj][1] = *reinterpret_cast<const f32x4*>(xr + bj * 128 + 4);
          }
        }
        SBAR();
#pragma unroll
        for (int mm = 0; mm < 2; ++mm) {
          const int m = mp * 2 + mm, rl = ai * 128 + wr * 64 + m * 16 + fr;
          u16* orow = p.kC + (long)(m0 + rl) * 1024 + c0;
          const float* gp = gbase; asm volatile("" : "+v"(gp));
          float ss = 0.f;
#pragma unroll
          for (int bj = 0; bj < 2; ++bj) {
            const f32x4 g0 = *reinterpret_cast<const f32x4*>(gp + bj * 128), g1 = *reinterpret_cast<const f32x4*>(gp + bj * 128 + 4);
            const f32x4 q0 = *reinterpret_cast<const f32x4*>(pbase + ((((ai * 2 + bj) * 4 + m) * 2 + 0) * pstr));
            const f32x4 q1 = *reinterpret_cast<const f32x4*>(pbase + ((((ai * 2 + bj) * 4 + m) * 2 + 1) * pstr));
            f32x4 v0 = xv[mm][bj][0] + g0 * (acc[ai][bj][m][0] + q0);
            f32x4 v1 = xv[mm][bj][1] + g1 * (acc[ai][bj][m][1] + q1);
            u32x4 w = {cvtpk(v0[0], v0[1]), cvtpk(v0[2], v0[3]), cvtpk(v1[0], v1[1]), cvtpk(v1[2], v1[3])};
            *reinterpret_cast<u32x4*>(orow + bj * 128) = w;
#pragma unroll
            for (int e = 0; e < 4; ++e) {
              float lo = __uint_as_float(w[e] << 16), hi = __uint_as_float(w[e] & 0xffff0000u);
              ss += lo * lo + hi * hi;
            }
          }
          ss += __shfl_xor(ss, 16); ss += __shfl_xor(ss, 32);
          if (fq == 0) p.ssq2p[(long)(m0 + rl) * 16 + u.pn * 4 + wc] = ss;
        }
        SBAR();
      }
  }
};
__device__ void phase6(const Params& p, char* smem) {
  SegOrder S; S.init(T_ALL, 1024, (int)gridDim.x, (int)blockIdx.x);
  pg8::Gemm g{p.zb, p.woutT + 1024 * 1024, T_ALL, 1024, 1024, p.qb, p.woutT};
  EpiOut E{p};
  pg8::gemm_phase<EpiOut, SegOrder, false>((PG8_LAS unsigned char*)smem, g, S, E, nullptr);
  __syncthreads();
}

__device__ void phase7(const Params& p, char* smem) {
  const int tid = opaque_tid(), lane = tid & 63, wid = tid >> 6;
  for (int it = blockIdx.x; it < T_ALL / 32; it += gridDim.x) {
    u32x2 w[4][4]; float sq[4];
#pragma unroll
    for (int rr = 0; rr < 4; ++rr) {
      const int t = it * 32 + rr * 8 + wid;
      const u16* xr = p.kC + (long)t * 1024;
#pragma unroll
      for (int i = 0; i < 4; ++i) w[rr][i] = *reinterpret_cast<const u32x2*>(xr + i * 256 + lane * 4);
      sq[rr] = (lane < 16) ? p.ssq2p[(long)t * 16 + lane] : 0.f;
    }
#pragma unroll
    for (int rr = 0; rr < 4; ++rr) {
      const int t = it * 32 + rr * 8 + wid;
      float s = sq[rr];
      s += __shfl_xor(s, 1); s += __shfl_xor(s, 2); s += __shfl_xor(s, 4); s += __shfl_xor(s, 8);
      s = __shfl(s, 0);
      const float rs = rsqrtf(s * (1.f / 1024.f) + EPSF);
      float* yr = p.out + (long)t * 1024;
#pragma unroll
      for (int i = 0; i < 4; ++i) {
        int col = i * 256 + lane * 4;
        float4 g = *reinterpret_cast<const float4*>(p.final_g + col);
        float4 v;
        v.x = __uint_as_float(w[rr][i][0] << 16) * rs * g.x; v.y = __uint_as_float(w[rr][i][0] & 0xffff0000u) * rs * g.y;
        v.z = __uint_as_float(w[rr][i][1] << 16) * rs * g.z; v.w = __uint_as_float(w[rr][i][1] & 0xffff0000u) * rs * g.w;
        __builtin_nontemporal_store(v.x, yr + col); __builtin_nontemporal_store(v.y, yr + col + 1);
        __builtin_nontemporal_store(v.z, yr + col + 2); __builtin_nontemporal_store(v.w, yr + col + 3);
      }
    }
  }
}

#define XB_TMO      128
#define XB_XCNT(j)  (256  + 64 * (j))
#define XB_XSUB(j)  (1280 + 64 * (j))
#define XB_XGEN(j)  (2304 + 64 * (j))
#define XB_TOP      3328
#define XB_TOPGEN   3392
#define XCD_BAR_WORDS 3456
#define XB_SPIN_CAP (1u << 18)
#define XLAS __attribute__((address_space(3)))

__device__ __forceinline__ unsigned xb_ld(unsigned* p)              { return __hip_atomic_load(p, __ATOMIC_RELAXED, __HIP_MEMORY_SCOPE_AGENT); }
__device__ __forceinline__ unsigned xb_add(unsigned* p, unsigned v) { return __hip_atomic_fetch_add(p, v, __ATOMIC_RELAXED, __HIP_MEMORY_SCOPE_AGENT); }
__device__ __forceinline__ unsigned xb_xcc_id() { return (unsigned)__builtin_amdgcn_s_getreg((3 << 11) | 20) & 0xFu; }
#define XB_SPIN(cond, bar) do { unsigned _sp = 0; while (cond) { __builtin_amdgcn_s_sleep(1); \
    if ((++_sp & 255u) == 0u) { if (xb_ld(&(bar)[XB_TMO])) break; if (_sp > XB_SPIN_CAP) { atomicAdd(&(bar)[XB_TMO], 1u); break; } } } } while (0)

struct XcdBarrier {
    unsigned* bar; unsigned x;
    volatile XLAS unsigned* st;
};

__device__ __forceinline__ XcdBarrier xcd_barrier_post(unsigned* bar, volatile XLAS unsigned* st) {
    XcdBarrier b; b.bar = bar; b.x = xb_xcc_id(); b.st = st;
    if (threadIdx.x == 0) (void)xb_add(&bar[XB_XCNT(b.x)], 1u);
    return b;
}
__device__ __forceinline__ void xcd_barrier_complete(unsigned* bar, unsigned x, unsigned& nloc, unsigned& nx) {
    const unsigned G = gridDim.x * gridDim.y * gridDim.z;
    unsigned sum, cnt, mine, sp = 0u;
    for (;;) {
        sum = 0u; cnt = 0u; mine = 0u;
#pragma unroll
        for (unsigned j = 0; j < 16; ++j) { const unsigned c = xb_ld(&bar[XB_XCNT(j)]); sum += c; cnt += (c > 0u) ? 1u : 0u; mine = (j == x) ? c : mine; }
        if (sum == G) break;
        __builtin_amdgcn_s_sleep(1);
        if ((++sp & 255u) == 0u) { if (xb_ld(&bar[XB_TMO])) break; if (sp > XB_SPIN_CAP) { atomicAdd(&bar[XB_TMO], 1u); break; } }
    }
    nloc = mine > 0u ? mine : 1u; nx = cnt > 0u ? cnt : 1u;
}

__device__ __forceinline__ void xcd_barrier(const XcdBarrier& b) {
    asm volatile("s_waitcnt vmcnt(0)" ::: "memory");
    __syncthreads();
    if (threadIdx.x == 0) {
        unsigned* bar = b.bar;
        __builtin_amdgcn_s_waitcnt(0);
        unsigned nloc = b.st[0], nx = b.st[1];
        if (nloc == 0u) { xcd_barrier_complete(bar, b.x, nloc, nx); b.st[0] = nloc; b.st[1] = nx; }
        const unsigned old = xb_add(&bar[XB_XSUB(b.x)], 1u);
        const unsigned gen = old / nloc;
        if (old + 1u == (gen + 1u) * nloc) {
            __builtin_amdgcn_fence(__ATOMIC_RELEASE, "agent");
            asm volatile("s_waitcnt vmcnt(0)" ::: "memory");
            const unsigned og = xb_add(&bar[XB_TOP], 1u);
            const unsigned tg = og / nx;
            if (og + 1u == (tg + 1u) * nx) xb_add(&bar[XB_TOPGEN], 1u);
            else XB_SPIN(xb_ld(&bar[XB_TOPGEN]) == tg, bar);
            __builtin_amdgcn_fence(__ATOMIC_ACQUIRE, "agent");
            xb_add(&bar[XB_XGEN(b.x)], 1u);
            asm volatile("s_waitcnt vmcnt(0)" ::: "memory");
        } else {
            XB_SPIN(xb_ld(&bar[XB_XGEN(b.x)]) == gen, bar);
            __builtin_amdgcn_fence(__ATOMIC_ACQUIRE, "agent");
            asm volatile("s_waitcnt vmcnt(0)" ::: "memory");
        }
    }
    __syncthreads();
}

template <int PH> __device__ __forceinline__ void run_phase(const Params& p, char* smem) {
  if constexpr (PH == 0) phase0(p, smem);
  if constexpr (PH == 1) phase1(p, smem);
  if constexpr (PH == 2) phase2(p, smem);
  if constexpr (PH == 3) phase3(p, smem);
  if constexpr (PH == 4) phase4(p, smem);
  if constexpr (PH == 5) phase5(p, smem);
  if constexpr (PH == 6) phase6(p, smem);
  if constexpr (PH == 7) phase7(p, smem);
}

#if MK_COOP
__global__ void __launch_bounds__(NTHR) fwd_megakernel(Params p) {
  extern __shared__ __attribute__((aligned(16))) char smem[];
  cg::grid_group grid = cg::this_grid();
  __shared__ unsigned xb_st[4];
  if (threadIdx.x < 4) xb_st[threadIdx.x] = 0u;
  __syncthreads();
  if (p.probe == 0x7fffffff) grid.sync();
  const XcdBarrier xb = xcd_barrier_post(p.bar, (volatile XLAS unsigned*)xb_st);
  for (int r = 0; r < REP0; ++r) { phase0(p, smem); xcd_barrier(xb); }
  for (int r = 0; r < REP1; ++r) { phase1(p, smem); xcd_barrier(xb); }
  for (int r = 0; r < REP2; ++r) { phase2(p, smem); xcd_barrier(xb); }
  phase3(p, smem); xcd_barrier(xb);
  phase4(p, smem); xcd_barrier(xb);
  phase5(p, smem); xcd_barrier(xb);
  for (int r = 0; r < REP6; ++r) { phase6(p, smem); xcd_barrier(xb); }
  phase7(p, smem);
}
#else
template <int PH> __global__ void __launch_bounds__(NTHR) phase_kernel(Params p) {
  extern __shared__ __attribute__((aligned(16))) char smem[];
  run_phase<PH>(p, smem);
}
#endif

#ifndef XLAST
#define XLAST
#endif
#ifndef LAST_PHASE
#define LAST_PHASE 7
#endif
__global__ void dbg_copy(const uint4* __restrict__ src, uint4* __restrict__ dst, long n16) {
  for (long i = blockIdx.x * 256L + threadIdx.x; i < n16; i += gridDim.x * 256L) dst[i] = src[i];
}
extern "C" void kernel_launch(void* const* d_in, const int* in_sizes, int n_in, void* d_out, int out_size, void* d_ws, size_t ws_size,
                              hipStream_t stream) {
  Params p;
  memset(&p, 0, sizeof(p));
  const float* const* in = (const float* const*)d_in;
  p.x_prompt = in[0]; p.x_sample = in[1]; p.cache_k = in[2]; p.cache_v = in[3]; p.state_ssd = in[4]; p.c = in[5]; p.c_ctx = in[6];
  p.w_mod = in[7]; p.b_mod = in[8]; p.norm_g = in[9]; p.w_in = in[10]; p.lq1 = in[11]; p.lk1 = in[12]; p.lq2 = in[13]; p.lk2 = in[14];
  p.subln_g = in[15]; p.conv_w = in[16]; p.conv_b = in[17]; p.dt_bias = in[18]; p.A_log = in[19]; p.D_skip = in[20];
  p.ssd_norm_g = in[21]; p.w_out = in[22]; p.final_g = in[23];
  p.out = (float*)d_out;
  p.probe = PROBE_MASK;
  char* w = (char*)d_ws; size_t off = 0;
  auto take = [&](size_t bytes) { char* r = w + off; off += (bytes + 255) & ~(size_t)255; return r; };
  p.winT = (u16*)take((size_t)NPADW * 1024 * 2);
  p.woutT = (u16*)take((size_t)1024 * 2048 * 2);
  p.qb = (u16*)take((size_t)T_ALL * 1024 * 2);
  p.kC = (u16*)take((size_t)T_CTX * 1024 * 2);
  p.kS = (u16*)take((size_t)4 * 4608 * 1024 * 2);
  p.vC = (u16*)take((size_t)T_CTX * 1024 * 2);
  p.vS = (u16*)take((size_t)4 * 4608 * 1024 * 2);
  p.zb = (u16*)take((size_t)T_ALL * 1024 * 2);
  p.xbc = (u16*)take((size_t)T_ALL * 1536 * 2);
  p.dtb = (float*)take((size_t)T_ALL * 32 * 4);
  p.modv = (float*)take((size_t)5 * 3072 * 4);
  p.rope = (float*)take((size_t)64 * 16 * 2 * 4);
  p.misc = (float*)take(256);
  p.cd = (float*)take((size_t)160 * 16 * 2 * 4);
  p.ssqp = (float*)take((size_t)T_ALL * 16 * 4);
  p.ssq2p = (float*)take((size_t)T_ALL * 16 * 4);
  p.bar = (unsigned*)take((size_t)(XCD_BAR_WORDS + 64 + 65536) * 4);
  if (off > ws_size) { fprintf(stderr, "kernel_launch: workspace too small: need %zu have %zu\n", off, ws_size); return; }
  p.hb = (u16*)d_out;
  p.st = (u16*)d_out;
  p.gb = (u16*)d_out + (size_t)T_ALL * 1024;

#if MK_COOP
  static int grid_blocks = 0;
  if (!grid_blocks) {
    int dev = 0, cus = 0, per_cu = 0;
    hipGetDevice(&dev);
    hipDeviceGetAttribute(&cus, hipDeviceAttributeMultiprocessorCount, dev);
    hipFuncSetAttribute((const void*)fwd_megakernel, hipFuncAttributeMaxDynamicSharedMemorySize, LDS_BYTES);
    hipOccupancyMaxActiveBlocksPerMultiprocessor(&per_cu, (const void*)fwd_megakernel, NTHR, LDS_BYTES);
    if (per_cu < 1) per_cu = 1;
    grid_blocks = cus * per_cu;
  }
  (void)hipMemsetAsync(p.bar, 0, (size_t)(XCD_BAR_WORDS + 64 + 65536) * 4, stream);
  void* args[] = {&p};
  hipError_t e = hipLaunchCooperativeKernel((const void*)fwd_megakernel, dim3(grid_blocks), dim3(NTHR), args, LDS_BYTES, stream);
  if (e != hipSuccess) fprintf(stderr, "cooperative launch failed: %s (grid %d)\n", hipGetErrorString(e), grid_blocks);
#else
  static int attr_done = 0;
  if (!attr_done) {
    hipFuncSetAttribute((const void*)phase_kernel<0>, hipFuncAttributeMaxDynamicSharedMemorySize, LDS_BYTES);
    hipFuncSetAttribute((const void*)phase_kernel<1>, hipFuncAttributeMaxDynamicSharedMemorySize, LDS_BYTES);
    hipFuncSetAttribute((const void*)phase_kernel<2>, hipFuncAttributeMaxDynamicSharedMemorySize, LDS_BYTES);
    hipFuncSetAttribute((const void*)phase_kernel<3>, hipFuncAttributeMaxDynamicSharedMemorySize, LDS_BYTES);
    hipFuncSetAttribute((const void*)phase_kernel<4>, hipFuncAttributeMaxDynamicSharedMemorySize, LDS_BYTES);
    hipFuncSetAttribute((const void*)phase_kernel<5>, hipFuncAttributeMaxDynamicSharedMemorySize, LDS_BYTES);
    hipFuncSetAttribute((const void*)phase_kernel<6>, hipFuncAttributeMaxDynamicSharedMemorySize, LDS_BYTES);
    hipFuncSetAttribute((const void*)phase_kernel<7>, hipFuncAttributeMaxDynamicSharedMemorySize, LDS_BYTES);
    attr_done = 1;
  }
  const int G = 256;
  if (LAST_PHASE >= 0) hipLaunchKernelGGL(phase_kernel<0>, dim3(G), dim3(NTHR), LDS_BYTES, stream, p);
  if (LAST_PHASE >= 1) hipLaunchKernelGGL(phase_kernel<1>, dim3(G), dim3(NTHR), LDS_BYTES, stream, p);
  if (LAST_PHASE >= 2) hipLaunchKernelGGL(phase_kernel<2>, dim3(G), dim3(NTHR), LDS_BYTES, stream, p);
  if (LAST_PHASE >= 3) hipLaunchKernelGGL(phase_kernel<3>, dim3(G), dim3(NTHR), LDS_BYTES, stream, p);
  if (LAST_PHASE >= 4) hipLaunchKernelGGL(phase_kernel<4>, dim3(G), dim3(NTHR), LDS_BYTES, stream, p);
  if (LAST_PHASE >= 5) hipLaunchKernelGGL(phase_kernel<5>, dim3(G), dim3(NTHR), LDS_BYTES, stream, p);
  if (LAST_PHASE >= 6) hipLaunchKernelGGL(phase_kernel<6>, dim3(G), dim3(NTHR), LDS_BYTES, stream, p);
  if (LAST_PHASE >= 7) hipLaunchKernelGGL(phase_kernel<7>, dim3(G), dim3(NTHR), LDS_BYTES, stream, p);
#if LAST_PHASE == 3
  hipLaunchKernelGGL(dbg_copy, dim3(1024), dim3(256), 0, stream, (const uint4*)p.qb, (uint4*)p.gb, (long)T_ALL * 1024 * 2 / 16);
#endif
#endif
}
```

```cpp
#include <hip/hip_runtime.h>
#include <hip/hip_cooperative_groups.h>
#include <cstdio>
#include <cstring>
#include <cstdint>
namespace cg = cooperative_groups;

#ifndef REP0
#define REP0 1
#endif
#ifndef REP1
#define REP1 1
#endif
#ifndef REP2
#define REP2 1
#endif
#ifndef REP6
#define REP6 1
#endif
__device__ __forceinline__ int opaque_tid() { int t = threadIdx.x; asm volatile("" : "+v"(t)); return t; }
#ifndef PROBE_MASK
#define PROBE_MASK 0
#endif
constexpr int SPLIT_FLAG0 = 3456;
#ifndef MK_COOP
#define MK_COOP 1
#endif

typedef unsigned short u16;
using bf16x8 = __attribute__((ext_vector_type(8))) short;
using s16x4  = __attribute__((ext_vector_type(4))) short;
using f32x4  = __attribute__((ext_vector_type(4))) float;
using f32x16 = __attribute__((ext_vector_type(16))) float;
using u32x4  = __attribute__((ext_vector_type(4))) unsigned;
using u32x2  = __attribute__((ext_vector_type(2))) unsigned;

constexpr int NTHR = 512;
constexpr int T_CTX = 4096, T_ALL = 20480;
constexpr int NPROJ = 6688, NPADW = 6912;
constexpr int LDS_BYTES = 135168;
constexpr float EPSF = 1e-6f;
constexpr float LAM_INIT = 0.2f;
#ifndef DBG_ST
#define DBG_ST 1
#endif

struct Params {
  const float *x_prompt, *x_sample, *cache_k, *cache_v, *state_ssd, *c, *c_ctx, *w_mod, *b_mod, *norm_g, *w_in,
      *lq1, *lk1, *lq2, *lk2, *subln_g, *conv_w, *conv_b, *dt_bias, *A_log, *D_skip, *ssd_norm_g, *w_out, *final_g;
  float* out;
  u16 *winT, *woutT, *qb, *kC, *kS, *vC, *vS, *zb, *xbc, *hb, *gb, *st;
  float *dtb, *modv, *rope, *misc, *cd, *ssqp, *ssq2p;
  unsigned* bar;
  int probe, pad_;
};

typedef __bf16 bf16v2 __attribute__((ext_vector_type(2)));
typedef float f32v2 __attribute__((ext_vector_type(2)));
__device__ __forceinline__ unsigned cvtpk(float lo, float hi) {
  f32v2 v = {lo, hi}; bf16v2 b = __builtin_convertvector(v, bf16v2); return __builtin_bit_cast(unsigned, b);
}
__device__ __forceinline__ u16 f2bf(float x) { __bf16 b = (__bf16)x; return __builtin_bit_cast(u16, b); }
__device__ __forceinline__ float bf2f(u16 x) { return __uint_as_float(((unsigned)x) << 16); }
__device__ __forceinline__ float bfs2f(short x) { return __uint_as_float(((unsigned)(u16)x) << 16); }
__device__ __forceinline__ float siluf(float v) { return v * __builtin_amdgcn_rcpf(1.f + __expf(-v)); }
__device__ __forceinline__ bf16x8 pack8(const float* v) {
  u32x4 w = {cvtpk(v[0], v[1]), cvtpk(v[2], v[3]), cvtpk(v[4], v[5]), cvtpk(v[6], v[7])};
  return *reinterpret_cast<bf16x8*>(&w);
}
__device__ __forceinline__ f32x4 mfma16(bf16x8 a, bf16x8 b, f32x4 c) {
  return __builtin_amdgcn_mfma_f32_16x16x32_bf16(a, b, c, 0, 0, 0);
}

__device__ void p0_mod_item(const Params& p, int i, char* smem) {
  const int tid = opaque_tid();
  float* sc = (float*)smem;
  float* red = sc + 5 * 1024;
  for (int idx = tid; idx < 5120; idx += NTHR) {
    int r = idx >> 10, k = idx & 1023;
    float v = (r == 0) ? p.c_ctx[k] : p.c[(r - 1) * 1024 + k];
    sc[idx] = v / (1.f + expf(-v));
  }
  __syncthreads();
  const int kg = tid >> 4, cq = tid & 15, c0 = i * 64;
  f32x4 a0 = {0, 0, 0, 0}, a1 = a0, a2 = a0, a3 = a0, a4 = a0;
  const float* w = p.w_mod + (long)(kg * 32) * 3072 + c0 + cq * 4;
#pragma unroll 8
  for (int k = 0; k < 32; ++k) {
    f32x4 wv = __builtin_nontemporal_load(reinterpret_cast<const f32x4*>(w + (long)k * 3072));
    int kk = kg * 32 + k;
    a0 += sc[kk] * wv; a1 += sc[1024 + kk] * wv; a2 += sc[2048 + kk] * wv; a3 += sc[3072 + kk] * wv; a4 += sc[4096 + kk] * wv;
  }
  *reinterpret_cast<f32x4*>(red + (kg * 5 + 0) * 64 + cq * 4) = a0; *reinterpret_cast<f32x4*>(red + (kg * 5 + 1) * 64 + cq * 4) = a1;
  *reinterpret_cast<f32x4*>(red + (kg * 5 + 2) * 64 + cq * 4) = a2; *reinterpret_cast<f32x4*>(red + (kg * 5 + 3) * 64 + cq * 4) = a3;
  *reinterpret_cast<f32x4*>(red + (kg * 5 + 4) * 64 + cq * 4) = a4;
  __syncthreads();
  if (tid < 320) {
    int r = tid >> 6, cc = tid & 63;
    float sum = p.b_mod[c0 + cc];
    for (int q = 0; q < 32; ++q) sum += red[(q * 5 + r) * 64 + cc];
    p.modv[r * 3072 + c0 + cc] = sum;
  }
  if (i == 0 && tid == 511) {
    float s1 = 0, s2 = 0;
    for (int k = 0; k < 64; ++k) { s1 += p.lq1[k] * p.lk1[k]; s2 += p.lq2[k] * p.lk2[k]; }
    p.misc[0] = expf(s1) - expf(s2) + LAM_INIT;
  }
}

__device__ void p0_transpose_item(const float* __restrict__ src, int ldsrc, int nvalid, u16* __restrict__ dst, int lddst,
                                  int n0, int k0, int kd0, const float* __restrict__ kscale, char* smem) {
  float* tile = (float*)smem;
  const int tid = opaque_tid();
  {
    int r = tid >> 3, cc = (tid & 7) * 8;
    float sc = 1.f;
    if (kscale != nullptr && (k0 + r) >= 1024) sc = kscale[k0 + r - 1024];
    float4 x0 = {0.f, 0.f, 0.f, 0.f}, x1 = {0.f, 0.f, 0.f, 0.f};
    if (n0 + cc < nvalid) {
      const float* sp = src + (long)(k0 + r) * ldsrc + n0 + cc;
      x0 = *reinterpret_cast<const float4*>(sp); x1 = *reinterpret_cast<const float4*>(sp + 4);
    }
    float* tp = tile + r * 65 + cc;
    tp[0] = x0.x * sc; tp[1] = x0.y * sc; tp[2] = x0.z * sc; tp[3] = x0.w * sc;
    tp[4] = x1.x * sc; tp[5] = x1.y * sc; tp[6] = x1.z * sc; tp[7] = x1.w * sc;
  }
  __syncthreads();
  {
    int n = tid >> 3, kk = (tid & 7) * 8;
    float v[8];
#pragma unroll
    for (int e = 0; e < 8; ++e) v[e] = tile[(kk + e) * 65 + n];
    *reinterpret_cast<bf16x8*>(dst + (long)(n0 + n) * lddst + kd0 + kk) = pack8(v);
  }
}

__device__ void p0_transpose4(const float* __restrict__ src, int ldsrc, int nvalid, u16* __restrict__ dst, int lddst,
                              int n0, int k0, int kd0, const float* __restrict__ kscale, char* smem) {
  float* tile = (float*)smem;
  const int tid = opaque_tid();
  const int r = tid >> 3, cc = (tid & 7) * 8;
  float4 x0[4], x1[4]; float sc[4];
#pragma unroll
  for (int j = 0; j < 4; ++j) {
    const int kr = k0 + j * 64 + r;
    sc[j] = (kscale != nullptr && kr >= 1024) ? kscale[kr - 1024] : 1.f;
    x0[j] = float4{0.f, 0.f, 0.f, 0.f}; x1[j] = x0[j];
    if (n0 + cc < nvalid) {
      const float* sp = src + (long)kr * ldsrc + n0 + cc;
      const f32x4 y0 = __builtin_nontemporal_load(reinterpret_cast<const f32x4*>(sp)), y1 = __builtin_nontemporal_load(reinterpret_cast<const f32x4*>(sp + 4));
      x0[j] = float4{y0[0], y0[1], y0[2], y0[3]}; x1[j] = float4{y1[0], y1[1], y1[2], y1[3]};
    }
  }
#pragma unroll
  for (int j = 0; j < 4; ++j) {
    float* tp = tile + j * 4160 + r * 65 + cc;
    tp[0] = x0[j].x * sc[j]; tp[1] = x0[j].y * sc[j]; tp[2] = x0[j].z * sc[j]; tp[3] = x0[j].w * sc[j];
    tp[4] = x1[j].x * sc[j]; tp[5] = x1[j].y * sc[j]; tp[6] = x1[j].z * sc[j]; tp[7] = x1[j].w * sc[j];
  }
  __syncthreads();
  const int n = tid >> 3, kk = (tid & 7) * 8;
#pragma unroll
  for (int j = 0; j < 4; ++j) {
    float v[8];
#pragma unroll
    for (int e = 0; e < 8; ++e) v[e] = tile[j * 4160 + (kk + e) * 65 + n];
    *reinterpret_cast<bf16x8*>(dst + (long)(n0 + n) * lddst + kd0 + j * 64 + kk) = pack8(v);
  }
}

__device__ void p0_rope_item(const Params& p) {
  const int tid = opaque_tid();
  for (int idx = tid; idx < 1024; idx += NTHR) {
    int pos = idx >> 4, i = idx & 15;
    double inv = 1.0;
    for (int q = 0; q < i; ++q) inv *= 0.56234132519034908;
    double ang = (double)pos * inv;
    double kq = rint(ang * 0.63661977236758134);
    double r = ang - kq * 1.5707963267948966 - kq * 6.123233995736766e-17;
    double r2 = r * r;
    double s = r * (1.0 + r2 * (-1.0 / 6 + r2 * (1.0 / 120 + r2 * (-1.0 / 5040 + r2 * (1.0 / 362880 + r2 * (-1.0 / 39916800 + r2 * (1.0 / 6227020800.0 + r2 * (-1.0 / 1307674368000.0))))))));
    double cs = 1.0 + r2 * (-0.5 + r2 * (1.0 / 24 + r2 * (-1.0 / 720 + r2 * (1.0 / 40320 + r2 * (-1.0 / 3628800 + r2 * (1.0 / 479001600 + r2 * (-1.0 / 87178291200.0 + r2 * (1.0 / 20922789888000.0))))))));
    long kk = (long)kq; int qd = (int)(kk & 3);
    double so, co;
    if (qd == 0) { so = s; co = cs; } else if (qd == 1) { so = cs; co = -s; } else if (qd == 2) { so = -s; co = -cs; } else { so = -cs; co = s; }
    p.rope[idx * 2 + 0] = (float)co;
    p.rope[idx * 2 + 1] = (float)so;
  }
}

__device__ void phase0_pre_item(const Params& p, int i, char* smem) {
  const int tid = opaque_tid();
  constexpr int N_WIN = 108 * 4, N_WOUT = 16 * 8, N_CACHE = 256, N_ROPE = 1;
    if (i < N_WIN) {
      int nt = i >> 2, kq = i & 3;
      p0_transpose4(p.w_in, NPROJ, NPROJ, p.winT, 1024, nt * 64, kq * 256, kq * 256, nullptr, smem);
      __syncthreads();
    } else if ((i -= N_WIN) < N_WOUT) {
      int nt = i >> 3, kq = i & 7;
      p0_transpose4(p.w_out, 1024, 1024, p.woutT + (kq >= 4 ? 1024 * 1024 : 0), 1024, nt * 64, kq * 256, (kq & 3) * 256, p.ssd_norm_g, smem);
      __syncthreads();
    } else if ((i -= N_WOUT) < N_CACHE) {
      float4 xa[4], xb[4];
#pragma unroll
      for (int j = 0; j < 4; ++j) {
        const int piece = i * 4 + j, tens = piece >> 9, blk = piece & 511;
        const float* src = (tens ? p.cache_v : p.cache_k) + (long)blk * 4096 + tid * 8;
        { const f32x4 y0 = __builtin_nontemporal_load(reinterpret_cast<const f32x4*>(src)), y1 = __builtin_nontemporal_load(reinterpret_cast<const f32x4*>(src + 4));
          xa[j] = float4{y0[0], y0[1], y0[2], y0[3]}; xb[j] = float4{y1[0], y1[1], y1[2], y1[3]}; }
      }
#pragma unroll
      for (int j = 0; j < 4; ++j) {
        const int piece = i * 4 + j, tens = piece >> 9, blk = piece & 511;
        const long e0 = (long)blk * 4096 + tid * 8;
        const int b = (int)(e0 >> 19); const long rem = e0 & ((1 << 19) - 1);
        u16* dst = (tens ? p.vS : p.kS) + ((long)b * 4608 + 4096) * 1024 + rem;
        float v[8] = {xa[j].x, xa[j].y, xa[j].z, xa[j].w, xb[j].x, xb[j].y, xb[j].z, xb[j].w};
        *reinterpret_cast<bf16x8*>(dst) = pack8(v);
      }
    } else if ((i -= N_CACHE) < N_ROPE) {
      p0_rope_item(p);
    }
}
__device__ void phase0(const Params& p, char* smem) {
  constexpr int N_PRE = 108 * 4 + 16 * 8 + 256 + 1;
  if (gridDim.x == 256) {
    if (blockIdx.x < 48) { p0_mod_item(p, blockIdx.x, smem); __syncthreads(); }
    else { for (int i = blockIdx.x - 48; i < N_PRE; i += 208) phase0_pre_item(p, i, smem); }
  } else {
    for (int it = blockIdx.x; it < 48 + N_PRE; it += gridDim.x) {
      if (it < 48) { p0_mod_item(p, it, smem); __syncthreads(); } else phase0_pre_item(p, it - 48, smem);
    }
  }
}

__device__ void phase1(const Params& p, char* smem) {
  const int tid = opaque_tid(), lane = tid & 63, wid = tid >> 6;
  (void)tid;
  for (int i = blockIdx.x; i < T_ALL / 32; i += gridDim.x) {
      float4 v[4][4]; float ss[4];
#pragma unroll
      for (int rr = 0; rr < 4; ++rr) {
        const int t = i * 32 + rr * 8 + wid;
        const float* xr = (t < T_CTX) ? p.x_prompt + (long)t * 1024 : p.x_sample + (long)(t - T_CTX) * 1024;
#pragma unroll
        for (int q = 0; q < 4; ++q) v[rr][q] = *reinterpret_cast<const float4*>(xr + q * 256 + lane * 4);
      }
#pragma unroll
      for (int rr = 0; rr < 4; ++rr) {
        float a = 0.f;
#pragma unroll
        for (int q = 0; q < 4; ++q) a += v[rr][q].x * v[rr][q].x + v[rr][q].y * v[rr][q].y + v[rr][q].z * v[rr][q].z + v[rr][q].w * v[rr][q].w;
#pragma unroll
        for (int o = 32; o >= 1; o >>= 1) a += __shfl_xor(a, o);
        ss[rr] = rsqrtf(a * (1.f / 1024.f) + EPSF);
      }
#pragma unroll
      for (int rr = 0; rr < 4; ++rr) {
        const int t = i * 32 + rr * 8 + wid;
        const int mr = (t < T_CTX) ? 0 : 1 + ((t - T_CTX) >> 12);
        const float rs = ss[rr];
#pragma unroll
        for (int q = 0; q < 4; ++q) {
          int col = q * 256 + lane * 4;
          float4 g = *reinterpret_cast<const float4*>(p.norm_g + col);
          float4 sh = *reinterpret_cast<const float4*>(p.modv + mr * 3072 + col);
          float4 sc = *reinterpret_cast<const float4*>(p.modv + mr * 3072 + 1024 + col);
          float h0 = v[rr][q].x * rs * g.x * (1.f + sc.x) + sh.x;
          float h1 = v[rr][q].y * rs * g.y * (1.f + sc.y) + sh.y;
          float h2 = v[rr][q].z * rs * g.z * (1.f + sc.z) + sh.z;
          float h3 = v[rr][q].w * rs * g.w * (1.f + sc.w) + sh.w;
          u32x2 w = {cvtpk(h0, h1), cvtpk(h2, h3)};
          *reinterpret_cast<u32x2*>(p.hb + (long)t * 1024 + col) = w;
        }
      }
  }
}

constexpr int G_LD = 72;
constexpr int G_ABYTES = 256 * G_LD * 2, G_BBYTES = 128 * G_LD * 2, G_STAGE = G_ABYTES + G_BBYTES;

__device__ __forceinline__ void gemm_kloop(f32x4 (&acc)[4][4], const u16* __restrict__ A, int lda,
                                           const u16* __restrict__ B, int ldb, int nk, char* smem) {
  const int tid = opaque_tid(), lane = tid & 63, wid = __builtin_amdgcn_readfirstlane(tid >> 6), wm = wid >> 1, wn = wid & 1, fr = lane & 15, fq = lane >> 4;
  bf16x8 ra[4], rb[2];
  const int lr = tid >> 3, lc = (tid & 7) * 8;
  __syncthreads();
#pragma unroll
  for (int i = 0; i < 4; ++i) ra[i] = *reinterpret_cast<const bf16x8*>(A + (long)(lr + i * 64) * lda + lc);
#pragma unroll
  for (int i = 0; i < 2; ++i) rb[i] = *reinterpret_cast<const bf16x8*>(B + (long)(lr + i * 64) * ldb + lc);
  {
    u16* As = (u16*)smem; u16* Bs = (u16*)(smem + G_ABYTES);
#pragma unroll
    for (int i = 0; i < 4; ++i) *reinterpret_cast<bf16x8*>(As + (lr + i * 64) * G_LD + lc) = ra[i];
#pragma unroll
    for (int i = 0; i < 2; ++i) *reinterpret_cast<bf16x8*>(Bs + (lr + i * 64) * G_LD + lc) = rb[i];
  }
  __syncthreads();
  for (int kt = 0; kt < nk; ++kt) {
    if (kt + 1 < nk) {
#pragma unroll
      for (int i = 0; i < 4; ++i) ra[i] = *reinterpret_cast<const bf16x8*>(A + (long)(lr + i * 64) * lda + (kt + 1) * 64 + lc);
#pragma unroll
      for (int i = 0; i < 2; ++i) rb[i] = *reinterpret_cast<const bf16x8*>(B + (long)(lr + i * 64) * ldb + (kt + 1) * 64 + lc);
    }
    const u16* As = (const u16*)(smem + (kt & 1) * G_STAGE);
    const u16* Bs = (const u16*)(smem + (kt & 1) * G_STAGE + G_ABYTES);
#pragma unroll
    for (int ks = 0; ks < 2; ++ks) {
      bf16x8 a[4], b[4];
#pragma unroll
      for (int mi = 0; mi < 4; ++mi) a[mi] = *reinterpret_cast<const bf16x8*>(As + (wm * 64 + mi * 16 + fr) * G_LD + ks * 32 + fq * 8);
#pragma unroll
      for (int ni = 0; ni < 4; ++ni) b[ni] = *reinterpret_cast<const bf16x8*>(Bs + (wn * 64 + ni * 16 + fr) * G_LD + ks * 32 + fq * 8);
#pragma unroll
      for (int mi = 0; mi < 4; ++mi)
#pragma unroll
        for (int ni = 0; ni < 4; ++ni) acc[mi][ni] = mfma16(a[mi], b[ni], acc[mi][ni]);
    }
    if (kt + 1 < nk) {
      u16* As2 = (u16*)(smem + ((kt + 1) & 1) * G_STAGE); u16* Bs2 = (u16*)(smem + ((kt + 1) & 1) * G_STAGE + G_ABYTES);
#pragma unroll
      for (int i = 0; i < 4; ++i) *reinterpret_cast<bf16x8*>(As2 + (lr + i * 64) * G_LD + lc) = ra[i];
#pragma unroll
      for (int i = 0; i < 2; ++i) *reinterpret_cast<bf16x8*>(Bs2 + (lr + i * 64) * G_LD + lc) = rb[i];
    }
    __syncthreads();
  }
}

namespace pg8 {
#define PG8_LAS __attribute__((address_space(3)))
typedef unsigned short bf16_t;
typedef short bf16x8 __attribute__((ext_vector_type(8)));
typedef float f32x4 __attribute__((ext_vector_type(4)));
typedef unsigned u32x4 __attribute__((ext_vector_type(4)));
constexpr int BM = 256, BK = 64, HALF = 128, HTB = HALF * BK * 2  , STAGE_BYTES = 8 * HTB, NXCD = 8, WGM = 4;

__host__ __device__ __forceinline__ int lds_byte(int r, int c) { const int st = (r >> 4) * 2 + (c >> 5), rr = r & 15, cc = c & 31, ob = rr * 64 + cc * 2; return st * 1024 + (ob ^ (((ob >> 9) & 1) << 5)); }
__host__ __device__ __forceinline__ void stage_rc(int b, int& R, int& C) { const int st = b / 1024, sb = b % 1024, swz = sb ^ (((sb >> 9) & 1) << 5); R = (st >> 1) * 16 + swz / 64; C = (st & 1) * 32 + (swz % 64) / 2; }
__host__ __device__ __forceinline__ int perm32(int rho) { const int n = rho >> 4, i = rho & 15; return 8 * (i >> 2) + 4 * n + (i & 3); }

struct Unit { int pm, pn, seg, split; };
struct Gemm { const bf16_t* A; const bf16_t* Bt; int M, N, K; const bf16_t* A2; const bf16_t* Bt2; };

struct StaticOrder {
    int nM, nN, nwg, G, c;
    __host__ __device__ void init(int M, int N, int G_, int c_) { nM = M / BM; nN = N / BM; nwg = nM * nN; G = G_; c = c_; }
    __host__ __device__ bool tile_at(long L, Unit& u) const {
        if (L >= nwg) return false;
        int wgid = (int)L; { const int q = nwg / NXCD, r = nwg % NXCD, xcd = wgid % NXCD, off = wgid / NXCD; wgid = (xcd < r ? xcd * (q + 1) : r * (q + 1) + (xcd - r) * q) + off; }
        const int nig = WGM * nN, gid = wgid / nig, fm = gid * WGM, gsz = (nM - fm) < WGM ? (nM - fm) : WGM;
        u.pm = fm + ((wgid % nig) % gsz); u.pn = (wgid % nig) / gsz; u.seg = 0; u.split = 0; return true;
    }
    __host__ __device__ bool next(int i, Unit& u) const { return tile_at((long)i * G + c, u); }
    __device__ __forceinline__ void a_ready(const Unit&) const {}
    __device__ __forceinline__ void done(const Unit&) const {}
};
template <class Epi, class Sched, bool STAMP = false>
__device__ __forceinline__ void gemm_phase(PG8_LAS unsigned char* lds, const Gemm g, const Sched& S, const Epi& E, unsigned long long* stamps) {
    const int tid = opaque_tid(), wid = __builtin_amdgcn_readfirstlane(tid >> 6), lane = tid & 63, wr = wid >> 2, wc = wid & 3, fr = lane & 15, fq = lane >> 4;
    const int K = g.K, nt = K / BK;
    int ts_lo = 0, ts_hi = 0, nts = 0; const unsigned long long rt_entry = STAMP ? (unsigned long long)wall_clock64() : 0ull;
#define PG8_STAMP() do { if (STAMP && wid == 0 && nts < 64) { const unsigned long long _c = (unsigned long long)clock64(); \
        ts_lo = (lane == nts) ? (int)(unsigned)_c : ts_lo; ts_hi = (lane == nts) ? (int)(unsigned)(_c >> 32) : ts_hi; ++nts; } } while (0)
    PG8_STAMP();
    unsigned voffA[2], voffB[2];
#pragma unroll
    for (int i = 0; i < 2; ++i) { int R, C; stage_rc(tid * 16 + i * 8192, R, C); const int Rb = Epi::PERM ? ((R & ~31) + perm32(R & 31)) : R;
        voffA[i] = (unsigned)(R * K + C) * 2u; voffB[i] = (unsigned)(Rb * K + C) * 2u; }
    const size_t kstep = (size_t)(BK * 2);
    const size_t hstep = (size_t)HALF * K * 2;
    const size_t tstep = 2 * hstep;
    const unsigned ldsw = (unsigned)wid * 1024u;
    const int aoff = lds_byte(wr * 64 + fr, fq * 8), boff = lds_byte(wc * 32 + fr, fq * 8);
#define PG8_SA(b, h) (((b) * 2 + (h)) * HTB)
#define PG8_SB(b, h) ((4 + (b) * 2 + (h)) * HTB)
#define PG8_STAGE(bufoff, gbase, voff) do { _Pragma("unroll") for (int _i = 0; _i < 2; ++_i) \
        __builtin_amdgcn_global_load_lds((const unsigned*)((const char*)(gbase) + (voff)[_i]), (PG8_LAS unsigned*)(lds + (bufoff) + ldsw + _i * 8192), 16, 0, 0); } while (0)
#define PG8_LDA(dst, b, h) do { _Pragma("unroll") for (int m = 0; m < 4; ++m) _Pragma("unroll") for (int k = 0; k < 2; ++k) dst[m][k] = *(const PG8_LAS bf16x8*)(lds + PG8_SA(b, h) + aoff + m * 2048 + k * 1024); } while (0)
#define PG8_LDB(dst, b, h) do { _Pragma("unroll") for (int n = 0; n < 2; ++n) _Pragma("unroll") for (int k = 0; k < 2; ++k) dst[n][k] = *(const PG8_LAS bf16x8*)(lds + PG8_SB(b, h) + boff + n * 2048 + k * 1024); } while (0)
#define PG8_MMA(ai, bj, At, Bt) do { __builtin_amdgcn_s_setprio(1); _Pragma("unroll") for (int m = 0; m < 4; ++m) _Pragma("unroll") for (int n = 0; n < 2; ++n) _Pragma("unroll") for (int k = 0; k < 2; ++k) \
        acc[ai][bj][m][n] = __builtin_amdgcn_mfma_f32_16x16x32_bf16(Bt[n][k], At[m][k], acc[ai][bj][m][n], 0, 0, 0); __builtin_amdgcn_s_setprio(0); } while (0)
#define PG8_WAIT_V(n) asm volatile("s_waitcnt vmcnt(" #n ")" ::: "memory")
#define PG8_WAIT_L(n) asm volatile("s_waitcnt lgkmcnt(" #n ")" ::: "memory")
#define PG8_BAR __builtin_amdgcn_s_barrier()
#define PG8_SCHED __builtin_amdgcn_sched_barrier(0)
    Unit cur, nxt; int ui = 0;
    if (!S.next(0, cur)) return;
    f32x4 acc[2][2][4][2];
#pragma unroll
    for (int a = 0; a < 2; ++a)
#pragma unroll
        for (int b = 0; b < 2; ++b)
#pragma unroll
            for (int m = 0; m < 4; ++m)
#pragma unroll
                for (int n = 0; n < 2; ++n) acc[a][b][m][n] = (f32x4){0.f, 0.f, 0.f, 0.f};
    bf16x8 At[4][2], B0[2][2], B1[2][2];
    const char* cA = (const char*)(cur.seg ? g.A2 : g.A) + (size_t)cur.pm * tstep; const char* cB = (const char*)(cur.seg ? g.Bt2 : g.Bt) + (size_t)cur.pn * tstep;
    S.a_ready(cur);
    PG8_STAGE(PG8_SB(0, 0), cB, voffB); PG8_STAGE(PG8_SA(0, 0), cA, voffA); PG8_STAGE(PG8_SB(0, 1), cB + hstep, voffB); PG8_STAGE(PG8_SA(0, 1), cA + hstep, voffA);
    if (wr == 1) PG8_BAR;
    PG8_WAIT_V(4); PG8_BAR;
    PG8_STAGE(PG8_SB(1, 0), cB + kstep, voffB); PG8_STAGE(PG8_SA(1, 0), cA + kstep, voffA); PG8_STAGE(PG8_SB(1, 1), cB + hstep + kstep, voffB);
    PG8_WAIT_V(6); PG8_BAR;
    PG8_STAMP();
    for (;;) {
        const bool has_next = S.next(ui + 1, nxt);
        const char* nA = has_next ? (const char*)(nxt.seg ? g.A2 : g.A) + (size_t)nxt.pm * tstep : cA; const char* nB = has_next ? (const char*)(nxt.seg ? g.Bt2 : g.Bt) + (size_t)nxt.pn * tstep : cB;
        for (int t = 0; t < nt; t += 2) {
            const bool last = (t == nt - 2);
            const char* a1 = cA + (size_t)(t + 1) * kstep;
            const char* a2 = last ? nA : cA + (size_t)(t + 2) * kstep; const char* b2 = last ? nB : cB + (size_t)(t + 2) * kstep;
            const char* a3 = a2 + kstep; const char* b3 = b2 + kstep;
            if (last && has_next) S.a_ready(nxt);
            PG8_LDB(B0, 0, 0); PG8_SCHED; PG8_LDA(At, 0, 0); PG8_STAGE(PG8_SA(1, 1), a1 + hstep, voffA);
            PG8_WAIT_L(8); PG8_BAR; PG8_WAIT_L(0); PG8_MMA(0, 0, At, B0); PG8_BAR; PG8_SCHED;
            PG8_LDB(B1, 0, 1); PG8_STAGE(PG8_SB(0, 0), b2, voffB);
            PG8_BAR; PG8_WAIT_L(0); PG8_MMA(0, 1, At, B1); PG8_BAR;
            PG8_LDA(At, 0, 1); PG8_STAGE(PG8_SA(0, 0), a2, voffA);
            PG8_BAR; PG8_WAIT_L(0); PG8_MMA(1, 0, At, B0); PG8_BAR; PG8_SCHED;
            PG8_STAGE(PG8_SB(0, 1), b2 + hstep, voffB);
            PG8_WAIT_V(6); PG8_BAR; PG8_MMA(1, 1, At, B1); PG8_BAR;
            PG8_LDB(B0, 1, 0); PG8_SCHED; PG8_LDA(At, 1, 0); PG8_STAGE(PG8_SA(0, 1), a2 + hstep, voffA);
            PG8_WAIT_L(8); PG8_BAR; PG8_WAIT_L(0); PG8_MMA(0, 0, At, B0); PG8_BAR; PG8_SCHED;
            PG8_LDB(B1, 1, 1); PG8_STAGE(PG8_SB(1, 0), b3, voffB);
            PG8_BAR; PG8_WAIT_L(0); PG8_MMA(0, 1, At, B1); PG8_BAR;
            PG8_LDA(At, 1, 1); PG8_STAGE(PG8_SA(1, 0), a3, voffA);
            PG8_BAR; PG8_WAIT_L(0); PG8_MMA(1, 0, At, B0); PG8_BAR; PG8_SCHED;
            PG8_STAGE(PG8_SB(1, 1), b3 + hstep, voffB);
            PG8_WAIT_V(6); PG8_BAR; PG8_MMA(1, 1, At, B1); PG8_BAR;
        }
        PG8_STAMP();
        if constexpr (!Epi::AFTER_DRAIN) { E(acc, cur, wr, wc, fr, fq); S.done(cur); }
        PG8_STAMP();
        if (!has_next) break;
        if (!(Epi::KEEP && cur.seg == 0))
#pragma unroll
        for (int a = 0; a < 2; ++a)
#pragma unroll
            for (int b = 0; b < 2; ++b)
#pragma unroll
                for (int m = 0; m < 4; ++m)
#pragma unroll
                    for (int n = 0; n < 2; ++n) acc[a][b][m][n] = (f32x4){0.f, 0.f, 0.f, 0.f};
        cur = nxt; cA = nA; cB = nB; ++ui;
    }
    PG8_WAIT_V(0);
    if (wr == 0) PG8_BAR;
    PG8_BAR;
    if constexpr (Epi::AFTER_DRAIN) { E.fused(acc, cur, wr, wc, fr, fq, lds, wid, lane); S.done(cur); }
    PG8_STAMP();
    if (STAMP && wid == 0) { stamps[lane] = lane < nts ? (((unsigned long long)(unsigned)ts_hi << 32) | (unsigned)ts_lo) : 0ull;
        if (lane == 62) stamps[62] = rt_entry; if (lane == 63) stamps[63] = (unsigned long long)wall_clock64(); }
#undef PG8_STAMP
#undef PG8_SA
#undef PG8_SB
#undef PG8_STAGE
#undef PG8_LDA
#undef PG8_LDB
#undef PG8_MMA
#undef PG8_WAIT_V
#undef PG8_WAIT_L
#undef PG8_BAR
#undef PG8_SCHED
}
}
template <int SEG> __device__ __forceinline__ void epi_proj_seg(const Params& p, const f32x4 (&acc)[2][2][4][2], int m0, int n0, int wr, int wc, int fr, int fq) {
  const bool is_ctx = (m0 < T_CTX);
  const bool do_rope = (SEG <= 1) && !is_ctx;
#pragma unroll
  for (int ai = 0; ai < 2; ++ai)
#pragma unroll
    for (int m = 0; m < 4; ++m) {
      const int t = m0 + ai * 128 + wr * 64 + m * 16 + fr;
      const int ts = t - T_CTX, bsm = ts >> 12, tl = ts & 4095;
      f32x4 rc[4];
      if (do_rope) {
        const int pos = (wc & 1) ? (tl & 63) : (tl >> 6);
        const f32x4* rp = reinterpret_cast<const f32x4*>(p.rope + (pos * 16 + 8 * (fq & 1)) * 2);
        rc[0] = rp[0]; rc[1] = rp[1]; rc[2] = rp[2]; rc[3] = rp[3];
      }
#pragma unroll
      for (int bj = 0; bj < 2; ++bj) {
        f32x4 v0 = acc[ai][bj][m][0], v1 = acc[ai][bj][m][1];
        const int n = n0 + bj * 128 + wc * 32 + 8 * fq;
        if (do_rope) {
          const float sgn = (fq < 2) ? -1.f : 1.f;
#pragma unroll
          for (int e = 0; e < 4; ++e) {
            float o0 = __shfl_xor(v0[e], 32), o1 = __shfl_xor(v1[e], 32);
            float c0 = rc[e >> 1][(e & 1) * 2], s0 = rc[e >> 1][(e & 1) * 2 + 1];
            float c1 = rc[2 + (e >> 1)][(e & 1) * 2], s1 = rc[2 + (e >> 1)][(e & 1) * 2 + 1];
            v0[e] = v0[e] * c0 + sgn * o0 * s0;
            v1[e] = v1[e] * c1 + sgn * o1 * s1;
          }
        }
        if (SEG == 3 || SEG == 4) {
#pragma unroll
          for (int e = 0; e < 4; ++e) { v0[e] = siluf(v0[e]); v1[e] = siluf(v1[e]); }
        }
        if (SEG == 6) {
          if (bj == 0 && wc == 0) {
            float* fo = p.dtb + (long)t * 32 + 8 * fq;
            *reinterpret_cast<f32x4*>(fo) = v0; *reinterpret_cast<f32x4*>(fo + 4) = v1;
          }
        } else {
          u32x4 w = {cvtpk(v0[0], v0[1]), cvtpk(v0[2], v0[3]), cvtpk(v1[0], v1[1]), cvtpk(v1[2], v1[3])};
          u16* dst;
          if (SEG == 0) dst = p.qb + (long)t * 1024 + n;
          else if (SEG == 1 || SEG == 2) {
            const int c = n - SEG * 1024;
            if (is_ctx) {
              dst = (SEG == 1 ? p.kC : p.vC) + (long)t * 1024 + c;
              float* fo = p.out + (SEG == 1 ? 20971520L : 25165824L) + (long)t * 1024 + c;
              *reinterpret_cast<f32x4*>(fo) = v0; *reinterpret_cast<f32x4*>(fo + 4) = v1;
            } else dst = (SEG == 1 ? p.kS : p.vS) + ((long)bsm * 4608 + tl) * 1024 + c;
          } else if (SEG == 3) dst = p.gb + (long)t * 1024 + (n - 3072);
          else if (SEG == 4) dst = p.zb + (long)t * 1024 + (n - 4096);
          else dst = p.xbc + (long)t * 1536 + (n - 5120);
          *reinterpret_cast<u32x4*>(dst) = w;
        }
      }
    }
}
struct EpiProj {
  static constexpr bool PERM = true, AFTER_DRAIN = false, KEEP = false;
  const Params& p;
  __device__ __forceinline__ void operator()(const f32x4 (&acc)[2][2][4][2], const pg8::Unit& u, int wr, int wc, int fr, int fq) const {
    const int m0 = u.pm * 256, n0 = u.pn * 256;
    const int seg = (n0 < 5120) ? (n0 >> 10) : (n0 < 6656 ? 5 : 6);
    switch (seg) {
      case 0: epi_proj_seg<0>(p, acc, m0, n0, wr, wc, fr, fq); break;
      case 1: epi_proj_seg<1>(p, acc, m0, n0, wr, wc, fr, fq); break;
      case 2: epi_proj_seg<2>(p, acc, m0, n0, wr, wc, fr, fq); break;
      case 3: epi_proj_seg<3>(p, acc, m0, n0, wr, wc, fr, fq); break;
      case 4: epi_proj_seg<4>(p, acc, m0, n0, wr, wc, fr, fq); break;
      case 5: epi_proj_seg<5>(p, acc, m0, n0, wr, wc, fr, fq); break;
      default: epi_proj_seg<6>(p, acc, m0, n0, wr, wc, fr, fq); break;
    }
  }
};

__device__ void phase2(const Params& p, char* smem) {
  pg8::StaticOrder S; S.init(T_ALL, NPADW, (int)gridDim.x, (int)blockIdx.x);
  pg8::Gemm g{p.hb, p.winT, T_ALL, NPADW, 1024, p.hb, p.winT};
  EpiProj E{p};
  pg8::gemm_phase<EpiProj, pg8::StaticOrder, false>((PG8_LAS unsigned char*)smem, g, S, E, nullptr);
  __syncthreads();
}

constexpr int SHM_V = 64 * 128 * 2, SHM_K = 64 * 128 * 2;
constexpr float ASCALE = 0.125f;
constexpr float ATHR = 8.f;
#define KSWZ(row, colB) ((row) * 256 + ((colB) ^ (((row) & 7) << 4)))
#define SBAR() __builtin_amdgcn_sched_barrier(0)
__device__ __forceinline__ int crow(int r, int hi) { return (r & 3) + 8 * (r >> 2) + 4 * hi; }

__device__ __forceinline__ void partialSM(f32x16& p0, f32x16& p1, float& m_reg, float& mn, float& alpha) {
  constexpr float C = ASCALE * 1.4426950408889634f;
  float pmax = p0[0];
#pragma unroll
  for (int r = 1; r < 16; ++r) pmax = fmaxf(pmax, p0[r]);
#pragma unroll
  for (int r = 0; r < 16; ++r) pmax = fmaxf(pmax, p1[r]);
  { auto rr = __builtin_amdgcn_permlane32_swap(__float_as_uint(pmax), __float_as_uint(pmax), false, false);
    pmax = fmaxf(__uint_as_float(rr[0]), __uint_as_float(rr[1])); }
  if (__builtin_expect(__all(pmax - m_reg <= ATHR / ASCALE), 1)) { mn = m_reg; alpha = 1.f; }
  else { mn = fmaxf(m_reg, pmax); alpha = __builtin_amdgcn_exp2f((m_reg - mn) * C); m_reg = mn; }
  float mnC = -mn * C;
#pragma unroll
  for (int r = 0; r < 16; ++r) p0[r] = fmaf(p0[r], C, mnC);
#pragma unroll
  for (int r = 0; r < 16; ++r) p1[r] = fmaf(p1[r], C, mnC);
#pragma unroll
  for (int r = 0; r < 16; ++r) p0[r] = __builtin_amdgcn_exp2f(p0[r]);
}
__device__ __forceinline__ void finishSM(f32x16& p0, f32x16& p1, float alpha, float& l_reg, bf16x8& pa0, bf16x8& pa1, bf16x8& pa2, bf16x8& pa3) {
#pragma unroll
  for (int r = 0; r < 16; ++r) p1[r] = __builtin_amdgcn_exp2f(p1[r]);
  float ps = 0;
#pragma unroll
  for (int r = 0; r < 16; ++r) ps += p0[r];
#pragma unroll
  for (int r = 0; r < 16; ++r) ps += p1[r];
  { auto rr = __builtin_amdgcn_permlane32_swap(__float_as_uint(ps), __float_as_uint(ps), false, false);
    ps = __uint_as_float(rr[0]) + __uint_as_float(rr[1]); }
  l_reg = l_reg * alpha + ps;
#define PK4(P, BASE, OUT) do { unsigned a0 = cvtpk(P[BASE + 0], P[BASE + 1]), a1 = cvtpk(P[BASE + 2], P[BASE + 3]);   \
    unsigned b0 = cvtpk(P[BASE + 4], P[BASE + 5]), b1 = cvtpk(P[BASE + 6], P[BASE + 7]);                              \
    auto r0 = __builtin_amdgcn_permlane32_swap(a0, b0, false, false); auto r1 = __builtin_amdgcn_permlane32_swap(a1, b1, false, false); \
    u32x4 w = {r0[0], r1[0], r0[1], r1[1]}; OUT = *reinterpret_cast<bf16x8*>(&w); } while (0)
  PK4(p0, 0, pa0); PK4(p0, 8, pa1); PK4(p1, 0, pa2); PK4(p1, 8, pa3);
#undef PK4
}
__device__ __forceinline__ void qkt(f32x16& p0, f32x16& p1, const u16* Ks, const bf16x8* qr, int r32, int hi, int comp) {
  p0 = f32x16{}; p1 = f32x16{};
#pragma unroll
  for (int d0 = 0; d0 < 4; ++d0) { int cb = (comp * 64 + d0 * 16 + hi * 8) * 2;
    bf16x8 b0 = *reinterpret_cast<const bf16x8*>((const char*)Ks + KSWZ(r32, cb));
    bf16x8 b1 = *reinterpret_cast<const bf16x8*>((const char*)Ks + KSWZ(32 + r32, cb));
    bf16x8 q = qr[d0];
    p0 = __builtin_amdgcn_mfma_f32_32x32x16_bf16(b0, q, p0, 0, 0, 0);
    p1 = __builtin_amdgcn_mfma_f32_32x32x16_bf16(b1, q, p1, 0, 0, 0); }
}
__device__ __forceinline__ int v_st(int k, int c) { const int kk = (k & ~0xC) | ((k & 4) << 1) | ((k & 8) >> 1); return ((kk >> 3) * 4 + (c >> 5)) * 512 + ((kk & 7) * 32 + (c & 31)) * 2; }
__device__ __forceinline__ int v_rd_base(int lane) { return ((lane & 3) << 3) | (((lane >> 2) & 3) << 6) | (((lane >> 4) & 1) << 5) | (((lane >> 5) & 1) << 8); }
constexpr int v_rd_off(int d0, int ks, int half) { return d0 * 512 + ks * 4096 + half * 2048; }
template <int OFF> __device__ __forceinline__ s16x4 tr_read(int vb) {
  s16x4 r; asm volatile("ds_read_b64_tr_b16 %0, %1 offset:%2" : "=&v"(r) : "v"(vb), "i"(OFF) : "memory"); return r;
}
template <int D0> __device__ __forceinline__ void pv_one(f32x16& od, int vb, bf16x8 pa0, bf16x8 pa1, bf16x8 pa2, bf16x8 pa3) {
  const s16x4 l0 = tr_read<v_rd_off(D0, 0, 0)>(vb), h0 = tr_read<v_rd_off(D0, 0, 1)>(vb), l1 = tr_read<v_rd_off(D0, 1, 0)>(vb), h1 = tr_read<v_rd_off(D0, 1, 1)>(vb);
  const s16x4 l2 = tr_read<v_rd_off(D0, 2, 0)>(vb), h2 = tr_read<v_rd_off(D0, 2, 1)>(vb), l3 = tr_read<v_rd_off(D0, 3, 0)>(vb), h3 = tr_read<v_rd_off(D0, 3, 1)>(vb);
  asm volatile("s_waitcnt lgkmcnt(0)" ::: "memory"); SBAR();
#define PK(L, H) (bf16x8){L[0], L[1], L[2], L[3], H[0], H[1], H[2], H[3]}
  od = __builtin_amdgcn_mfma_f32_32x32x16_bf16(pa0, PK(l0, h0), od, 0, 0, 0);
  od = __builtin_amdgcn_mfma_f32_32x32x16_bf16(pa1, PK(l1, h1), od, 0, 0, 0);
  od = __builtin_amdgcn_mfma_f32_32x32x16_bf16(pa2, PK(l2, h2), od, 0, 0, 0);
  od = __builtin_amdgcn_mfma_f32_32x32x16_bf16(pa3, PK(l3, h3), od, 0, 0, 0);
#undef PK
}
__device__ __forceinline__ void pv_d0(f32x16* o, int vb, bf16x8 pa0, bf16x8 pa1, bf16x8 pa2, bf16x8 pa3) {
  pv_one<0>(o[0], vb, pa0, pa1, pa2, pa3); pv_one<1>(o[1], vb, pa0, pa1, pa2, pa3); pv_one<2>(o[2], vb, pa0, pa1, pa2, pa3); pv_one<3>(o[3], vb, pa0, pa1, pa2, pa3);
}

__device__ __forceinline__ void attn_item(const Params& p, long tq0, int h, const u16* __restrict__ Kh, const u16* __restrict__ Vh, int seq, char* lds) {
  constexpr int LDK = 1024;
  const int tid = opaque_tid(), wid = __builtin_amdgcn_readfirstlane(tid >> 6), lane = tid & 63, r32 = lane & 31, hi = lane >> 5;
  const int comp = wid >> 2, qg = wid & 3;
  u16* V_lds = (u16*)lds; u16* K_lds = (u16*)(lds + 2 * SHM_V);
  float* wsl = (float*)(lds + 2 * SHM_V + 2 * SHM_K) + wid * 64; float* li_l = wsl; float* al_l = wsl + 32;
  float m_reg = -1e30f, l_reg = 0; f32x16 o[4] = {};
  char* Q_lds = lds + 2 * SHM_V + 2 * SHM_K + 2048;
  {
#pragma unroll
    for (int i = 0; i < 4; ++i) {
      int id = tid + i * NTHR; int row = id >> 4, ch = id & 15;
      bf16x8 v = *reinterpret_cast<const bf16x8*>(p.qb + (tq0 + row) * 1024 + h * 128 + ch * 8);
      *reinterpret_cast<bf16x8*>(Q_lds + KSWZ(row, ch * 16)) = v;
    }
  }
  __syncthreads();
  bf16x8 qr[4];
#pragma unroll
  for (int d0 = 0; d0 < 4; ++d0) qr[d0] = *reinterpret_cast<const bf16x8*>(Q_lds + (qg * 32) * 256 + KSWZ(r32, (comp * 64 + d0 * 16 + hi * 8) * 2));
  const int sr = tid >> 4, sc = (tid & 15) * 8, vst0 = v_st(sr, sc), vst1 = v_st(32 + sr, sc);
  const int vb0 = (int)(uintptr_t)V_lds + v_rd_base(lane);
  constexpr int SDEPTH = 1;
  struct { bf16x8 vs0, vs1, ks0, ks1; } sr_[SDEPTH];
#define SLOAD(i, k0) do { sr_[i].vs0 = *reinterpret_cast<const bf16x8*>(&Vh[(long)((k0) + sr) * LDK + sc]); sr_[i].vs1 = *reinterpret_cast<const bf16x8*>(&Vh[(long)((k0) + 32 + sr) * LDK + sc]); \
    sr_[i].ks0 = *reinterpret_cast<const bf16x8*>(&Kh[(long)((k0) + sr) * LDK + sc]); sr_[i].ks1 = *reinterpret_cast<const bf16x8*>(&Kh[(long)((k0) + 32 + sr) * LDK + sc]); } while (0)
#define SWRITE(b, i) do { *(bf16x8*)((char*)V_lds + (b) * SHM_V + vst0) = sr_[i].vs0;          \
    *(bf16x8*)((char*)V_lds + (b) * SHM_V + vst1) = sr_[i].vs1; int kc = sc * 2;               \
    *(bf16x8*)((char*)K_lds + (b) * SHM_K + KSWZ(sr, kc)) = sr_[i].ks0;                       \
    *(bf16x8*)((char*)K_lds + (b) * SHM_K + KSWZ(32 + sr, kc)) = sr_[i].ks1; } while (0)
#define SWAIT() do { if constexpr (SDEPTH == 2) asm volatile("s_waitcnt vmcnt(4)" ::: "memory"); else asm volatile("s_waitcnt vmcnt(0)" ::: "memory"); } while (0)
#define RESC(a) do { if (__any((a) < 1.f)) { if (hi == 0) al_l[r32] = (a); asm volatile("s_waitcnt lgkmcnt(0)" ::: "memory"); \
    _Pragma("unroll") for (int d = 0; d < 4; ++d) _Pragma("unroll") for (int r = 0; r < 16; ++r) o[d][r] *= al_l[crow(r, hi)]; } } while (0)
  f32x16 pA0, pA1, pB0, pB1; float mnA, mnB, alA, alB; bf16x8 pa0, pa1, pa2, pa3; const int NT = seq / 64;
  constexpr int SE = 0, SO = SDEPTH - 1;
  SLOAD(SE, 0); asm volatile("s_waitcnt vmcnt(0)" ::: "memory"); SWRITE(0, SE); __syncthreads();
  qkt(pA0, pA1, K_lds, qr, r32, hi, comp); partialSM(pA0, pA1, m_reg, mnA, alA);
  SLOAD(SO, 64); if constexpr (SDEPTH == 2) { if (2 < NT) SLOAD(SE, 2 * 64); }
  SWAIT(); SWRITE(1, SO); __syncthreads();
  for (int j = 1; j + 1 < NT; j += 2) {
    SBAR(); qkt(pB0, pB1, (u16*)((char*)K_lds + SHM_K), qr, r32, hi, comp);
    finishSM(pA0, pA1, alA, l_reg, pa0, pa1, pa2, pa3); SBAR();
    SLOAD(SO, (j + SDEPTH) * 64); SBAR();
    pv_d0(o, vb0, pa0, pa1, pa2, pa3); partialSM(pB0, pB1, m_reg, mnB, alB);
    __syncthreads(); SWAIT(); SWRITE(0, SE);
    RESC(alB); __syncthreads();
    SBAR(); qkt(pA0, pA1, K_lds, qr, r32, hi, comp);
    finishSM(pB0, pB1, alB, l_reg, pa0, pa1, pa2, pa3); SBAR();
    if (SDEPTH == 1 || j + 3 < NT) SLOAD(SE, (j + 1 + SDEPTH) * 64); SBAR();
    pv_d0(o, vb0 + (int)SHM_V, pa0, pa1, pa2, pa3); partialSM(pA0, pA1, m_reg, mnA, alA);
    __syncthreads(); SWAIT(); SWRITE(1, SO);
    RESC(alA); __syncthreads();
  }
  SBAR(); qkt(pB0, pB1, (u16*)((char*)K_lds + SHM_K), qr, r32, hi, comp);
  finishSM(pA0, pA1, alA, l_reg, pa0, pa1, pa2, pa3); SBAR();
  pv_d0(o, vb0, pa0, pa1, pa2, pa3); partialSM(pB0, pB1, m_reg, mnB, alB);
  __syncthreads(); RESC(alB);
  finishSM(pB0, pB1, alB, l_reg, pa0, pa1, pa2, pa3); SBAR();
  pv_d0(o, vb0 + (int)SHM_V, pa0, pa1, pa2, pa3);
  if (hi == 0) li_l[r32] = l_reg; asm volatile("s_waitcnt lgkmcnt(0)" ::: "memory");
  float rli[16];
#pragma unroll
  for (int r = 0; r < 16; ++r) rli[r] = 1.f / li_l[crow(r, hi)];
#undef SLOAD
#undef SWRITE
#undef SWAIT
#undef RESC
  __syncthreads();
  float* ex = (float*)lds;
  const float lam = p.misc[0];
  if (comp == 1) {
#pragma unroll
    for (int d0 = 0; d0 < 4; ++d0)
#pragma unroll
      for (int r = 0; r < 16; ++r) ex[((qg * 4 + d0) * 16 + r) * 64 + lane] = o[d0][r] * rli[r] * lam;
  }
  __syncthreads();
  if (comp == 0) {
    float ssq[16];
#pragma unroll
    for (int r = 0; r < 16; ++r) ssq[r] = 0.f;
#pragma unroll
    for (int d0 = 0; d0 < 4; ++d0)
#pragma unroll
      for (int r = 0; r < 16; ++r) {
        float v = o[d0][r] * rli[r] - ex[((qg * 4 + d0) * 16 + r) * 64 + lane];
        o[d0][r] = v; ssq[r] += v * v;
      }
#pragma unroll
    for (int r = 0; r < 16; ++r) {
      float s = ssq[r];
      s += __shfl_xor(s, 1); s += __shfl_xor(s, 2); s += __shfl_xor(s, 4); s += __shfl_xor(s, 8); s += __shfl_xor(s, 16);
      ssq[r] = rsqrtf(s * (1.f / 128.f) + EPSF) * (1.f - LAM_INIT);
    }
    float sg[4];
#pragma unroll
    for (int d0 = 0; d0 < 4; ++d0) sg[d0] = p.subln_g[d0 * 32 + r32];
    const long base = (tq0 + qg * 32 + 4 * hi) * 1024 + h * 128 + r32;
    const u16* gp = p.gb + base; u16* qp = p.qb + base;
#pragma unroll
    for (int r = 0; r < 16; ++r) {
      const int ro = ((r & 3) + 8 * (r >> 2)) * 1024;
      float g0 = bf2f(gp[ro]), g1 = bf2f(gp[ro + 32]), g2 = bf2f(gp[ro + 64]), g3 = bf2f(gp[ro + 96]);
      qp[ro] = f2bf(o[0][r] * ssq[r] * sg[0] * g0);
      qp[ro + 32] = f2bf(o[1][r] * ssq[r] * sg[1] * g1);
      qp[ro + 64] = f2bf(o[2][r] * ssq[r] * sg[2] * g2);
      qp[ro + 96] = f2bf(o[3][r] * ssq[r] * sg[3] * g3);
      SBAR();
    }
  }
  __syncthreads();
}


template <int D0> __device__ __forceinline__ void pv_two(f32x16& oa, f32x16& ob, int vb, bf16x8 a0, bf16x8 a1, bf16x8 a2, bf16x8 a3, bf16x8 b0, bf16x8 b1, bf16x8 b2, bf16x8 b3) {
  const s16x4 l0 = tr_read<v_rd_off(D0, 0, 0)>(vb), h0 = tr_read<v_rd_off(D0, 0, 1)>(vb), l1 = tr_read<v_rd_off(D0, 1, 0)>(vb), h1 = tr_read<v_rd_off(D0, 1, 1)>(vb);
  const s16x4 l2 = tr_read<v_rd_off(D0, 2, 0)>(vb), h2 = tr_read<v_rd_off(D0, 2, 1)>(vb), l3 = tr_read<v_rd_off(D0, 3, 0)>(vb), h3 = tr_read<v_rd_off(D0, 3, 1)>(vb);
#define PK(L, H) (bf16x8){L[0], L[1], L[2], L[3], H[0], H[1], H[2], H[3]}
  asm volatile("s_waitcnt lgkmcnt(6)" ::: "memory"); SBAR();
  { const bf16x8 v0 = PK(l0, h0);
    oa = __builtin_amdgcn_mfma_f32_32x32x16_bf16(a0, v0, oa, 0, 0, 0);
    ob = __builtin_amdgcn_mfma_f32_32x32x16_bf16(b0, v0, ob, 0, 0, 0); }
  SBAR(); asm volatile("s_waitcnt lgkmcnt(4)" ::: "memory"); SBAR();
  { const bf16x8 v1 = PK(l1, h1);
    oa = __builtin_amdgcn_mfma_f32_32x32x16_bf16(a1, v1, oa, 0, 0, 0);
    ob = __builtin_amdgcn_mfma_f32_32x32x16_bf16(b1, v1, ob, 0, 0, 0); }
  SBAR(); asm volatile("s_waitcnt lgkmcnt(2)" ::: "memory"); SBAR();
  { const bf16x8 v2 = PK(l2, h2);
    oa = __builtin_amdgcn_mfma_f32_32x32x16_bf16(a2, v2, oa, 0, 0, 0);
    ob = __builtin_amdgcn_mfma_f32_32x32x16_bf16(b2, v2, ob, 0, 0, 0); }
  SBAR(); asm volatile("s_waitcnt lgkmcnt(0)" ::: "memory"); SBAR();
  { const bf16x8 v3 = PK(l3, h3);
    oa = __builtin_amdgcn_mfma_f32_32x32x16_bf16(a3, v3, oa, 0, 0, 0);
    ob = __builtin_amdgcn_mfma_f32_32x32x16_bf16(b3, v3, ob, 0, 0, 0); }
#undef PK
}

__device__ __forceinline__ void attn_epi(const Params& p, f32x16 (&o)[4], const float (&rli)[16], int comp, int qg, int lane, int r32, int hi,
                                         long row0, int h, float* ex, float lam, bool dry) {
  const long gbase_i = (row0 + 4 * hi) * 1024 + h * 128 + r32;
  u16 gv0[8][4];
  if (comp == 0) {
    const u16* gp0 = p.gb + gbase_i;
#pragma unroll
    for (int r = 0; r < 8; ++r) {
      const int ro = ((r & 3) + 8 * (r >> 2)) * 1024;
      gv0[r][0] = gp0[ro]; gv0[r][1] = gp0[ro + 32]; gv0[r][2] = gp0[ro + 64]; gv0[r][3] = gp0[ro + 96];
    }
  }
  __syncthreads();
  if (comp == 1) {
#pragma unroll
    for (int d0 = 0; d0 < 4; ++d0)
#pragma unroll
      for (int r = 0; r < 16; ++r) ex[((qg * 4 + d0) * 16 + r) * 64 + lane] = o[d0][r] * rli[r] * lam;
  }
  __syncthreads();
  if (comp == 0) {
    float ssq[16];
#pragma unroll
    for (int r = 0; r < 16; ++r) ssq[r] = 0.f;
#pragma unroll
    for (int d0 = 0; d0 < 4; ++d0)
#pragma unroll
      for (int r = 0; r < 16; ++r) {
        float v = o[d0][r] * rli[r] - ex[((qg * 4 + d0) * 16 + r) * 64 + lane];
        o[d0][r] = v; ssq[r] += v * v;
      }
#pragma unroll
    for (int r = 0; r < 16; ++r) {
      float s = ssq[r];
      s += __shfl_xor(s, 1); s += __shfl_xor(s, 2); s += __shfl_xor(s, 4); s += __shfl_xor(s, 8); s += __shfl_xor(s, 16);
      ssq[r] = rsqrtf(s * (1.f / 128.f) + EPSF) * (1.f - LAM_INIT);
    }
    float sg[4];
#pragma unroll
    for (int d0 = 0; d0 < 4; ++d0) sg[d0] = p.subln_g[d0 * 32 + r32];
    const u16* gp = p.gb + gbase_i; u16* qp = p.qb + gbase_i;
#pragma unroll
    for (int r = 0; r < 8; ++r) {
      const int ro = ((r & 3) + 8 * (r >> 2)) * 1024;
      if (!dry) {
        qp[ro] = f2bf(o[0][r] * ssq[r] * sg[0] * bf2f(gv0[r][0]));
        qp[ro + 32] = f2bf(o[1][r] * ssq[r] * sg[1] * bf2f(gv0[r][1]));
        qp[ro + 64] = f2bf(o[2][r] * ssq[r] * sg[2] * bf2f(gv0[r][2]));
        qp[ro + 96] = f2bf(o[3][r] * ssq[r] * sg[3] * bf2f(gv0[r][3]));
      }
    }
    SBAR();
    u16 gv1[8][4];
#pragma unroll
    for (int rr = 0; rr < 8; ++rr) {
      const int r = 8 + rr, ro = ((r & 3) + 8 * (r >> 2)) * 1024;
      gv1[rr][0] = gp[ro]; gv1[rr][1] = gp[ro + 32]; gv1[rr][2] = gp[ro + 64]; gv1[rr][3] = gp[ro + 96];
    }
    SBAR();
#pragma unroll
    for (int rr = 0; rr < 8; ++rr) {
      const int r = 8 + rr, ro = ((r & 3) + 8 * (r >> 2)) * 1024;
      if (!dry) {
        qp[ro] = f2bf(o[0][r] * ssq[r] * sg[0] * bf2f(gv1[rr][0]));
        qp[ro + 32] = f2bf(o[1][r] * ssq[r] * sg[1] * bf2f(gv1[rr][1]));
        qp[ro + 64] = f2bf(o[2][r] * ssq[r] * sg[2] * bf2f(gv1[rr][2]));
        qp[ro + 96] = f2bf(o[3][r] * ssq[r] * sg[3] * bf2f(gv1[rr][3]));
      }
    }
  }
}

__device__ __forceinline__ void attn_item2(const Params& p, long tq0, int h, const u16* __restrict__ Kh, const u16* __restrict__ Vh, int seq, char* lds, bool dry) {
  constexpr int LDK = 1024;
  const int tid = opaque_tid(), wid = __builtin_amdgcn_readfirstlane(tid >> 6), lane = tid & 63, r32 = lane & 31, hi = lane >> 5;
  const int comp = wid >> 2, qg = wid & 3;
  u16* V_lds = (u16*)lds; u16* K_lds = (u16*)(lds + 2 * SHM_V);
  float* wsl = (float*)(lds + 2 * SHM_V + 2 * SHM_K) + wid * 128; float* li_a = wsl; float* al_a = wsl + 32; float* li_b = wsl + 64; float* al_b = wsl + 96;
  char* Q_lds = lds + 2 * SHM_V + 2 * SHM_K + 4096;
  float m_a = -1e30f, l_a = 0, m_b = -1e30f, l_b = 0; f32x16 oa[4] = {}, ob[4] = {};
#pragma unroll
  for (int i = 0; i < 8; ++i) {
    int id = tid + i * NTHR; int row = id >> 4, ch = id & 15;
    bf16x8 v = *reinterpret_cast<const bf16x8*>(p.qb + (tq0 + row) * 1024 + h * 128 + ch * 8);
    *reinterpret_cast<bf16x8*>(Q_lds + KSWZ(row, ch * 16)) = v;
  }
  const char* qa_p = Q_lds + (qg * 64) * 256; const char* qb_p = qa_p + 32 * 256;
  const int vb0 = (int)(uintptr_t)V_lds + v_rd_base(lane);
  typedef __attribute__((address_space(3))) unsigned char lds_u8;
  typedef __attribute__((address_space(3))) unsigned lds_u32;
  lds_u8* ldsl = (lds_u8*)lds;
  int koff[2], voff[2];
#pragma unroll
  for (int i = 0; i < 2; ++i) {
    const int offb = ((i * 8 + wid) * 64 + lane) * 16;
    { const int row = offb >> 8, wb = offb & 255, colB = wb ^ ((row & 7) << 4); koff[i] = row * LDK + (colB >> 1); }
    { const int sub = offb >> 9, within = offb & 511, kkh = sub >> 2, cblk = sub & 3, e = within >> 1, kkl = e >> 5, cl = e & 31;
      const int kk = kkh * 8 + kkl, k = (kk & ~0xC) | ((kk & 4) << 1) | ((kk & 8) >> 1); voff[i] = k * LDK + cblk * 32 + cl; }
  }
#define DMA(buf, k0) do { _Pragma("unroll") for (int _i = 0; _i < 2; ++_i) { \
    __builtin_amdgcn_global_load_lds((const unsigned*)(Kh + (long)(k0) * LDK + koff[_i]), (lds_u32*)(ldsl + 2 * SHM_V + (buf) * SHM_K + (_i * 8 + wid) * 1024), 16, 0, 0); \
    __builtin_amdgcn_global_load_lds((const unsigned*)(Vh + (long)(k0) * LDK + voff[_i]), (lds_u32*)(ldsl + (buf) * SHM_V + (_i * 8 + wid) * 1024), 16, 0, 0); } } while (0)
#define RESC2(a, O, AL) do { if (__any((a) < 1.f)) { if (hi == 0) AL[r32] = (a); asm volatile("s_waitcnt lgkmcnt(0)" ::: "memory"); \
    _Pragma("unroll") for (int d = 0; d < 4; ++d) _Pragma("unroll") for (int r = 0; r < 16; ++r) O[d][r] *= AL[crow(r, hi)]; } } while (0)
  const int NT = seq / 64;
  DMA(0, 0); asm volatile("s_waitcnt vmcnt(0)" ::: "memory"); __syncthreads();
  for (int j = 0; j < NT; ++j) {
    const int cur = j & 1;
    if (j + 1 < NT) { if (cur) DMA(0, (j + 1) * 64); else DMA(1, (j + 1) * 64); }
    f32x16 pA0 = {}, pA1 = {}, pB0 = {}, pB1 = {};
    {
      const char* Ks = (const char*)K_lds + cur * SHM_K;
#pragma unroll
      for (int d0 = 0; d0 < 4; ++d0) { const int cb = (comp * 64 + d0 * 16 + hi * 8) * 2;
        bf16x8 k0 = *reinterpret_cast<const bf16x8*>(Ks + KSWZ(r32, cb));
        bf16x8 k1 = *reinterpret_cast<const bf16x8*>(Ks + KSWZ(32 + r32, cb));
        bf16x8 qa = *reinterpret_cast<const bf16x8*>(qa_p + KSWZ(r32, cb));
        bf16x8 qb = *reinterpret_cast<const bf16x8*>(qb_p + KSWZ(r32, cb));
        pA0 = __builtin_amdgcn_mfma_f32_32x32x16_bf16(k0, qa, pA0, 0, 0, 0);
        pA1 = __builtin_amdgcn_mfma_f32_32x32x16_bf16(k1, qa, pA1, 0, 0, 0);
        pB0 = __builtin_amdgcn_mfma_f32_32x32x16_bf16(k0, qb, pB0, 0, 0, 0);
        pB1 = __builtin_amdgcn_mfma_f32_32x32x16_bf16(k1, qb, pB1, 0, 0, 0); SBAR(); }
    }
    float mn, al; bf16x8 a0, a1, a2, a3, b0, b1, b2, b3;
    partialSM(pA0, pA1, m_a, mn, al); RESC2(al, oa, al_a); finishSM(pA0, pA1, al, l_a, a0, a1, a2, a3);
    partialSM(pB0, pB1, m_b, mn, al); RESC2(al, ob, al_b); finishSM(pB0, pB1, al, l_b, b0, b1, b2, b3);
    SBAR();
    const int vb = vb0 + cur * (int)SHM_V;
    pv_two<0>(oa[0], ob[0], vb, a0, a1, a2, a3, b0, b1, b2, b3);
    pv_two<1>(oa[1], ob[1], vb, a0, a1, a2, a3, b0, b1, b2, b3);
    pv_two<2>(oa[2], ob[2], vb, a0, a1, a2, a3, b0, b1, b2, b3);
    pv_two<3>(oa[3], ob[3], vb, a0, a1, a2, a3, b0, b1, b2, b3);
    asm volatile("s_waitcnt vmcnt(0)" ::: "memory");
    __syncthreads();
  }
#undef DMA
#undef RESC2
  if (hi == 0) { li_a[r32] = l_a; li_b[r32] = l_b; } asm volatile("s_waitcnt lgkmcnt(0)" ::: "memory");
  const float lam = p.misc[0];
  float* ex = (float*)lds;
  {
    float rli[16];
#pragma unroll
    for (int r = 0; r < 16; ++r) rli[r] = __builtin_amdgcn_rcpf(li_a[crow(r, hi)]);
    attn_epi(p, oa, rli, comp, qg, lane, r32, hi, tq0 + qg * 64, h, ex, lam, dry);
  }
  {
    float rli[16];
#pragma unroll
    for (int r = 0; r < 16; ++r) rli[r] = __builtin_amdgcn_rcpf(li_b[crow(r, hi)]);
    attn_epi(p, ob, rli, comp, qg, lane, r32, hi, tq0 + qg * 64 + 32, h, ex, lam, dry);
  }
  __syncthreads();
}

__device__ __forceinline__ void conv8(const Params& p, long tok_s, int L, int tpos, int ch0, float (&o)[8]) {
  const u16* base = p.xbc + (tok_s + tpos) * 1536 + ch0;
  bf16x8 r1 = *reinterpret_cast<const bf16x8*>(base);
  bf16x8 r0 = {0, 0, 0, 0, 0, 0, 0, 0}, r2 = {0, 0, 0, 0, 0, 0, 0, 0};
  if (tpos > 0) r0 = *reinterpret_cast<const bf16x8*>(base - 1536);
  if (tpos < L - 1) r2 = *reinterpret_cast<const bf16x8*>(base + 1536);
  const f32x4* w0 = reinterpret_cast<const f32x4*>(p.conv_w + ch0);
  const f32x4* w1 = reinterpret_cast<const f32x4*>(p.conv_w + 1536 + ch0);
  const f32x4* w2 = reinterpret_cast<const f32x4*>(p.conv_w + 3072 + ch0);
  const f32x4* bb = reinterpret_cast<const f32x4*>(p.conv_b + ch0);
  const f32x4 wa0 = w0[0], wa1 = w0[1], wb0 = w1[0], wb1 = w1[1], wc0 = w2[0], wc1 = w2[1], b0 = bb[0], b1 = bb[1];
#pragma unroll
  for (int e = 0; e < 4; ++e) {
    float v = b0[e] + wa0[e] * bfs2f(r0[e]) + wb0[e] * bfs2f(r1[e]) + wc0[e] * bfs2f(r2[e]);
    o[e] = siluf(v);
    float u = b1[e] + wa1[e] * bfs2f(r0[4 + e]) + wb1[e] * bfs2f(r1[4 + e]) + wc1[e] * bfs2f(r2[4 + e]);
    o[4 + e] = siluf(u);
  }
}
__device__ __forceinline__ int rotc(int r, int c) { return (c + ((r >> 3) << 3)) & 127; }
__device__ __forceinline__ void chunk_geom(int cg, long& tok_s, int& L, int& tpos0) {
  if (cg < 32) { tok_s = (long)(cg >> 1) * 256; L = 256; tpos0 = (cg & 1) * 128; }
  else { int cs = cg - 32; tok_s = T_CTX + (long)(cs >> 5) * 4096; L = 4096; tpos0 = (cs & 31) * 128; }
}
__device__ __forceinline__ void ssd_dt_scan(const Params& p, long tok0, int head, float* dtv, float* cum, float* scn, float* tot) {
  const int tid = opaque_tid(), lane = tid & 63, wid = tid >> 6;
  if (tid < 256) {
    int d = tid >> 7, tl = tid & 127;
    float raw = p.dtb[(tok0 + tl) * 32 + d * 16 + head] + p.dt_bias[d * 16 + head];
    float dt = (raw > 20.f) ? raw : log1pf(expf(raw));
    float a = -expf(p.A_log[d * 16 + head]) * dt;
    dtv[d * 128 + tl] = dt;
    int li = d ? 127 - tl : tl;
    scn[d * 128 + li] = a;
  }
  __syncthreads();
  if (wid < 2) {
    int d = wid;
    float a0 = scn[d * 128 + 2 * lane], a1 = scn[d * 128 + 2 * lane + 1];
    float s = a0 + a1;
#pragma unroll
    for (int off = 1; off < 64; off <<= 1) { float t = __shfl_up(s, off); if (lane >= off) s += t; }
    float c0 = s - a1, c1 = s;
    int li0 = 2 * lane, li1 = 2 * lane + 1;
    cum[d * 128 + (d ? 127 - li0 : li0)] = c0;
    cum[d * 128 + (d ? 127 - li1 : li1)] = c1;
    if (lane == 63) tot[d] = c1;
  }
  __syncthreads();
}

__device__ void ssd_state_item(const Params& p, int cg, int head, char* smem, bool dry) {
  const int tid = opaque_tid(), lane = tid & 63, wid = tid >> 6, fr = lane & 15, fq = lane >> 4;
  float* dtv = (float*)smem; float* cum = dtv + 256; float* scn = cum + 256; float* tot = scn + 256;
  u16* XsT = (u16*)(smem + 4096);
  u16* BT = XsT + 64 * 136;
  long tok_s; int L, tpos0; chunk_geom(cg, tok_s, L, tpos0);
  const long tok0 = (long)cg * 128;
  const int g = head >> 2;
  ssd_dt_scan(p, tok0, head, dtv, cum, scn, tot);
  const float tot0 = tot[0], tot1 = tot[1];
#pragma unroll
  for (int rep = 0; rep < 2; ++rep) {
    int id = tid + rep * NTHR; int tl = id >> 3, p0 = (id & 7) * 8;
    float xo[8], bo[8];
    conv8(p, tok_s, L, tpos0 + tl, head * 64 + p0, xo);
    conv8(p, tok_s, L, tpos0 + tl, 1024 + g * 64 + p0, bo);
    float s0 = dtv[tl] * __expf(tot0 - cum[tl]);
    float s1 = dtv[128 + tl] * __expf(tot1 - cum[128 + tl]);
    const int tc = rotc(p0, tl);
#pragma unroll
    for (int e = 0; e < 8; ++e) {
      XsT[(p0 + e) * 136 + tc] = f2bf(xo[e]);
      BT[(p0 + e) * 136 + tc] = f2bf(bo[e] * s0);
      BT[(64 + p0 + e) * 136 + tc] = f2bf(bo[e] * s1);
    }
  }
  __syncthreads();
  {
    const int d = wid >> 2, pb = wid & 3;
    f32x4 acc[4];
#pragma unroll
    for (int ni = 0; ni < 4; ++ni) acc[ni] = f32x4{0.f, 0.f, 0.f, 0.f};
#pragma unroll
    for (int ks = 0; ks < 4; ++ks) {
      bf16x8 a = *reinterpret_cast<const bf16x8*>(XsT + (pb * 16 + fr) * 136 + rotc(pb * 16 + fr, ks * 32 + fq * 8));
#pragma unroll
      for (int ni = 0; ni < 4; ++ni) {
        bf16x8 b = *reinterpret_cast<const bf16x8*>(BT + (d * 64 + ni * 16 + fr) * 136 + rotc(ni * 16 + fr, ks * 32 + fq * 8));
        acc[ni] = mfma16(a, b, acc[ni]);
      }
    }
    u16* dst = p.st + ((long)(cg * 16 + head) * 2 + d) * 4096;
#pragma unroll
    for (int ni = 0; ni < 4; ++ni)
#pragma unroll
      for (int j = 0; j < 4; ++j) { if (!dry) dst[(pb * 16 + fq * 4 + j) * 64 + ni * 16 + fr] = f2bf(acc[ni][j]); }
  }
  if (tid < 2 && !dry) p.cd[(cg * 16 + head) * 2 + tid] = __expf(tot[tid]);
  __syncthreads();
}

__device__ void ssd_state_item2(const Params& p, int it0, char* smem, bool dry) {
  const int tid = opaque_tid(), lane = tid & 63, wid = tid >> 6, fr = lane & 15, fq = lane >> 4;
  constexpr int RSTRIDE = 57344;
  {
    const int u = tid >> 8, t2 = tid & 255, cg = (it0 + u) >> 4, head = (it0 + u) & 15;
    float* dtv = (float*)(smem + u * RSTRIDE); float* scn = dtv + 512;
    const int d = t2 >> 7, tl = t2 & 127;
    float raw = p.dtb[((long)cg * 128 + tl) * 32 + d * 16 + head] + p.dt_bias[d * 16 + head];
    float dt = (raw > 20.f) ? raw : log1pf(expf(raw));
    float a = -expf(p.A_log[d * 16 + head]) * dt;
    dtv[d * 128 + tl] = dt;
    scn[d * 128 + (d ? 127 - tl : tl)] = a;
  }
  __syncthreads();
  if (wid < 4) {
    const int u = wid >> 1, d = wid & 1;
    float* dtv = (float*)(smem + u * RSTRIDE); float* cum = dtv + 256; float* scn = cum + 256; float* tot = scn + 256;
    float a0 = scn[d * 128 + 2 * lane], a1 = scn[d * 128 + 2 * lane + 1];
    float sacc = a0 + a1;
#pragma unroll
    for (int off = 1; off < 64; off <<= 1) { float t = __shfl_up(sacc, off); if (lane >= off) sacc += t; }
    float c0 = sacc - a1, c1 = sacc;
    int li0 = 2 * lane, li1 = 2 * lane + 1;
    cum[d * 128 + (d ? 127 - li0 : li0)] = c0;
    cum[d * 128 + (d ? 127 - li1 : li1)] = c1;
    if (lane == 63) tot[d] = c1;
  }
  __syncthreads();
#pragma unroll
  for (int u = 0; u < 2; ++u) {
    const int cg = (it0 + u) >> 4, head = (it0 + u) & 15, g = head >> 2;
    float* dtv = (float*)(smem + u * RSTRIDE); float* cum = dtv + 256; float* tot = dtv + 768;
    u16* XsT = (u16*)(smem + u * RSTRIDE + 4096); u16* BT = XsT + 64 * 136;
    long tok_s; int L, tpos0; chunk_geom(cg, tok_s, L, tpos0);
    const float tot0 = tot[0], tot1 = tot[1];
#pragma unroll
    for (int rep = 0; rep < 2; ++rep) {
      int id = tid + rep * NTHR; int tl = id >> 3, p0 = (id & 7) * 8;
      float xo[8], bo[8];
      conv8(p, tok_s, L, tpos0 + tl, head * 64 + p0, xo);
      conv8(p, tok_s, L, tpos0 + tl, 1024 + g * 64 + p0, bo);
      float s0 = dtv[tl] * __expf(tot0 - cum[tl]);
      float s1 = dtv[128 + tl] * __expf(tot1 - cum[128 + tl]);
      const int tc = rotc(p0, tl);
#pragma unroll
      for (int e = 0; e < 8; ++e) {
        XsT[(p0 + e) * 136 + tc] = f2bf(xo[e]);
        BT[(p0 + e) * 136 + tc] = f2bf(bo[e] * s0);
        BT[(64 + p0 + e) * 136 + tc] = f2bf(bo[e] * s1);
      }
    }
  }
  __syncthreads();
#pragma unroll
  for (int u = 0; u < 2; ++u) {
    const int cg = (it0 + u) >> 4, head = (it0 + u) & 15;
    const u16* XsT = (const u16*)(smem + u * RSTRIDE + 4096); const u16* BT = XsT + 64 * 136;
    const float* tot = (const float*)(smem + u * RSTRIDE) + 768;
    const int d = wid >> 2, pb = wid & 3;
    f32x4 acc[4];
#pragma unroll
    for (int ni = 0; ni < 4; ++ni) acc[ni] = f32x4{0.f, 0.f, 0.f, 0.f};
#pragma unroll
    for (int ks = 0; ks < 4; ++ks) {
      bf16x8 a = *reinterpret_cast<const bf16x8*>(XsT + (pb * 16 + fr) * 136 + rotc(pb * 16 + fr, ks * 32 + fq * 8));
#pragma unroll
      for (int ni = 0; ni < 4; ++ni) {
        bf16x8 b = *reinterpret_cast<const bf16x8*>(BT + (d * 64 + ni * 16 + fr) * 136 + rotc(ni * 16 + fr, ks * 32 + fq * 8));
        acc[ni] = mfma16(a, b, acc[ni]);
      }
    }
    u16* dst = p.st + ((long)(cg * 16 + head) * 2 + d) * 4096;
#pragma unroll
    for (int ni = 0; ni < 4; ++ni)
#pragma unroll
      for (int j = 0; j < 4; ++j) { if (!dry) dst[(pb * 16 + fq * 4 + j) * 64 + ni * 16 + fr] = f2bf(acc[ni][j]); }
    if (tid < 2 && !dry) p.cd[(cg * 16 + head) * 2 + tid] = __expf(tot[tid]);
  }
  __syncthreads();
}

__device__ void phase3_attn(const Params& p, char* smem, bool dry) {
  constexpr int N_AS = 512, N_AC = 128;
  for (int it = blockIdx.x; it < N_AS + N_AC; it += gridDim.x) {
    long tq0; int h, seq; const u16 *kp, *vp;
    if (it < N_AS) {
      int qbi = it & 15, b = it >> 7; h = (it >> 4) & 7;
      if (gridDim.x == 256) {
        const int r = it >> 8, bid = it & 255, slot = bid >> 3;
        const int bh = r * 16 + (bid & 7) * 2 + (slot >> 4);
        qbi = slot & 15; b = bh >> 3; h = bh & 7;
      }
      tq0 = T_CTX + (long)b * 4096 + qbi * 256; seq = 4608;
      kp = p.kS + (long)b * 4608 * 1024 + h * 128; vp = p.vS + (long)b * 4608 * 1024 + h * 128;
    } else {
      int i = it - N_AS; int b = i >> 3; h = i & 7;
      tq0 = (long)b * 256; seq = 256;
      kp = p.kC + (long)b * 256 * 1024 + h * 128; vp = p.vC + (long)b * 256 * 1024 + h * 128;
    }
    attn_item2(p, tq0, h, kp, vp, seq, smem, dry);
  }
}
__device__ void phase3_state(const Params& p, char* smem, bool dry) {
  int start = blockIdx.x, stride = gridDim.x, cnt = (160 * 8 - (int)blockIdx.x + (int)gridDim.x - 1) / (int)gridDim.x;
  if (gridDim.x == 256) { stride = 128; if (blockIdx.x < 128) { start = blockIdx.x; cnt = 4; } else { start = 512 + (blockIdx.x - 128); cnt = 6; } }
#pragma unroll 1
  for (int k = 0; k < cnt; ++k) ssd_state_item2(p, (start + k * stride) * 2, smem, dry);
}
__device__ void phase3(const Params& p, char* smem) {
  if (p.probe & 8) phase3_attn(p, smem, true);
  if (p.probe & 16) phase3_state(p, smem, true);
  phase3_attn(p, smem, false);
  phase3_state(p, smem, false);
}

__device__ void phase4(const Params& p, char* smem) {
  const int tid = opaque_tid();
  for (int it = blockIdx.x; it < 256 + 1024; it += gridDim.x) {
    int seq, head, d, half, nc, c0; const float* h0p = nullptr; float* outp = nullptr;
    if (it < 256) { half = it & 1; d = (it >> 1) & 1; head = (it >> 2) & 15; int b = it >> 6; seq = 16 + b; nc = 32; c0 = 32 + b * 32;
      h0p = p.state_ssd + ((long)(b * 2 + d) * 16 + head) * 4096; }
    else { int i = it - 256; half = i & 1; d = (i >> 1) & 1; head = (i >> 2) & 15; int b = i >> 6; seq = b; nc = 2; c0 = b * 2;
      outp = p.out + 29360128L + ((long)(b * 2 + d) * 16 + head) * 4096; }
    (void)seq;
    const int e = half * 2048 + tid * 4;
    float h[4] = {0.f, 0.f, 0.f, 0.f};
    if (h0p) { float4 v = *reinterpret_cast<const float4*>(h0p + e); h[0] = v.x; h[1] = v.y; h[2] = v.z; h[3] = v.w; }
    const int cstart = d ? c0 + nc - 1 : c0, cstep = d ? -1 : 1;
    for (int i0 = 0; i0 < nc; i0 += 8) {
      u32x2 sv[8]; float dc[8];
#pragma unroll
      for (int k = 0; k < 8; ++k) if (i0 + k < nc) {
        int cgi = cstart + (i0 + k) * cstep;
        sv[k] = *reinterpret_cast<const u32x2*>(p.st + ((long)(cgi * 16 + head) * 2 + d) * 4096 + e);
        dc[k] = p.cd[(cgi * 16 + head) * 2 + d];
      }
#pragma unroll
      for (int k = 0; k < 8; ++k) if (i0 + k < nc) {
        int cgi = cstart + (i0 + k) * cstep;
        u32x2 hw = {cvtpk(h[0], h[1]), cvtpk(h[2], h[3])};
        *reinterpret_cast<u32x2*>(p.st + ((long)(cgi * 16 + head) * 2 + d) * 4096 + e) = hw;
        float s0 = __uint_as_float(sv[k][0] << 16), s1 = __uint_as_float(sv[k][0] & 0xffff0000u);
        float s2 = __uint_as_float(sv[k][1] << 16), s3 = __uint_as_float(sv[k][1] & 0xffff0000u);
        h[0] = h[0] * dc[k] + s0; h[1] = h[1] * dc[k] + s1; h[2] = h[2] * dc[k] + s2; h[3] = h[3] * dc[k] + s3;
      }
    }
    if (outp) { float4 v = {h[0], h[1], h[2], h[3]}; *reinterpret_cast<float4*>(outp + e) = v; }
  }
}

__device__ void ssd_y_item(const Params& p, int cg, int head, char* smem, bool dry) {
  const int tid = opaque_tid(), lane = tid & 63, wid = tid >> 6, fr = lane & 15, fq = lane >> 4;
  float* dtv = (float*)smem; float* cum = dtv + 256; float* scn = cum + 256; float* tot = scn + 256;
  u16* XT = (u16*)(smem + 4096);
  u16* Cs = XT + 64 * 136;
  u16* Bs = Cs + 128 * 72;
  u16* Ms = Bs + 128 * 72;
  u16* Hs = Ms + 128 * 136;
  long tok_s; int L, tpos0; chunk_geom(cg, tok_s, L, tpos0);
  const long tok0 = (long)cg * 128;
  const int g = head >> 2;
  bf16x8 hpre[2];
  {
    const int pp = tid >> 3, ch = (tid & 7) * 8;
    hpre[0] = *reinterpret_cast<const bf16x8*>(p.st + ((long)(cg * 16 + head) * 2 + 0) * 4096 + pp * 64 + ch);
    hpre[1] = *reinterpret_cast<const bf16x8*>(p.st + ((long)(cg * 16 + head) * 2 + 1) * 4096 + pp * 64 + ch);
  }
  ssd_dt_scan(p, tok0, head, dtv, cum, scn, tot);
#pragma unroll
  for (int rep = 0; rep < 2; ++rep) {
    int id = tid + rep * NTHR; int tl = id >> 3, p0 = (id & 7) * 8;
    float xo[8], bo[8], co[8];
    conv8(p, tok_s, L, tpos0 + tl, head * 64 + p0, xo);
    conv8(p, tok_s, L, tpos0 + tl, 1024 + g * 64 + p0, bo);
    conv8(p, tok_s, L, tpos0 + tl, 1280 + g * 64 + p0, co);
#pragma unroll
    for (int e = 0; e < 8; ++e) XT[(p0 + e) * 136 + rotc(p0, tl)] = f2bf(xo[e]);
    *reinterpret_cast<bf16x8*>(Bs + tl * 72 + p0) = pack8(bo);
    *reinterpret_cast<bf16x8*>(Cs + tl * 72 + p0) = pack8(co);
  }
  __syncthreads();
  f32x4 cb[8];
#pragma unroll
  for (int si = 0; si < 8; ++si) cb[si] = f32x4{0.f, 0.f, 0.f, 0.f};
#pragma unroll
  for (int ks = 0; ks < 2; ++ks) {
    bf16x8 a = *reinterpret_cast<const bf16x8*>(Cs + (wid * 16 + fr) * 72 + ks * 32 + fq * 8);
#pragma unroll
    for (int si = 0; si < 8; ++si) {
      bf16x8 b = *reinterpret_cast<const bf16x8*>(Bs + (si * 16 + fr) * 72 + ks * 32 + fq * 8);
      cb[si] = mfma16(a, b, cb[si]);
    }
  }
  f32x4 yacc[4];
#pragma unroll
  for (int pi = 0; pi < 4; ++pi) yacc[pi] = f32x4{0.f, 0.f, 0.f, 0.f};
  u16 zpre[4][4];
#pragma unroll
  for (int j = 0; j < 4; ++j)
#pragma unroll
    for (int pi = 0; pi < 4; ++pi) zpre[j][pi] = p.zb[(tok0 + wid * 16 + fq * 4 + j) * 1024 + head * 64 + pi * 16 + fr];
  {
    {
      int pp = tid >> 3, ch = (tid & 7) * 8;
      *reinterpret_cast<bf16x8*>(Hs + pp * 72 + ch) = hpre[0];
      *reinterpret_cast<bf16x8*>(Hs + 64 * 72 + pp * 72 + ch) = hpre[1];
    }
    float cq0[4], cq1[4];
#pragma unroll
    for (int j = 0; j < 4; ++j) { cq0[j] = cum[wid * 16 + fq * 4 + j]; cq1[j] = cum[128 + wid * 16 + fq * 4 + j]; }
#pragma unroll
    for (int si = 0; si < 8; ++si) {
      const int s = si * 16 + fr;
      const float cs0 = cum[s], cs1 = cum[128 + s], dt0 = dtv[s], dt1 = dtv[128 + s];
#pragma unroll
      for (int j = 0; j < 4; ++j) {
        const int q = wid * 16 + fq * 4 + j;
        const float arg = (s < q) ? (cq0[j] - cs0) : (cq1[j] - cs1);
        const float w = (s < q) ? dt0 : ((s > q) ? dt1 : dt0 + dt1);
        const float v = cb[si][j] * __expf((s == q) ? 0.f : arg) * w;
        Ms[q * 136 + s] = f2bf(v);
      }
    }
    __syncthreads();
    f32x4 tmp0[4], tmp1[4];
#pragma unroll
    for (int pi = 0; pi < 4; ++pi) { tmp0[pi] = f32x4{0.f, 0.f, 0.f, 0.f}; tmp1[pi] = f32x4{0.f, 0.f, 0.f, 0.f}; }
#pragma unroll
    for (int ks = 0; ks < 4; ++ks) {
      bf16x8 a = *reinterpret_cast<const bf16x8*>(Ms + (wid * 16 + fr) * 136 + ks * 32 + fq * 8);
#pragma unroll
      for (int pi = 0; pi < 4; ++pi) {
        bf16x8 b = *reinterpret_cast<const bf16x8*>(XT + (pi * 16 + fr) * 136 + rotc(pi * 16 + fr, ks * 32 + fq * 8));
        yacc[pi] = mfma16(a, b, yacc[pi]);
      }
    }
#pragma unroll
    for (int ks = 0; ks < 2; ++ks) {
      bf16x8 a = *reinterpret_cast<const bf16x8*>(Cs + (wid * 16 + fr) * 72 + ks * 32 + fq * 8);
#pragma unroll
      for (int pi = 0; pi < 4; ++pi) {
        bf16x8 b0 = *reinterpret_cast<const bf16x8*>(Hs + (pi * 16 + fr) * 72 + ks * 32 + fq * 8);
        bf16x8 b1 = *reinterpret_cast<const bf16x8*>(Hs + 64 * 72 + (pi * 16 + fr) * 72 + ks * 32 + fq * 8);
        tmp0[pi] = mfma16(a, b0, tmp0[pi]);
        tmp1[pi] = mfma16(a, b1, tmp1[pi]);
      }
    }
#pragma unroll
    for (int j = 0; j < 4; ++j) {
      const float e0 = __expf(cq0[j]), e1 = __expf(cq1[j]);
#pragma unroll
      for (int pi = 0; pi < 4; ++pi) yacc[pi][j] += e0 * tmp0[pi][j] + e1 * tmp1[pi][j];
    }
  }
  const float dsk = p.D_skip[head];
#pragma unroll
  for (int j = 0; j < 4; ++j) {
    int q = wid * 16 + fq * 4 + j;
    float ss = 0.f;
#pragma unroll
    for (int pi = 0; pi < 4; ++pi) {
      int pp = pi * 16 + fr;
      long idx = (tok0 + q) * 1024 + head * 64 + pp;
      float y = yacc[pi][j] + dsk * bf2f(XT[pp * 136 + rotc(pp, q)]);
      float yg = y * bf2f(zpre[j][pi]);
      if (!dry) p.zb[idx] = f2bf(yg);
      ss += yg * yg;
    }
    ss += __shfl_xor(ss, 1); ss += __shfl_xor(ss, 2); ss += __shfl_xor(ss, 4); ss += __shfl_xor(ss, 8);
    if (fr == 0 && !dry) p.ssqp[(tok0 + q) * 16 + head] = ss;
  }
  __syncthreads();
}
__device__ void phase5(const Params& p, char* smem) {
  if (p.probe & 32) { for (int it = blockIdx.x; it < 160 * 16; it += gridDim.x) ssd_y_item(p, it >> 4, it & 15, smem, true); }
  for (int it = blockIdx.x; it < 160 * 16; it += gridDim.x) ssd_y_item(p, it >> 4, it & 15, smem, false);
}

struct SegOrder : pg8::StaticOrder {
  __device__ bool next(int i, pg8::Unit& u) const {
    if (G != 256 || nwg != 320) { if (!tile_at((long)(i >> 1) * G + c, u)) return false; u.seg = i & 1; return true; }
    if (i < 2) { tile_at(c, u); u.seg = i; return true; }
    if (i > 2 || c >= 128) return false;
    const int t2 = c & 63;
    tile_at(256 + t2, u); u.seg = c >> 6; u.split = 1 + t2; return true;
  }
};
struct EpiOut {
  static constexpr bool PERM = true, AFTER_DRAIN = false, KEEP = true;
  const Params& p;
  __device__ __forceinline__ void operator()(f32x4 (&acc)[2][2][4][2], const pg8::Unit& u, int wr, int wc, int fr, int fq) const {
    const int m0 = u.pm * 256, n0 = u.pn * 256;
    if (u.seg == 0) {
#pragma unroll
      for (int ai = 0; ai < 2; ++ai) {
        f32x4 sv[4][4];
#pragma unroll
        for (int m = 0; m < 4; ++m) {
          const int t = m0 + ai * 128 + wr * 64 + m * 16 + fr;
          const f32x4* sp = reinterpret_cast<const f32x4*>(p.ssqp + (long)t * 16);
          sv[m][0] = sp[0]; sv[m][1] = sp[1]; sv[m][2] = sp[2]; sv[m][3] = sp[3];
        }
        SBAR();
#pragma unroll
        for (int m = 0; m < 4; ++m) {
          const f32x4 sa = sv[m][0] + sv[m][1] + sv[m][2] + sv[m][3];
          const float r = rsqrtf((sa[0] + sa[1] + sa[2] + sa[3]) * (1.f / 1024.f) + EPSF);
#pragma unroll
          for (int bj = 0; bj < 2; ++bj)
#pragma unroll
            for (int n = 0; n < 2; ++n) acc[ai][bj][m][n] *= r;
        }
        SBAR();
      }
      if (u.split) {
        const int wid = wr * 4 + wc, lane = fq * 16 + fr;
        float* sc = reinterpret_cast<float*>(p.st) + (size_t)(u.split - 1) * 65536 + (wid * 64 + lane) * 4;
#pragma unroll
        for (int ai = 0; ai < 2; ++ai)
#pragma unroll
          for (int bj = 0; bj < 2; ++bj)
#pragma unroll
            for (int m = 0; m < 4; ++m)
              { *reinterpret_cast<f32x4*>(sc + ((((ai * 2 + bj) * 4 + m) * 2 + 0) * 2048)) = acc[ai][bj][m][0]; *reinterpret_cast<f32x4*>(sc + ((((ai * 2 + bj) * 4 + m) * 2 + 1) * 2048)) = acc[ai][bj][m][1]; }
        __builtin_amdgcn_fence(__ATOMIC_RELEASE, "agent");
        asm volatile("s_waitcnt vmcnt(0)" ::: "memory");
        if (lane == 0) __hip_atomic_fetch_add(p.bar + SPLIT_FLAG0 + (u.split - 1), 1u, __ATOMIC_RELAXED, __HIP_MEMORY_SCOPE_AGENT);
      }
      return;
    }
    if (u.split) {
      const int wid = wr * 4 + wc, lane = fq * 16 + fr;
      unsigned* fl = p.bar + SPLIT_FLAG0 + (u.split - 1);
      unsigned sp = 0;
      while (__hip_atomic_load(fl, __ATOMIC_RELAXED, __HIP_MEMORY_SCOPE_AGENT) < 8u) { __builtin_amdgcn_s_sleep(2); if (++sp > (1u << 22)) break; }
      __builtin_amdgcn_fence(__ATOMIC_ACQUIRE, "agent");
      asm volatile("s_waitcnt vmcnt(0)" ::: "memory");
    }
    const int mr = (m0 < T_CTX) ? 0 : 1 + ((m0 - T_CTX) >> 12);
    const float* xb = (m0 < T_CTX) ? p.x_prompt + (long)m0 * 1024 : p.x_sample + (long)(m0 - T_CTX) * 1024;
    const int c0 = n0 + wc * 32 + 8 * fq;
    const float* gbase = p.modv + mr * 3072 + 2048 + c0;
    const bool spl = (u.split != 0);
    const int pstr = spl ? 2048 : 0;
    const float* pbase = spl ? reinterpret_cast<const float*>(p.st) + (size_t)(u.split - 1) * 65536 + ((wr * 4 + wc) * 64 + fq * 16 + fr) * 4
                             : reinterpret_cast<const float*>(p.bar + SPLIT_FLAG0 + 64);
#pragma unroll
    for (int ai = 0; ai < 2; ++ai)
#pragma unroll
      for (int mp = 0; mp < 2; ++mp) {
        f32x4 xv[2][2][2];
#pragma unroll
        for (int mm = 0; mm < 2; ++mm) {
          const int m = mp * 2 + mm, rl = ai * 128 + wr * 64 + m * 16 + fr;
          const float* xr = xb + rl * 1024 + c0;
#pragma unroll
          for (int bj = 0; bj < 2; ++bj) {
            xv[mm][bj][0] = __builtin_nontemporal_load(reinterpret_cast<const f32x4*>(xr + bj * 128)); xv[mm][bj][1] = __builtin_nontemporal_load(reinterpret_cast<const f32x4*>(xr + bj * 128 + 4));
          }
        }
        SBAR();
#pragma unroll
        for (int mm = 0; mm < 2; ++mm) {
          const int m = mp * 2 + mm, rl = ai * 128 + wr * 64 + m * 16 + fr;
          u16* orow = p.kC + (long)(m0 + rl) * 1024 + c0;
          const float* gp = gbase; asm volatile("" : "+v"(gp));
          float ss = 0.f;
#pragma unroll
          for (int bj = 0; bj < 2; ++bj) {
            const f32x4 g0 = *reinterpret_cast<const f32x4*>(gp + bj * 128), g1 = *reinterpret_cast<const f32x4*>(gp + bj * 128 + 4);
            const f32x4 q0 = *reinterpret_cast<const f32x4*>(pbase + ((((ai * 2 + bj) * 4 + m) * 2 + 0) * pstr));
            const f32x4 q1 = *reinterpret_cast<const f32x4*>(pbase + ((((ai * 2 + bj) * 4 + m) * 2 + 1) * pstr));
            f32x4 v0 = xv[mm][bj][0] + g0 * (acc[ai][bj][m][0] + q0);
            f32x4 v1 = xv[mm][bj][1] + g1 * (acc[ai][bj][m][1] + q1);
            u32x4 w = {cvtpk(v0[0], v0[1]), cvtpk(v0[2], v0[3]), cvtpk(v1[0], v1[1]), cvtpk(v1[2], v1[3])};
            *reinterpret_cast<u32x4*>(orow + bj * 128) = w;
#pragma unroll
            for (int e = 0; e < 4; ++e) {
              float lo = __uint_as_float(w[e] << 16), hi = __uint_as_float(w[e] & 0xffff0000u);
              ss += lo * lo + hi * hi;
            }
          }
          ss += __shfl_xor(ss, 16); ss += __shfl_xor(ss, 32);
          if (fq == 0) p.ssq2p[(long)(m0 + rl) * 16 + u.pn * 4 + wc] = ss;
        }
        SBAR();
      }
  }
};
__device__ void phase6(const Params& p, char* smem) {
  SegOrder S; S.init(T_ALL, 1024, (int)gridDim.x, (int)blockIdx.x);
  pg8::Gemm g{p.zb, p.woutT + 1024 * 1024, T_ALL, 1024, 1024, p.qb, p.woutT};
  EpiOut E{p};
  pg8::gemm_phase<EpiOut, SegOrder, false>((PG8_LAS unsigned char*)smem, g, S, E, nullptr);
  __syncthreads();
}

__device__ void phase7(const Params& p, char* smem) {
  const int tid = opaque_tid(), lane = tid & 63, wid = tid >> 6;
  for (int it = blockIdx.x; it < T_ALL / 32; it += gridDim.x) {
    u32x2 w[4][4]; float sq[4];
#pragma unroll
    for (int rr = 0; rr < 4; ++rr) {
      const int t = it * 32 + rr * 8 + wid;
      const u16* xr = p.kC + (long)t * 1024;
#pragma unroll
      for (int i = 0; i < 4; ++i) w[rr][i] = *reinterpret_cast<const u32x2*>(xr + i * 256 + lane * 4);
      sq[rr] = (lane < 16) ? p.ssq2p[(long)t * 16 + lane] : 0.f;
    }
#pragma unroll
    for (int rr = 0; rr < 4; ++rr) {
      const int t = it * 32 + rr * 8 + wid;
      float s = sq[rr];
      s += __shfl_xor(s, 1); s += __shfl_xor(s, 2); s += __shfl_xor(s, 4); s += __shfl_xor(s, 8);
      s = __shfl(s, 0);
      const float rs = rsqrtf(s * (1.f / 1024.f) + EPSF);
      float* yr = p.out + (long)t * 1024;
#pragma unroll
      for (int i = 0; i < 4; ++i) {
        int col = i * 256 + lane * 4;
        float4 g = *reinterpret_cast<const float4*>(p.final_g + col);
        float4 v;
        v.x = __uint_as_float(w[rr][i][0] << 16) * rs * g.x; v.y = __uint_as_float(w[rr][i][0] & 0xffff0000u) * rs * g.y;
        v.z = __uint_as_float(w[rr][i][1] << 16) * rs * g.z; v.w = __uint_as_float(w[rr][i][1] & 0xffff0000u) * rs * g.w;
        __builtin_nontemporal_store(v.x, yr + col); __builtin_nontemporal_store(v.y, yr + col + 1);
        __builtin_nontemporal_store(v.z, yr + col + 2); __builtin_nontemporal_store(v.w, yr + col + 3);
      }
    }
  }
}

#define XB_TMO      128
#define XB_XCNT(j)  (256  + 64 * (j))
#define XB_XSUB(j)  (1280 + 64 * (j))
#define XB_XGEN(j)  (2304 + 64 * (j))
#define XB_TOP      3328
#define XB_TOPGEN   3392
#define XCD_BAR_WORDS 3456
#define XB_SPIN_CAP (1u << 18)
#define XLAS __attribute__((address_space(3)))

__device__ __forceinline__ unsigned xb_ld(unsigned* p)              { return __hip_atomic_load(p, __ATOMIC_RELAXED, __HIP_MEMORY_SCOPE_AGENT); }
__device__ __forceinline__ unsigned xb_add(unsigned* p, unsigned v) { return __hip_atomic_fetch_add(p, v, __ATOMIC_RELAXED, __HIP_MEMORY_SCOPE_AGENT); }
__device__ __forceinline__ unsigned xb_xcc_id() { return (unsigned)__builtin_amdgcn_s_getreg((3 << 11) | 20) & 0xFu; }
#define XB_SPIN(cond, bar) do { unsigned _sp = 0; while (cond) { __builtin_amdgcn_s_sleep(1); \
    if ((++_sp & 255u) == 0u) { if (xb_ld(&(bar)[XB_TMO])) break; if (_sp > XB_SPIN_CAP) { atomicAdd(&(bar)[XB_TMO], 1u); break; } } } } while (0)

struct XcdBarrier {
    unsigned* bar; unsigned x;
    volatile XLAS unsigned* st;
};

__device__ __forceinline__ XcdBarrier xcd_barrier_post(unsigned* bar, volatile XLAS unsigned* st) {
    XcdBarrier b; b.bar = bar; b.x = xb_xcc_id(); b.st = st;
    if (threadIdx.x == 0) (void)xb_add(&bar[XB_XCNT(b.x)], 1u);
    return b;
}
__device__ __forceinline__ void xcd_barrier_complete(unsigned* bar, unsigned x, unsigned& nloc, unsigned& nx) {
    const unsigned G = gridDim.x * gridDim.y * gridDim.z;
    unsigned sum, cnt, mine, sp = 0u;
    for (;;) {
        sum = 0u; cnt = 0u; mine = 0u;
#pragma unroll
        for (unsigned j = 0; j < 16; ++j) { const unsigned c = xb_ld(&bar[XB_XCNT(j)]); sum += c; cnt += (c > 0u) ? 1u : 0u; mine = (j == x) ? c : mine; }
        if (sum == G) break;
        __builtin_amdgcn_s_sleep(1);
        if ((++sp & 255u) == 0u) { if (xb_ld(&bar[XB_TMO])) break; if (sp > XB_SPIN_CAP) { atomicAdd(&bar[XB_TMO], 1u); break; } }
    }
    nloc = mine > 0u ? mine : 1u; nx = cnt > 0u ? cnt : 1u;
}

__device__ __forceinline__ void xcd_barrier(const XcdBarrier& b) {
    asm volatile("s_waitcnt vmcnt(0)" ::: "memory");
    __syncthreads();
    if (threadIdx.x == 0) {
        unsigned* bar = b.bar;
        __builtin_amdgcn_s_waitcnt(0);
        unsigned nloc = b.st[0], nx = b.st[1];
        if (nloc == 0u) { xcd_barrier_complete(bar, b.x, nloc, nx); b.st[0] = nloc; b.st[1] = nx; }
        const unsigned old = xb_add(&bar[XB_XSUB(b.x)], 1u);
        const unsigned gen = old / nloc;
        if (old + 1u == (gen + 1u) * nloc) {
            __builtin_amdgcn_fence(__ATOMIC_RELEASE, "agent");
            asm volatile("s_waitcnt vmcnt(0)" ::: "memory");
            const unsigned og = xb_add(&bar[XB_TOP], 1u);
            const unsigned tg = og / nx;
            if (og + 1u == (tg + 1u) * nx) xb_add(&bar[XB_TOPGEN], 1u);
            else XB_SPIN(xb_ld(&bar[XB_TOPGEN]) == tg, bar);
            __builtin_amdgcn_fence(__ATOMIC_ACQUIRE, "agent");
            xb_add(&bar[XB_XGEN(b.x)], 1u);
            asm volatile("s_waitcnt vmcnt(0)" ::: "memory");
        } else {
            XB_SPIN(xb_ld(&bar[XB_XGEN(b.x)]) == gen, bar);
            __builtin_amdgcn_fence(__ATOMIC_ACQUIRE, "agent");
            asm volatile("s_waitcnt vmcnt(0)" ::: "memory");
        }
    }
    __syncthreads();
}

template <int PH> __device__ __forceinline__ void run_phase(const Params& p, char* smem) {
  if constexpr (PH == 0) phase0(p, smem);
  if constexpr (PH == 1) phase1(p, smem);
  if constexpr (PH == 2) phase2(p, smem);
  if constexpr (PH == 3) phase3(p, smem);
  if constexpr (PH == 4) phase4(p, smem);
  if constexpr (PH == 5) phase5(p, smem);
  if constexpr (PH == 6) phase6(p, smem);
  if constexpr (PH == 7) phase7(p, smem);
}

#if MK_COOP
__global__ void __launch_bounds__(NTHR) fwd_megakernel(Params p) {
  extern __shared__ __attribute__((aligned(16))) char smem[];
  cg::grid_group grid = cg::this_grid();
  __shared__ unsigned xb_st[4];
  if (threadIdx.x < 4) xb_st[threadIdx.x] = 0u;
  __syncthreads();
  if (p.probe == 0x7fffffff) grid.sync();
  const XcdBarrier xb = xcd_barrier_post(p.bar, (volatile XLAS unsigned*)xb_st);
  for (int r = 0; r < REP0; ++r) { phase0(p, smem); xcd_barrier(xb); }
  for (int r = 0; r < REP1; ++r) { phase1(p, smem); xcd_barrier(xb); }
  for (int r = 0; r < REP2; ++r) { phase2(p, smem); xcd_barrier(xb); }
  phase3(p, smem); xcd_barrier(xb);
  phase4(p, smem); xcd_barrier(xb);
  phase5(p, smem); xcd_barrier(xb);
  for (int r = 0; r < REP6; ++r) { phase6(p, smem); xcd_barrier(xb); }
  phase7(p, smem);
}
#else
template <int PH> __global__ void __launch_bounds__(NTHR) phase_kernel(Params p) {
  extern __shared__ __attribute__((aligned(16))) char smem[];
  run_phase<PH>(p, smem);
}
#endif

#ifndef XLAST
#define XLAST
#endif
#ifndef LAST_PHASE
#define LAST_PHASE 7
#endif
__global__ void dbg_copy(const uint4* __restrict__ src, uint4* __restrict__ dst, long n16) {
  for (long i = blockIdx.x * 256L + threadIdx.x; i < n16; i += gridDim.x * 256L) dst[i] = src[i];
}
extern "C" void kernel_launch(void* const* d_in, const int* in_sizes, int n_in, void* d_out, int out_size, void* d_ws, size_t ws_size,
                              hipStream_t stream) {
  Params p;
  memset(&p, 0, sizeof(p));
  const float* const* in = (const float* const*)d_in;
  p.x_prompt = in[0]; p.x_sample = in[1]; p.cache_k = in[2]; p.cache_v = in[3]; p.state_ssd = in[4]; p.c = in[5]; p.c_ctx = in[6];
  p.w_mod = in[7]; p.b_mod = in[8]; p.norm_g = in[9]; p.w_in = in[10]; p.lq1 = in[11]; p.lk1 = in[12]; p.lq2 = in[13]; p.lk2 = in[14];
  p.subln_g = in[15]; p.conv_w = in[16]; p.conv_b = in[17]; p.dt_bias = in[18]; p.A_log = in[19]; p.D_skip = in[20];
  p.ssd_norm_g = in[21]; p.w_out = in[22]; p.final_g = in[23];
  p.out = (float*)d_out;
  p.probe = PROBE_MASK;
  char* w = (char*)d_ws; size_t off = 0;
  auto take = [&](size_t bytes) { char* r = w + off; off += (bytes + 255) & ~(size_t)255; return r; };
  p.winT = (u16*)take((size_t)NPADW * 1024 * 2);
  p.woutT = (u16*)take((size_t)1024 * 2048 * 2);
  p.qb = (u16*)take((size_t)T_ALL * 1024 * 2);
  p.kC = (u16*)take((size_t)T_CTX * 1024 * 2);
  p.kS = (u16*)take((size_t)4 * 4608 * 1024 * 2);
  p.vC = (u16*)take((size_t)T_CTX * 1024 * 2);
  p.vS = (u16*)take((size_t)4 * 4608 * 1024 * 2);
  p.zb = (u16*)take((size_t)T_ALL * 1024 * 2);
  p.xbc = (u16*)take((size_t)T_ALL * 1536 * 2);
  p.dtb = (float*)take((size_t)T_ALL * 32 * 4);
  p.modv = (float*)take((size_t)5 * 3072 * 4);
  p.rope = (float*)take((size_t)64 * 16 * 2 * 4);
  p.misc = (float*)take(256);
  p.cd = (float*)take((size_t)160 * 16 * 2 * 4);
  p.ssqp = (float*)take((size_t)T_ALL * 16 * 4);
  p.ssq2p = (float*)take((size_t)T_ALL * 16 * 4);
  p.bar = (unsigned*)take((size_t)(XCD_BAR_WORDS + 64 + 65536) * 4);
  if (off > ws_size) { fprintf(stderr, "kernel_launch: workspace too small: need %zu have %zu\n", off, ws_size); return; }
  p.hb = (u16*)d_out;
  p.st = (u16*)d_out;
  p.gb = (u16*)d_out + (size_t)T_ALL * 1024;

#if MK_COOP
  static int grid_blocks = 0;
  if (!grid_blocks) {
    int dev = 0, cus = 0, per_cu = 0;
    hipGetDevice(&dev);
    hipDeviceGetAttribute(&cus, hipDeviceAttributeMultiprocessorCount, dev);
    hipFuncSetAttribute((const void*)fwd_megakernel, hipFuncAttributeMaxDynamicSharedMemorySize, LDS_BYTES);
    hipOccupancyMaxActiveBlocksPerMultiprocessor(&per_cu, (const void*)fwd_megakernel, NTHR, LDS_BYTES);
    if (per_cu < 1) per_cu = 1;
    grid_blocks = cus * per_cu;
  }
  (void)hipMemsetAsync(p.bar, 0, (size_t)(XCD_BAR_WORDS + 64 + 65536) * 4, stream);
  void* args[] = {&p};
  hipError_t e = hipLaunchCooperativeKernel((const void*)fwd_megakernel, dim3(grid_blocks), dim3(NTHR), args, LDS_BYTES, stream);
  if (e != hipSuccess) fprintf(stderr, "cooperative launch failed: %s (grid %d)\n", hipGetErrorString(e), grid_blocks);
#else
  static int attr_done = 0;
  if (!attr_done) {
    hipFuncSetAttribute((const void*)phase_kernel<0>, hipFuncAttributeMaxDynamicSharedMemorySize, LDS_BYTES);
    hipFuncSetAttribute((const void*)phase_kernel<1>, hipFuncAttributeMaxDynamicSharedMemorySize, LDS_BYTES);
    hipFuncSetAttribute((const void*)phase_kernel<2>, hipFuncAttributeMaxDynamicSharedMemorySize, LDS_BYTES);
    hipFuncSetAttribute((const void*)phase_kernel<3>, hipFuncAttributeMaxDynamicSharedMemorySize, LDS_BYTES);
    hipFuncSetAttribute((const void*)phase_kernel<4>, hipFuncAttributeMaxDynamicSharedMemorySize, LDS_BYTES);
    hipFuncSetAttribute((const void*)phase_kernel<5>, hipFuncAttributeMaxDynamicSharedMemorySize, LDS_BYTES);
    hipFuncSetAttribute((const void*)phase_kernel<6>, hipFuncAttributeMaxDynamicSharedMemorySize, LDS_BYTES);
    hipFuncSetAttribute((const void*)phase_kernel<7>, hipFuncAttributeMaxDynamicSharedMemorySize, LDS_BYTES);
    attr_done = 1;
  }
  const int G = 256;
  if (LAST_PHASE >= 0) hipLaunchKernelGGL(phase_kernel<0>, dim3(G), dim3(NTHR), LDS_BYTES, stream, p);
  if (LAST_PHASE >= 1) hipLaunchKernelGGL(phase_kernel<1>, dim3(G), dim3(NTHR), LDS_BYTES, stream, p);
  if (LAST_PHASE >= 2) hipLaunchKernelGGL(phase_kernel<2>, dim3(G), dim3(NTHR), LDS_BYTES, stream, p);
  if (LAST_PHASE >= 3) hipLaunchKernelGGL(phase_kernel<3>, dim3(G), dim3(NTHR), LDS_BYTES, stream, p);
  if (LAST_PHASE >= 4) hipLaunchKernelGGL(phase_kernel<4>, dim3(G), dim3(NTHR), LDS_BYTES, stream, p);
  if (LAST_PHASE >= 5) hipLaunchKernelGGL(phase_kernel<5>, dim3(G), dim3(NTHR), LDS_BYTES, stream, p);
  if (LAST_PHASE >= 6) hipLaunchKernelGGL(phase_kernel<6>, dim3(G), dim3(NTHR), LDS_BYTES, stream, p);
  if (LAST_PHASE >= 7) hipLaunchKernelGGL(phase_kernel<7>, dim3(G), dim3(NTHR), LDS_BYTES, stream, p);
#if LAST_PHASE == 3
  hipLaunchKernelGGL(dbg_copy, dim3(1024), dim3(256), 0, stream, (const uint4*)p.qb, (uint4*)p.gb, (long)T_ALL * 1024 * 2 / 16);
#endif
#endif
}
```
